# Optimizing an MI355X kernel written in HIP

```python
import math
import jax, jax.numpy as jnp
from jax import lax
import numpy as np

D_MODEL = 4096
BATCH = 8
SEQ = 2048
DEPTH = 2
DEC_BATCH = 8
DEC_SEQ = 16
PAST_LEN = 2048

CHUNK = 64
MIX_W = D_MODEL // 4
HEAD_DIM = 128
N_HEADS_B = MIX_W // HEAD_DIM
N_HEADS_C = MIX_W // HEAD_DIM
SSM_GROUP = 16
N_GROUPS = MIX_W // SSM_GROUP
SSM_STATE = 64
BAND_CHUNKS = 8
BAND_LEN = BAND_CHUNKS * CHUNK
MAX_REL = 128
SB_BLOCK = 128
N_BRANCH = 3
N_IN = 10 * MIX_W + N_BRANCH * D_MODEL
RMS_EPS = 1e-6
NEG_INF = -1e30

kernel_name = "hybrid_streaming_encoder_step"


def rmsnorm(x, g):
    x32 = x.astype(jnp.float32)
    r = lax.rsqrt(jnp.mean(x32 * x32, axis=-1, keepdims=True) + RMS_EPS)
    return (x32 * r * g.astype(jnp.float32)).astype(x.dtype)


def _cmul_combine(e1, e2):
    a1r, a1i, b1r, b1i = e1
    a2r, a2i, b2r, b2i = e2
    ar = a2r * a1r - a2i * a1i
    ai = a2r * a1i + a2i * a1r
    br = a2r * b1r - a2i * b1i + b2r
    bi = a2r * b1i + a2i * b1r + b2i
    return (ar, ai, br, bi)


def s5_scan(u, h0_re, h0_im, a_re, a_im, log_dt, b_re, b_im, c_re, c_im, d_skip):
    f32 = jnp.float32
    bsz, s, _ = u.shape
    u32 = u.astype(f32)
    ug = u32.reshape(bsz, s, N_GROUPS, SSM_GROUP)
    a_re = a_re.astype(f32)
    a_im = a_im.astype(f32)
    dt = jnp.exp(log_dt.astype(f32))[:, None]
    mag = jnp.exp(a_re * dt)
    ab_re = mag * jnp.cos(a_im * dt)
    ab_im = mag * jnp.sin(a_im * dt)
    den = a_re * a_re + a_im * a_im
    nr = ab_re - 1.0
    k_re = (nr * a_re + ab_im * a_im) / den
    k_im = (ab_im * a_re - nr * a_im) / den
    b_re = b_re.astype(f32)
    b_im = b_im.astype(f32)
    bb_re = k_re[..., None] * b_re - k_im[..., None] * b_im
    bb_im = k_re[..., None] * b_im + k_im[..., None] * b_re
    bu_re = jnp.einsum("bsgp,gnp->bsgn", ug, bb_re)
    bu_im = jnp.einsum("bsgp,gnp->bsgn", ug, bb_im)
    h0_re = h0_re.astype(f32)
    h0_im = h0_im.astype(f32)
    bu_re = bu_re.at[:, 0].add(ab_re * h0_re - ab_im * h0_im)
    bu_im = bu_im.at[:, 0].add(ab_re * h0_im + ab_im * h0_re)
    ar = jnp.broadcast_to(ab_re, bu_re.shape)
    ai = jnp.broadcast_to(ab_im, bu_re.shape)
    _, _, h_re, h_im = lax.associative_scan(_cmul_combine, (ar, ai, bu_re, bu_im), axis=1)
    y = (jnp.einsum("bsgn,gpn->bsgp", h_re, c_re.astype(f32))
         - jnp.einsum("bsgn,gpn->bsgp", h_im, c_im.astype(f32)))
    y = y.reshape(bsz, s, MIX_W) + d_skip.astype(f32) * u32
    return y, h_re[:, -1], h_im[:, -1]


def rel_bias_lookup(rel_bias, qpos, kpos):
    rel = jnp.clip(qpos[:, None] - kpos[None, :], -MAX_REL, MAX_REL) + MAX_REL
    return rel_bias[:, rel].astype(jnp.float32)


def band_attention_prompt(q, k, v, rel_bias):
    bsz, s, h, dh = q.shape
    nc = s // CHUNK
    band = (BAND_CHUNKS + 1) * CHUNK
    qc = q.reshape(bsz, nc, CHUNK, h, dh)
    kc = k.reshape(bsz, nc, CHUNK, h, dh)
    vc = v.reshape(bsz, nc, CHUNK, h, dh)
    cidx = jnp.arange(nc)[:, None] + jnp.arange(BAND_CHUNKS + 1)[None, :] - BAND_CHUNKS
    valid = jnp.repeat(cidx >= 0, CHUNK, axis=1)
    cidx = jnp.maximum(cidx, 0)
    kb = kc[:, cidx].reshape(bsz, nc, band, h, dh)
    vb = vc[:, cidx].reshape(bsz, nc, band, h, dh)
    bias = rel_bias_lookup(rel_bias, jnp.arange(CHUNK) + BAND_CHUNKS * CHUNK, jnp.arange(band))
    sc = jnp.einsum("bcqhd,bckhd->bchqk", qc, kb).astype(jnp.float32) * (1.0 / math.sqrt(dh)) + bias
    sc = jnp.where(valid[None, :, None, None, :], sc, NEG_INF)
    p = jax.nn.softmax(sc, axis=-1)
    o = jnp.einsum("bchqk,bckhd->bcqhd", p.astype(vb.dtype), vb)
    return o.reshape(bsz, s, h * dh)


def band_attention_sample(q, k, v, cache_k, cache_v, rel_bias):
    bsz, n, h, dh = q.shape
    lc = cache_k.shape[1]
    kk = jnp.concatenate([cache_k.astype(k.dtype), k], axis=1)
    vv = jnp.concatenate([cache_v.astype(v.dtype), v], axis=1)
    bias = rel_bias_lookup(rel_bias, jnp.arange(n) + lc, jnp.arange(lc + n))
    sc = jnp.einsum("bqhd,bkhd->bhqk", q, kk).astype(jnp.float32) * (1.0 / math.sqrt(dh)) + bias
    p = jax.nn.softmax(sc, axis=-1)
    o = jnp.einsum("bhqk,bkhd->bqhd", p.astype(vv.dtype), vv)
    return o.reshape(bsz, n, h * dh)


def stick_breaking_block(q, qpos, k, v, kpos):
    dh = q.shape[-1]
    z = jnp.einsum("bqhd,bkhd->bhqk", q, k).astype(jnp.float32) * (1.0 / math.sqrt(dh))
    causal = kpos[None, :] < qpos[:, None]
    log_beta = jax.nn.log_sigmoid(z)
    log_fail = jnp.where(causal, jax.nn.log_sigmoid(-z), 0.0)
    later = lax.cumsum(log_fail, axis=3, reverse=True) - log_fail
    w = jnp.where(causal, jnp.exp(log_beta + later), 0.0)
    return jnp.einsum("bhqk,bkhd->bqhd", w.astype(v.dtype), v)


def stick_breaking_prompt(q, k, v):
    bsz, s, h, dh = q.shape
    nb = s // SB_BLOCK
    qb = q.reshape(bsz, nb, SB_BLOCK, h, dh).transpose(1, 0, 2, 3, 4)
    qpos = jnp.arange(s).reshape(nb, SB_BLOCK)
    kpos = jnp.arange(s)
    o = lax.map(lambda a: stick_breaking_block(a[0], a[1], k, v, kpos), (qb, qpos))
    return o.transpose(1, 0, 2, 3, 4).reshape(bsz, s, h * dh)


def stick_breaking_sample(q, k, v, cache_k, cache_v):
    bsz, n, h, dh = q.shape
    pl = cache_k.shape[1]
    kk = jnp.concatenate([cache_k.astype(k.dtype), k], axis=1)
    vv = jnp.concatenate([cache_v.astype(v.dtype), v], axis=1)
    o = stick_breaking_block(q, pl + jnp.arange(n), kk, vv, jnp.arange(pl + n))
    return o.reshape(bsz, n, h * dh)


def hybrid_layer(x, w, cache):
    (norm_g, w_in, a_re, a_im, log_dt, b_re, b_im, c_re, c_im, d_skip, w_glu, b_glu,
     qn_g, kn_g, rel_bias, w_br_a, w_br_b, w_br_c, gate_b, w_out) = w
    f32 = jnp.float32
    bsz, s, _ = x.shape
    hx = rmsnorm(x, norm_g)
    proj = hx @ w_in
    (u_a, z_a, q_b, k_b, v_b, z_b, q_c, k_c, v_c, z_c, g_in) = jnp.split(
        proj, [MIX_W * i for i in range(1, 11)], axis=-1)
    split_heads = lambda t: t.reshape(bsz, s, -1, HEAD_DIM)
    if cache is None:
        h0_re = jnp.zeros((bsz, N_GROUPS, SSM_STATE), f32)
        h0_im = jnp.zeros((bsz, N_GROUPS, SSM_STATE), f32)
    else:
        sb_k_c, sb_v_c, band_k_c, band_v_c, h0_re, h0_im = cache
    y_a, hT_re, hT_im = s5_scan(u_a, h0_re, h0_im, a_re, a_im, log_dt, b_re, b_im, c_re, c_im, d_skip)
    y_a = jax.nn.gelu(y_a)
    y_a = (y_a * jax.nn.sigmoid(y_a @ w_glu.astype(f32) + b_glu.astype(f32))).astype(x.dtype)
    qb = rmsnorm(split_heads(q_b), qn_g)
    kb = rmsnorm(split_heads(k_b), kn_g)
    vb = split_heads(v_b)
    qc, kc, vc = split_heads(q_c), split_heads(k_c), split_heads(v_c)
    if cache is None:
        y_b = band_attention_prompt(qb, kb, vb, rel_bias)
        y_c = stick_breaking_prompt(qc, kc, vc)
        keep = min(BAND_LEN, s)
        band_k_new, band_v_new = kb[:, s - keep:], vb[:, s - keep:]
    else:
        y_b = band_attention_sample(qb, kb, vb, band_k_c, band_v_c, rel_bias)
        y_c = stick_breaking_sample(qc, kc, vc, sb_k_c, sb_v_c)
        band_k_new, band_v_new = kb, vb
    o_a = (y_a * jax.nn.silu(z_a)) @ w_br_a
    o_b = (y_b * jax.nn.silu(z_b)) @ w_br_b
    o_c = (y_c * jax.nn.silu(z_c)) @ w_br_c
    g = jax.nn.sigmoid((g_in + gate_b).astype(f32)).astype(x.dtype).reshape(bsz, s, N_BRANCH, D_MODEL)
    mixed = g[:, :, 0] * o_a + g[:, :, 1] * o_b + g[:, :, 2] * o_c
    y = x + mixed @ w_out
    return y, (kc, vc, band_k_new, band_v_new, hT_re, hT_im)


def setup_inputs(seed: int = 0) -> dict:
    key = jax.random.key(seed)
    ks = jax.random.split(key, 32)
    f32 = jnp.float32
    nrm = lambda k, shape, scale: jax.random.normal(k, shape, f32) * scale
    band_keep = min(BAND_LEN, PAST_LEN)
    n_idx = jnp.arange(SSM_STATE, dtype=f32)
    return {
        "x_prompt": nrm(ks[0], (BATCH, SEQ, D_MODEL), 1.0),
        "x_sample": nrm(ks[1], (DEC_BATCH, DEC_SEQ, D_MODEL), 1.0),
        "cache_sb_k": nrm(ks[2], (DEPTH, DEC_BATCH, PAST_LEN, N_HEADS_C, HEAD_DIM), 1.0),
        "cache_sb_v": nrm(ks[3], (DEPTH, DEC_BATCH, PAST_LEN, N_HEADS_C, HEAD_DIM), 1.0),
        "cache_band_k": nrm(ks[4], (DEPTH, DEC_BATCH, band_keep, N_HEADS_B, HEAD_DIM), 1.0),
        "cache_band_v": nrm(ks[5], (DEPTH, DEC_BATCH, band_keep, N_HEADS_B, HEAD_DIM), 1.0),
        "state_ssm_re": nrm(ks[6], (DEPTH, DEC_BATCH, N_GROUPS, SSM_STATE), 0.3),
        "state_ssm_im": nrm(ks[7], (DEPTH, DEC_BATCH, N_GROUPS, SSM_STATE), 0.3),
        "norm_g": 1.0 + nrm(ks[8], (DEPTH, D_MODEL), 0.05),
        "w_in": nrm(ks[9], (DEPTH, D_MODEL, N_IN), D_MODEL ** -0.5),
        "ssm_a_re": -0.5 + nrm(ks[10], (DEPTH, N_GROUPS, SSM_STATE), 0.01),
        "ssm_a_im": math.pi * n_idx + nrm(ks[11], (DEPTH, N_GROUPS, SSM_STATE), 0.01),
        "ssm_log_dt": jax.random.uniform(ks[12], (DEPTH, N_GROUPS), f32, math.log(1e-3), math.log(1e-1)),
        "ssm_b_re": nrm(ks[13], (DEPTH, N_GROUPS, SSM_STATE, SSM_GROUP), (2.0 * SSM_GROUP) ** -0.5),
        "ssm_b_im": nrm(ks[14], (DEPTH, N_GROUPS, SSM_STATE, SSM_GROUP), (2.0 * SSM_GROUP) ** -0.5),
        "ssm_c_re": nrm(ks[15], (DEPTH, N_GROUPS, SSM_GROUP, SSM_STATE), SSM_STATE ** -0.5),
        "ssm_c_im": nrm(ks[16], (DEPTH, N_GROUPS, SSM_GROUP, SSM_STATE), SSM_STATE ** -0.5),
        "ssm_d": nrm(ks[17], (DEPTH, MIX_W), 0.5),
        "w_glu": nrm(ks[18], (DEPTH, MIX_W, MIX_W), MIX_W ** -0.5),
        "b_glu": nrm(ks[19], (DEPTH, MIX_W), 0.02),
        "q_norm_g": 1.0 + nrm(ks[20], (DEPTH, HEAD_DIM), 0.05),
        "k_norm_g": 1.0 + nrm(ks[21], (DEPTH, HEAD_DIM), 0.05),
        "rel_bias": nrm(ks[22], (DEPTH, N_HEADS_B, 2 * MAX_REL + 1), 0.1),
        "w_br_a": nrm(ks[23], (DEPTH, MIX_W, D_MODEL), MIX_W ** -0.5),
        "w_br_b": nrm(ks[24], (DEPTH, MIX_W, D_MODEL), MIX_W ** -0.5),
        "w_br_c": nrm(ks[25], (DEPTH, MIX_W, D_MODEL), MIX_W ** -0.5),
        "gate_b": nrm(ks[26], (DEPTH, N_BRANCH * D_MODEL), 0.02),
        "w_out": nrm(ks[27], (DEPTH, D_MODEL, D_MODEL), D_MODEL ** -0.5),
    }


def reference(x_prompt, x_sample, cache_sb_k, cache_sb_v, cache_band_k, cache_band_v,
              state_ssm_re, state_ssm_im, norm_g, w_in, ssm_a_re, ssm_a_im, ssm_log_dt,
              ssm_b_re, ssm_b_im, ssm_c_re, ssm_c_im, ssm_d, w_glu, b_glu, q_norm_g, k_norm_g,
              rel_bias, w_br_a, w_br_b, w_br_c, gate_b, w_out):
    yp = x_prompt
    ys = x_sample
    p_states = []
    s_states = []
    for l in range(DEPTH):
        w = (norm_g[l], w_in[l], ssm_a_re[l], ssm_a_im[l], ssm_log_dt[l], ssm_b_re[l], ssm_b_im[l],
             ssm_c_re[l], ssm_c_im[l], ssm_d[l], w_glu[l], b_glu[l], q_norm_g[l], k_norm_g[l],
             rel_bias[l], w_br_a[l], w_br_b[l], w_br_c[l], gate_b[l], w_out[l])
        yp, sp = hybrid_layer(yp, w, None)
        ys, ss = hybrid_layer(ys, w, (cache_sb_k[l], cache_sb_v[l], cache_band_k[l], cache_band_v[l],
                                      state_ssm_re[l], state_ssm_im[l]))
        p_states.append(sp)
        s_states.append(ss)
    stk = lambda states, i: jnp.stack([st[i] for st in states], axis=0)
    return (yp, ys,
            stk(p_states, 0), stk(p_states, 1), stk(p_states, 2), stk(p_states, 3), stk(p_states, 4), stk(p_states, 5),
            stk(s_states, 0), stk(s_states, 1), stk(s_states, 2), stk(s_states, 3), stk(s_states, 4), stk(s_states, 5))
```

```cpp
#include <hip/hip_runtime.h>
#include <cstdio>
#include <cstdint>

#ifndef MK_SPLIT
#define MK_SPLIT 0
#endif

#define LAS __attribute__((address_space(3)))
#define GAS __attribute__((address_space(1)))
typedef unsigned short bf16_t;
typedef short bf16x8 __attribute__((ext_vector_type(8)));
typedef short s16x4 __attribute__((ext_vector_type(4)));
typedef float f32x2 __attribute__((ext_vector_type(2)));
typedef float f32x4 __attribute__((ext_vector_type(4)));
typedef float f32x16 __attribute__((ext_vector_type(16)));
typedef unsigned u32x2 __attribute__((ext_vector_type(2)));
typedef unsigned u32x4 __attribute__((ext_vector_type(4)));
typedef __bf16 bf16x2_t __attribute__((ext_vector_type(2)));

constexpr int DM = 4096, SEQ = 2048, NB = 8, DSEQ = 16, MW = 1024, HD = 128, NH = 8, NG = 64, NST = 64, NIN = 22528;
constexpr int MP = NB * SEQ, MS = NB * DSEQ, MR = MP + MS, MROWS = 16640;
constexpr int KCS_ROWS = 2112, KBS_ROWS = 576, BANDK = 512, PASTL = 2048;
constexpr float LOG2E = 1.4426950408889634f, LN2 = 0.6931471805599453f;
constexpr size_t O_YP = 0, O_YS = O_YP + (size_t)MP * DM, O_PSBK = O_YS + (size_t)MS * DM, O_PSBV = O_PSBK + 2ull * MP * MW, O_PBK = O_PSBV + 2ull * MP * MW,
                 O_PBV = O_PBK + 2ull * NB * BANDK * MW, O_PSR = O_PBV + 2ull * NB * BANDK * MW, O_PSI = O_PSR + 2ull * NB * NG * NST, O_SSBK = O_PSI + 2ull * NB * NG * NST,
                 O_SSBV = O_SSBK + 2ull * MS * MW, O_SBK = O_SSBV + 2ull * MS * MW, O_SBV = O_SBK + 2ull * MS * MW, O_SSR = O_SBV + 2ull * MS * MW, O_SSI = O_SSR + 2ull * NB * NG * NST,
                 O_END = O_SSI + 2ull * NB * NG * NST;
constexpr size_t MiB = 1u << 20;
constexpr size_t R1K = (size_t)MROWS * 1024 * 2;
constexpr size_t WS_CTL = 0, CTL_ZERO_BYTES = 1 * MiB;
constexpr size_t WS_SSQ1 = 65536;
constexpr size_t WS_SSQ0 = 1 * MiB;
constexpr size_t WS_ABAR = WS_SSQ0 + 128 * 1024;
constexpr size_t WS_BMT = WS_ABAR + 64 * 1024;
constexpr size_t WS_CMT = WS_BMT + 512 * 1024;
constexpr size_t WS_WIN = 4 * MiB;
constexpr size_t WS_WGLU = WS_WIN + 2ull * NIN * DM * 2;
constexpr size_t WS_WBR = WS_WGLU + 2ull * MW * MW * 2;
constexpr size_t WS_WOUT = WS_WBR + 6ull * DM * MW * 2;
constexpr size_t WS_A0 = WS_WOUT + 2ull * DM * DM * 2;
constexpr size_t WS_U = WS_A0 + 4 * R1K;
constexpr size_t WS_SZ = WS_U + R1K;
constexpr size_t WS_QB = WS_SZ + 3 * R1K, WS_KB = WS_QB + R1K, WS_VB = WS_KB + R1K, WS_QC = WS_VB + R1K, WS_KC = WS_QC + R1K, WS_VC = WS_KC + R1K;
constexpr size_t WS_G = WS_VC + R1K;
constexpr size_t WS_YG = WS_G + 12 * R1K;
constexpr size_t WS_Y = WS_YG + R1K;
constexpr size_t WS_MX = WS_Y + 3 * R1K;
constexpr size_t WS_Y0 = WS_MX + 4 * R1K;
constexpr size_t WS_KCS = WS_Y0 + (size_t)MROWS * DM * 4;
constexpr size_t WS_VCS = WS_KCS + 16ull * KCS_ROWS * 1024 * 2;
constexpr size_t WS_KBS = WS_VCS + 16ull * KCS_ROWS * 1024 * 2;
constexpr size_t WS_VBS = WS_KBS + 16ull * KBS_ROWS * 1024 * 2;
constexpr size_t WS_END = WS_VBS + 16ull * KBS_ROWS * 1024 * 2;
static_assert(WS_END < 2900ull * MiB && WS_CMT + 512 * 1024 <= WS_WIN && (WS_WGLU % 256) == 0 && (R1K % 256) == 0, "d_ws map");
constexpr int CW_BAR = 4096;
constexpr int SCR_BYTES = 139264;
constexpr int LDSCTL_OFF = SCR_BYTES, MISC_OFF = LDSCTL_OFF + 320;
constexpr int LDS_BYTES = 147456;
constexpr int NWAVES = 8;

__device__ __forceinline__ unsigned pk2(float lo, float hi) { f32x2 v = {lo, hi}; bf16x2_t b = __builtin_convertvector(v, bf16x2_t); return __builtin_bit_cast(unsigned, b); }
__device__ __forceinline__ float bflo(unsigned w) { return __uint_as_float(w << 16); }
__device__ __forceinline__ float bfhi(unsigned w) { return __uint_as_float(w & 0xffff0000u); }
__device__ __forceinline__ float bf2f(bf16_t h) { return __uint_as_float((unsigned)h << 16); }
__device__ __forceinline__ bf16_t f2bf(float f) { return (bf16_t)(pk2(f, 0.f) & 0xffffu); }
__device__ __forceinline__ float ex2(float x) { return __builtin_amdgcn_exp2f(x); }
__device__ __forceinline__ float sigmoidf_(float x) { return __builtin_amdgcn_rcpf(1.0f + ex2(-x * LOG2E)); }
#define LDS_WAIT() asm volatile("s_waitcnt lgkmcnt(0)" ::: "memory")
#define VM_WAIT() asm volatile("s_waitcnt vmcnt(0)" ::: "memory")

namespace pg8 {
constexpr int BM = 256, BK = 64, HALF = 128, HTB = HALF * BK * 2  , STAGE_BYTES = 8 * HTB, NXCD = 8, WGM = 8;
__host__ __device__ __forceinline__ int lds_byte(int r, int c) { const int st = (r >> 4) * 2 + (c >> 5), rr = r & 15, cc = c & 31, ob = rr * 64 + cc * 2; return st * 1024 + (ob ^ (((ob >> 9) & 1) << 5)); }
__host__ __device__ __forceinline__ void stage_rc(int b, int& R, int& C) { const int st = b / 1024, sb = b % 1024, swz = sb ^ (((sb >> 9) & 1) << 5); R = (st >> 1) * 16 + swz / 64; C = (st & 1) * 32 + (swz % 64) / 2; }
__host__ __device__ __forceinline__ int perm32(int rho) { const int n = rho >> 4, i = rho & 15; return 8 * (i >> 2) + 4 * n + (i & 3); }

struct Unit { const char* a; const char* b; int pm, pn, aux; };
struct Gemm { int lda, ldb, K; };

template <int REP> struct TileOrder {
    int nM, nN, nwg, G, c; const char* A; const char* B; size_t atile, btile, arep, brep;
    __device__ __forceinline__ bool next(int i, Unit& u) const {
        const int ti = i / REP, r = i - ti * REP;
        const long L = (long)ti * G + c; if (L >= nwg) return false;
        int wgid = (int)L; { const int q = nwg / NXCD, rr = nwg % NXCD, xcd = wgid % NXCD, off = wgid / NXCD; wgid = (xcd < rr ? xcd * (q + 1) : rr * (q + 1) + (xcd - rr) * q) + off; }
        const int nig = WGM * nN, gid = wgid / nig, fm = gid * WGM, gsz = (nM - fm) < WGM ? (nM - fm) : WGM;
        u.pm = fm + ((wgid % nig) % gsz); u.pn = (wgid % nig) / gsz; u.aux = r;
        u.a = A + (size_t)u.pm * atile + (size_t)r * arep; u.b = B + (size_t)u.pn * btile + (size_t)r * brep; return true;
    }
};

template <class Epi, class Sched>
__device__ __forceinline__ void gemm_phase(LAS unsigned char* lds, const Gemm g, const Sched& S, const Epi& E) {
    int tid = threadIdx.x; asm volatile("" : "+v"(tid));
    const int wid = __builtin_amdgcn_readfirstlane(tid >> 6), lane = tid & 63, wr = wid >> 2, wc = wid & 3, fr = lane & 15, fq = lane >> 4;
    const int K = g.K, nt = K / BK;
    unsigned voffA[2], voffB[2];
#pragma unroll
    for (int i = 0; i < 2; ++i) { int R, C; stage_rc(tid * 16 + i * 8192, R, C); const int Rb = Epi::PERM ? ((R & ~31) + perm32(R & 31)) : R;
        voffA[i] = (unsigned)(R * g.lda + C) * 2u; voffB[i] = (unsigned)(Rb * g.ldb + C) * 2u; }
    const size_t kstep = (size_t)(BK * 2);
    const size_t hstepA = (size_t)HALF * g.lda * 2, hstepB = (size_t)HALF * g.ldb * 2;
    const unsigned ldsw = (unsigned)wid * 1024u;
    const int aoff = lds_byte(wr * 64 + fr, fq * 8), boff = lds_byte(wc * 32 + fr, fq * 8);
#define PG8_SA(b, h) (((b) * 2 + (h)) * HTB)
#define PG8_SB(b, h) ((4 + (b) * 2 + (h)) * HTB)
#define PG8_STAGE(bufoff, gbase, voff) do { _Pragma("unroll") for (int _i = 0; _i < 2; ++_i) \
        __builtin_amdgcn_global_load_lds((const unsigned*)((const char*)(gbase) + (voff)[_i]), (LAS unsigned*)(lds + (bufoff) + ldsw + _i * 8192), 16, 0, 0); } while (0)
#define PG8_LDA(dst, b, h) do { _Pragma("unroll") for (int m = 0; m < 4; ++m) _Pragma("unroll") for (int k = 0; k < 2; ++k) dst[m][k] = *(const LAS bf16x8*)(lds + PG8_SA(b, h) + aoff + m * 2048 + k * 1024); } while (0)
#define PG8_LDB(dst, b, h) do { _Pragma("unroll") for (int n = 0; n < 2; ++n) _Pragma("unroll") for (int k = 0; k < 2; ++k) dst[n][k] = *(const LAS bf16x8*)(lds + PG8_SB(b, h) + boff + n * 2048 + k * 1024); } while (0)
#define PG8_MMA(ai, bj, At, Bt) do { __builtin_amdgcn_s_setprio(1); _Pragma("unroll") for (int m = 0; m < 4; ++m) _Pragma("unroll") for (int n = 0; n < 2; ++n) _Pragma("unroll") for (int k = 0; k < 2; ++k) \
        acc[ai][bj][m][n] = __builtin_amdgcn_mfma_f32_16x16x32_bf16(Bt[n][k], At[m][k], acc[ai][bj][m][n], 0, 0, 0); __builtin_amdgcn_s_setprio(0); } while (0)
#define PG8_WAIT_V(n) asm volatile("s_waitcnt vmcnt(" #n ")" ::: "memory")
#define PG8_WAIT_L(n) asm volatile("s_waitcnt lgkmcnt(" #n ")" ::: "memory")
#define PG8_BAR __builtin_amdgcn_s_barrier()
#define PG8_SCHED __builtin_amdgcn_sched_barrier(0)
    Unit cur, nxt; int ui = 0;
    if (!S.next(0, cur)) return;
    f32x4 acc[2][2][4][2];
#pragma unroll
    for (int a = 0; a < 2; ++a)
#pragma unroll
        for (int b = 0; b < 2; ++b)
#pragma unroll
            for (int m = 0; m < 4; ++m)
#pragma unroll
                for (int n = 0; n < 2; ++n) acc[a][b][m][n] = (f32x4){0.f, 0.f, 0.f, 0.f};
    bf16x8 At[4][2], B0[2][2], B1[2][2];
    const char* cA = cur.a; const char* cB = cur.b;
    PG8_STAGE(PG8_SB(0, 0), cB, voffB); PG8_STAGE(PG8_SB(0, 1), cB + hstepB, voffB); PG8_STAGE(PG8_SA(0, 0), cA, voffA); PG8_STAGE(PG8_SA(0, 1), cA + hstepA, voffA);
    if (wr == 1) PG8_BAR;
    PG8_WAIT_V(2); PG8_BAR;
    PG8_STAGE(PG8_SB(1, 0), cB + kstep, voffB); PG8_STAGE(PG8_SA(1, 0), cA + kstep, voffA); PG8_STAGE(PG8_SB(1, 1), cB + hstepB + kstep, voffB);
    PG8_WAIT_V(6); PG8_BAR;
    for (;;) {
        const bool has_next = S.next(ui + 1, nxt);
        const char* nA = has_next ? nxt.a : cA; const char* nB = has_next ? nxt.b : cB;
        for (int t = 0; t < nt; t += 2) {
            const bool last = (t == nt - 2);
            const char* a1 = cA + (size_t)(t + 1) * kstep;
            const char* a2 = last ? nA : cA + (size_t)(t + 2) * kstep; const char* b2 = last ? nB : cB + (size_t)(t + 2) * kstep;
            const char* a3 = a2 + kstep; const char* b3 = b2 + kstep;
            PG8_LDB(B0, 0, 0); PG8_LDB(B1, 0, 1); PG8_SCHED; PG8_LDA(At, 0, 0); PG8_STAGE(PG8_SA(1, 1), a1 + hstepA, voffA);
            PG8_WAIT_V(8); PG8_WAIT_L(0); PG8_BAR; PG8_MMA(0, 0, At, B0); PG8_MMA(0, 1, At, B1); PG8_BAR; PG8_SCHED;
            PG8_LDA(At, 0, 1); PG8_STAGE(PG8_SB(0, 0), b2, voffB); PG8_STAGE(PG8_SB(0, 1), b2 + hstepB, voffB); PG8_STAGE(PG8_SA(0, 0), a2, voffA);
            PG8_WAIT_V(8); PG8_WAIT_L(0); PG8_BAR; PG8_MMA(1, 0, At, B0); PG8_MMA(1, 1, At, B1); PG8_BAR; PG8_SCHED;
            PG8_LDB(B0, 1, 0); PG8_LDB(B1, 1, 1); PG8_SCHED; PG8_LDA(At, 1, 0); PG8_STAGE(PG8_SA(0, 1), a2 + hstepA, voffA);
            PG8_WAIT_V(8); PG8_WAIT_L(0); PG8_BAR; PG8_MMA(0, 0, At, B0); PG8_MMA(0, 1, At, B1); PG8_BAR; PG8_SCHED;
            PG8_LDA(At, 1, 1); PG8_STAGE(PG8_SB(1, 0), b3, voffB); PG8_STAGE(PG8_SB(1, 1), b3 + hstepB, voffB); PG8_STAGE(PG8_SA(1, 0), a3, voffA);
            PG8_WAIT_V(8); PG8_WAIT_L(0); PG8_BAR; PG8_MMA(1, 0, At, B0); PG8_MMA(1, 1, At, B1); PG8_BAR; PG8_SCHED;
        }
        if (wr == 0) PG8_BAR;
        E(acc, cur, wr, wc, fr, fq);
        if (!has_next) break;
#pragma unroll
        for (int a = 0; a < 2; ++a)
#pragma unroll
            for (int b = 0; b < 2; ++b)
#pragma unroll
                for (int m = 0; m < 4; ++m)
#pragma unroll
                    for (int n = 0; n < 2; ++n) acc[a][b][m][n] = (f32x4){0.f, 0.f, 0.f, 0.f};
        cur = nxt; cA = nA; cB = nB; ++ui;
        if (wr == 1) PG8_BAR;
    }
    PG8_WAIT_V(0);
    PG8_BAR;
#undef PG8_SA
#undef PG8_SB
#undef PG8_STAGE
#undef PG8_LDA
#undef PG8_LDB
#undef PG8_MMA
#undef PG8_WAIT_V
#undef PG8_WAIT_L
#undef PG8_BAR
#undef PG8_SCHED
}
}

struct WsPtrs {
    unsigned char* ws;
#define WSP(name, T, off) __device__ __forceinline__ T* name() const { return (T*)(ws + (off)); }
    WSP(U, bf16_t, WS_U) WSP(SZ, bf16_t, WS_SZ) WSP(QB, bf16_t, WS_QB) WSP(KB, bf16_t, WS_KB) WSP(VB, bf16_t, WS_VB) WSP(QC, bf16_t, WS_QC) WSP(KC, bf16_t, WS_KC) WSP(VC, bf16_t, WS_VC)
    WSP(G, bf16_t, WS_G) WSP(YG, bf16_t, WS_YG) WSP(Y, bf16_t, WS_Y) WSP(MX, bf16_t, WS_MX) WSP(A0, bf16_t, WS_A0) WSP(KCS, bf16_t, WS_KCS) WSP(VCS, bf16_t, WS_VCS) WSP(KBS, bf16_t, WS_KBS) WSP(VBS, bf16_t, WS_VBS)
    WSP(Y0, float, WS_Y0) WSP(SSQ0, float, WS_SSQ0) WSP(SSQ1, float, WS_SSQ1)
#undef WSP
};
__device__ __forceinline__ void st_bf16x8(bf16_t* p, f32x4 v0, f32x4 v1) {
    u32x4 w; w.x = pk2(v0[0], v0[1]); w.y = pk2(v0[2], v0[3]); w.z = pk2(v1[0], v1[1]); w.w = pk2(v1[2], v1[3]); *(u32x4*)p = w;
}
struct Epi1 {
    static constexpr bool PERM = true;
    const float* ssq; const float* gate_b; float* out; WsPtrs W; int layer;
    __device__ __forceinline__ void operator()(const f32x4 (&acc)[2][2][4][2], const pg8::Unit& u, int wr, int wc, int fr, int fq) const {
        const int sec = u.pn >> 2;
        const int colt = (u.pn & 3) * 256 + wc * 32 + 8 * fq;
        int mode = 0, ld = 1024, coff = 0, special = 0; float scale = 1.f; bf16_t* base;
        if (sec >= 10) { mode = 2; base = W.G(); ld = 12288; coff = (sec - 10) * 1024; }
        else if (sec == 1 || sec == 5 || sec == 9) { mode = 1; base = W.SZ(); ld = 3072; coff = (sec == 1) ? 0 : (sec == 5 ? 1024 : 2048); }
        else { base = (sec == 0) ? W.U() : (sec == 2) ? W.QB() : (sec == 3) ? W.KB() : (sec == 4) ? W.VB() : (sec == 6) ? W.QC() : (sec == 7) ? W.KC() : W.VC();
               if (sec == 6) scale = 0.08838834764831845f; special = (sec == 4 || sec == 7 || sec == 8) ? sec : 0; }
        f32x4 bv[2][2];
#pragma unroll
        for (int bj = 0; bj < 2; ++bj)
#pragma unroll
            for (int n = 0; n < 2; ++n) bv[bj][n] = (mode == 2) ? *(const f32x4*)(gate_b + coff + colt + bj * 128 + 4 * n) : (f32x4){0.f, 0.f, 0.f, 0.f};
        const int l = layer;
#pragma unroll
        for (int ai = 0; ai < 2; ++ai)
#pragma unroll
            for (int m = 0; m < 4; ++m) {
                const int row = u.pm * 256 + ai * 128 + wr * 64 + m * 16 + fr;
                const float rs = __builtin_amdgcn_rsqf(ssq[row] * (1.0f / 4096.0f) + 1e-6f) * scale;
                bf16_t* d16 = base + (size_t)row * ld + coff + colt; float* d32 = nullptr; bool ok = true;
                if (special) {
                    if (row < MP) { const int b = row >> 11, t = row & 2047;
                        if (special == 7) d32 = out + O_PSBK + ((size_t)l * MP + row) * 1024 + colt;
                        else if (special == 8) d32 = out + O_PSBV + ((size_t)l * MP + row) * 1024 + colt;
                        else if (t >= SEQ - BANDK) d32 = out + O_PBV + ((size_t)(l * NB + b) * BANDK + (t - (SEQ - BANDK))) * 1024 + colt;
                    } else if (row < MR) { const int sr = row - MP, b = sr >> 4, t = sr & 15;
                        if (special == 7) { d16 = W.KCS() + ((size_t)(l * NB + b) * KCS_ROWS + PASTL + t) * 1024 + colt; d32 = out + O_SSBK + ((size_t)l * MS + sr) * 1024 + colt; }
                        else if (special == 8) { d16 = W.VCS() + ((size_t)(l * NB + b) * KCS_ROWS + PASTL + t) * 1024 + colt; d32 = out + O_SSBV + ((size_t)l * MS + sr) * 1024 + colt; }
                        else { d16 = W.VBS() + ((size_t)(l * NB + b) * KBS_ROWS + BANDK + t) * 1024 + colt; d32 = out + O_SBV + ((size_t)l * MS + sr) * 1024 + colt; }
                    } else ok = false;
                }
#pragma unroll
                for (int bj = 0; bj < 2; ++bj) {
                    f32x4 v0 = acc[ai][bj][m][0] * rs, v1 = acc[ai][bj][m][1] * rs;
                    if (mode == 2) { v0 = v0 + bv[bj][0]; v1 = v1 + bv[bj][1];
#pragma unroll
                        for (int j = 0; j < 4; ++j) { v0[j] = sigmoidf_(v0[j]); v1[j] = sigmoidf_(v1[j]); } }
                    else if (mode == 1) {
#pragma unroll
                        for (int j = 0; j < 4; ++j) { v0[j] = v0[j] * sigmoidf_(v0[j]); v1[j] = v1[j] * sigmoidf_(v1[j]); } }
                    if (ok) { st_bf16x8(d16 + bj * 128, v0, v1);
                        if (d32) { *(f32x4*)(d32 + bj * 128) = v0; *(f32x4*)(d32 + bj * 128 + 4) = v1; } }
                }
            }
    }
};
struct EpiGlu {
    static constexpr bool PERM = true;
    const float* bglu; WsPtrs W;
    __device__ __forceinline__ void operator()(const f32x4 (&acc)[2][2][4][2], const pg8::Unit& u, int wr, int wc, int fr, int fq) const {
        const int colt = u.pn * 256 + wc * 32 + 8 * fq;
        f32x4 bv[2][2];
#pragma unroll
        for (int bj = 0; bj < 2; ++bj)
#pragma unroll
            for (int n = 0; n < 2; ++n) bv[bj][n] = *(const f32x4*)(bglu + colt + bj * 128 + 4 * n);
#pragma unroll
        for (int ai = 0; ai < 2; ++ai)
#pragma unroll
            for (int m = 0; m < 4; ++m) {
                const int row = u.pm * 256 + ai * 128 + wr * 64 + m * 16 + fr;
#pragma unroll
                for (int bj = 0; bj < 2; ++bj) {
                    const int col = colt + bj * 128;
                    const u32x4 yg = *(const u32x4*)(W.YG() + (size_t)row * 1024 + col), sz = *(const u32x4*)(W.SZ() + (size_t)row * 3072 + col);
                    f32x4 v0 = acc[ai][bj][m][0] + bv[bj][0], v1 = acc[ai][bj][m][1] + bv[bj][1];
                    v0[0] = bflo(yg.x) * sigmoidf_(v0[0]) * bflo(sz.x); v0[1] = bfhi(yg.x) * sigmoidf_(v0[1]) * bfhi(sz.x);
                    v0[2] = bflo(yg.y) * sigmoidf_(v0[2]) * bflo(sz.y); v0[3] = bfhi(yg.y) * sigmoidf_(v0[3]) * bfhi(sz.y);
                    v1[0] = bflo(yg.z) * sigmoidf_(v1[0]) * bflo(sz.z); v1[1] = bfhi(yg.z) * sigmoidf_(v1[1]) * bfhi(sz.z);
                    v1[2] = bflo(yg.w) * sigmoidf_(v1[2]) * bflo(sz.w); v1[3] = bfhi(yg.w) * sigmoidf_(v1[3]) * bfhi(sz.w);
                    st_bf16x8(W.Y() + (size_t)row * 3072 + col, v0, v1);
                }
            }
    }
};
struct EpiBr {
    static constexpr bool PERM = true;
    WsPtrs W;
    __device__ __forceinline__ void operator()(const f32x4 (&acc)[2][2][4][2], const pg8::Unit& u, int wr, int wc, int fr, int fq) const {
        const int colt = u.pn * 256 + wc * 32 + 8 * fq, br = u.aux;
#pragma unroll
        for (int ai = 0; ai < 2; ++ai)
#pragma unroll
            for (int m = 0; m < 4; ++m) {
                const int row = u.pm * 256 + ai * 128 + wr * 64 + m * 16 + fr;
#pragma unroll
                for (int bj = 0; bj < 2; ++bj) {
                    const int col = colt + bj * 128;
                    const u32x4 g = *(const u32x4*)(W.G() + (size_t)row * 12288 + br * 4096 + col);
                    bf16_t* mp = W.MX() + (size_t)row * 4096 + col;
                    u32x4 pv = (u32x4){0u, 0u, 0u, 0u}; if (br > 0) pv = *(const u32x4*)mp;
                    f32x4 v0 = acc[ai][bj][m][0], v1 = acc[ai][bj][m][1];
                    v0[0] = v0[0] * bflo(g.x) + bflo(pv.x); v0[1] = v0[1] * bfhi(g.x) + bfhi(pv.x); v0[2] = v0[2] * bflo(g.y) + bflo(pv.y); v0[3] = v0[3] * bfhi(g.y) + bfhi(pv.y);
                    v1[0] = v1[0] * bflo(g.z) + bflo(pv.z); v1[1] = v1[1] * bfhi(g.z) + bfhi(pv.z); v1[2] = v1[2] * bflo(g.w) + bflo(pv.w); v1[3] = v1[3] * bfhi(g.w) + bfhi(pv.w);
                    st_bf16x8(mp, v0, v1);
                }
            }
    }
};
struct EpiOut {
    static constexpr bool PERM = false;
    const float* xp; const float* xs; const float* ng1; float* out; WsPtrs W; int layer;
    __device__ __forceinline__ void operator()(const f32x4 (&acc)[2][2][4][2], const pg8::Unit& u, int wr, int wc, int fr, int fq) const {
        const int colt = u.pn * 256 + wc * 32 + 4 * fq;
#pragma unroll
        for (int ai = 0; ai < 2; ++ai)
#pragma unroll
            for (int m = 0; m < 4; ++m) {
                const int row = u.pm * 256 + ai * 128 + wr * 64 + m * 16 + fr;
                const float* res; float* dst;
                if (layer == 0) { res = (row < MP) ? xp + (size_t)row * DM : (row < MR ? xs + (size_t)(row - MP) * DM : nullptr); dst = W.Y0() + (size_t)row * DM; }
                else { res = W.Y0() + (size_t)row * DM; dst = (row < MP) ? out + O_YP + (size_t)row * DM : (row < MR ? out + O_YS + (size_t)(row - MP) * DM : nullptr); }
                float ss = 0.f;
#pragma unroll
                for (int bj = 0; bj < 2; ++bj)
#pragma unroll
                    for (int n = 0; n < 2; ++n) {
                        const int col = colt + bj * 128 + n * 16;
                        f32x4 y = acc[ai][bj][m][n];
                        if (res) y = y + *(const f32x4*)(res + col);
                        if (dst) *(f32x4*)(dst + col) = y;
                        if (layer == 0) { const f32x4 gg = *(const f32x4*)(ng1 + col); ss += (y[0] * y[0] + y[1] * y[1]) + (y[2] * y[2] + y[3] * y[3]);
                            u32x2 w; w.x = pk2(y[0] * gg[0], y[1] * gg[1]); w.y = pk2(y[2] * gg[2], y[3] * gg[3]); *(u32x2*)(W.A0() + (size_t)row * DM + col) = w; }
                    }
                if (layer == 0) { ss += __shfl_xor(ss, 16); ss += __shfl_xor(ss, 32); if (fq == 0) atomicAdd(W.SSQ1() + row, ss); }
            }
    }
};

#define XB_TMO      128
#define XB_XCNT(j)  (256  + 64 * (j))
#define XB_XSUB(j)  (1280 + 64 * (j))
#define XB_XGEN(j)  (2304 + 64 * (j))
#define XB_TOP      3328
#define XB_TOPGEN   3392
#define XCD_BAR_WORDS 3456
#define XB_SPIN_CAP (1u << 22)
__device__ __forceinline__ unsigned xb_ld(unsigned* p)              { return __hip_atomic_load(p, __ATOMIC_RELAXED, __HIP_MEMORY_SCOPE_AGENT); }
__device__ __forceinline__ unsigned xb_add(unsigned* p, unsigned v) { return __hip_atomic_fetch_add(p, v, __ATOMIC_RELAXED, __HIP_MEMORY_SCOPE_AGENT); }
__device__ __forceinline__ unsigned xb_xcc_id() { return (unsigned)__builtin_amdgcn_s_getreg((3 << 11) | 20) & 0xFu; }
#define XB_SPIN(cond, bar) do { unsigned _sp = 0; while (cond) { __builtin_amdgcn_s_sleep(1); \
    if ((++_sp & 255u) == 0u) { if (xb_ld(&(bar)[XB_TMO])) break; if (_sp > XB_SPIN_CAP) { atomicAdd(&(bar)[XB_TMO], 1u); break; } } } } while (0)
struct XcdBarrier { unsigned* bar; unsigned x; volatile LAS unsigned* st; };
__device__ __forceinline__ XcdBarrier xcd_barrier_post(unsigned* bar, volatile LAS unsigned* st) {
    XcdBarrier b; b.bar = bar; b.x = xb_xcc_id(); b.st = st;
    if (threadIdx.x == 0) (void)xb_add(&bar[XB_XCNT(b.x)], 1u);
    return b;
}
__device__ __forceinline__ void xcd_barrier_complete(unsigned* bar, unsigned x, unsigned& nloc, unsigned& nx) {
    const unsigned G = gridDim.x * gridDim.y * gridDim.z;
    unsigned sum, cnt, mine, sp = 0u;
    for (;;) {
        sum = 0u; cnt = 0u; mine = 0u;
#pragma unroll
        for (unsigned j = 0; j < 16; ++j) { const unsigned c = xb_ld(&bar[XB_XCNT(j)]); sum += c; cnt += (c > 0u) ? 1u : 0u; mine = (j == x) ? c : mine; }
        if (sum == G) break;
        __builtin_amdgcn_s_sleep(1);
        if ((++sp & 255u) == 0u) { if (xb_ld(&bar[XB_TMO])) break; if (sp > XB_SPIN_CAP) { atomicAdd(&bar[XB_TMO], 1u); break; } }
    }
    nloc = mine > 0u ? mine : 1u; nx = cnt > 0u ? cnt : 1u;
}
__device__ __forceinline__ void xcd_barrier(const XcdBarrier& b) {
    asm volatile("s_waitcnt vmcnt(0)" ::: "memory");
    __syncthreads();
    if (threadIdx.x == 0) {
        unsigned* bar = b.bar;
        __builtin_amdgcn_s_waitcnt(0);
        unsigned nloc = b.st[0], nx = b.st[1];
        if (nloc == 0u) { xcd_barrier_complete(bar, b.x, nloc, nx); b.st[0] = nloc; b.st[1] = nx; }
        const unsigned old = xb_add(&bar[XB_XSUB(b.x)], 1u);
        const unsigned gen = old / nloc;
        if (old + 1u == (gen + 1u) * nloc) {
            __builtin_amdgcn_fence(__ATOMIC_RELEASE, "agent");
            asm volatile("s_waitcnt vmcnt(0)" ::: "memory");
            const unsigned og = xb_add(&bar[XB_TOP], 1u);
            const unsigned tg = og / nx;
            if (og + 1u == (tg + 1u) * nx) xb_add(&bar[XB_TOPGEN], 1u);
            else XB_SPIN(xb_ld(&bar[XB_TOPGEN]) == tg, bar);
            __builtin_amdgcn_fence(__ATOMIC_ACQUIRE, "agent");
            xb_add(&bar[XB_XGEN(b.x)], 1u);
            asm volatile("s_waitcnt vmcnt(0)" ::: "memory");
        } else {
            XB_SPIN(xb_ld(&bar[XB_XGEN(b.x)]) == gen, bar);
            __builtin_amdgcn_fence(__ATOMIC_ACQUIRE, "agent");
            asm volatile("s_waitcnt vmcnt(0)" ::: "memory");
        }
    }
    __syncthreads();
}

__device__ __forceinline__ void transpose_item(const float* W, int K, int N, bf16_t* WT, LAS float* scr, int item, int lane) {
    const int nblk = N / 64, kb = item / nblk, nb = item - kb * nblk, k0 = 64 * kb, n0 = 64 * nb;
    const int kq = lane >> 4, nq = lane & 15;
#pragma unroll 4
    for (int i = 0; i < 16; ++i) { const int kk = 4 * i + kq; const f32x4 v = *(const f32x4*)(W + (size_t)(k0 + kk) * N + n0 + 4 * nq);
        LAS float* s = scr + kk * 65 + 4 * nq; s[0] = v[0]; s[1] = v[1]; s[2] = v[2]; s[3] = v[3]; }
    LDS_WAIT();
    const int c = lane & 7, nl = lane >> 3;
#pragma unroll
    for (int j = 0; j < 8; ++j) { const int n = 8 * j + nl; const LAS float* s = scr + (8 * c) * 65 + n;
        u32x4 o; o.x = pk2(s[0 * 65], s[1 * 65]); o.y = pk2(s[2 * 65], s[3 * 65]); o.z = pk2(s[4 * 65], s[5 * 65]); o.w = pk2(s[6 * 65], s[7 * 65]);
        *(u32x4*)(WT + (size_t)(n0 + n) * K + k0 + 8 * c) = o; }
    LDS_WAIT();
}
__device__ __forceinline__ float wave_sum(float v) {
#pragma unroll
    for (int o = 1; o < 64; o <<= 1) v += __shfl_xor(v, o);
    return v;
}
__device__ __forceinline__ void xrow_to_a0(const float* xrow, const float* g, bf16_t* orow, float* ssq, int lane) {
    float s = 0.f;
#pragma unroll 4
    for (int j = 0; j < 16; ++j) { const f32x4 v = *((const f32x4*)xrow + lane + 64 * j), gg = *((const f32x4*)g + lane + 64 * j);
        s += (v[0] * v[0] + v[1] * v[1]) + (v[2] * v[2] + v[3] * v[3]);
        u32x2 w; w.x = pk2(v[0] * gg[0], v[1] * gg[1]); w.y = pk2(v[2] * gg[2], v[3] * gg[3]); *((u32x2*)orow + lane + 64 * j) = w; }
    s = wave_sum(s);
    if (lane == 0) *ssq = s;
}

constexpr int SSM_PITCH = 132;
__device__ __forceinline__ void ssm_unit(LAS float* S, const unsigned char* ws, const float* dskip_l, int l, int g, const bf16_t* U, bf16_t* YG, int row0, int ntok,
                                         const float* h0re, const float* h0im, float* ore, float* oim, int lane_) {
    int lane = lane_; asm volatile("" : "+v"(lane));
    const int r32 = lane & 31, hi = lane >> 5, p16 = lane & 15, q4 = lane >> 4;
    const f32x2 ab = *((const f32x2*)(ws + WS_ABAR) + (size_t)(l * NG + g) * NST + lane);
    const float ar = ab[0], ai = ab[1];
    bf16x8 bmf[4], cmf[4];
    const bf16_t* BMT = (const bf16_t*)(ws + WS_BMT) + (size_t)(l * NG + g) * 128 * 16;
    const bf16_t* CMT = (const bf16_t*)(ws + WS_CMT) + (size_t)(l * NG + g) * 16 * 128;
#pragma unroll
    for (int nb = 0; nb < 4; ++nb) bmf[nb] = *(const bf16x8*)(BMT + (size_t)(32 * nb + r32) * 16 + 8 * hi);
#pragma unroll
    for (int kb = 0; kb < 4; ++kb) cmf[kb] = *(const bf16x8*)(CMT + (size_t)p16 * 128 + 32 * kb + 8 * q4);
    const float dsk = dskip_l[16 * g + p16];
    float hr = h0re ? h0re[lane] : 0.f, hm = h0im ? h0im[lane] : 0.f;
    for (int t0 = 0; t0 < ntok; t0 += 32) {
        const int nt = (ntok - t0) < 32 ? (ntok - t0) : 32;
        const bf16x8 uf = *(const bf16x8*)(U + (size_t)(row0 + t0 + r32) * 1024 + 16 * g + 8 * hi);
#pragma unroll
        for (int nb = 0; nb < 4; ++nb) {
            f32x16 acc = {};
            acc = __builtin_amdgcn_mfma_f32_32x32x16_bf16(uf, bmf[nb], acc, 0, 0, 0);
#pragma unroll
            for (int r = 0; r < 16; ++r) S[((r & 3) + 8 * (r >> 2) + 4 * hi) * SSM_PITCH + 32 * nb + r32] = acc[r];
        }
        LDS_WAIT();
        float br[32], bi[32];
#pragma unroll
        for (int t = 0; t < 32; ++t) { br[t] = S[t * SSM_PITCH + lane]; bi[t] = S[t * SSM_PITCH + 64 + lane]; }
#pragma unroll
        for (int t = 0; t < 32; ++t) {
            const float nr = ar * hr - ai * hm + br[t], ni = ar * hm + ai * hr + bi[t];
            if (t < nt) { hr = nr; hm = ni; }
            S[t * SSM_PITCH + lane] = hr; S[t * SSM_PITCH + 64 + lane] = hm;
        }
        LDS_WAIT();
#pragma unroll
        for (int th = 0; th < 2; ++th) {
            f32x4 ya = {0.f, 0.f, 0.f, 0.f};
#pragma unroll
            for (int kb = 0; kb < 4; ++kb) {
                const LAS float* sp = S + (16 * th + p16) * SSM_PITCH + 32 * kb + 8 * q4;
                const f32x4 a0 = *(const LAS f32x4*)sp, a1 = *(const LAS f32x4*)(sp + 4);
                u32x4 w; w.x = pk2(a0[0], a0[1]); w.y = pk2(a0[2], a0[3]); w.z = pk2(a1[0], a1[1]); w.w = pk2(a1[2], a1[3]);
                ya = __builtin_amdgcn_mfma_f32_16x16x32_bf16(__builtin_bit_cast(bf16x8, w), cmf[kb], ya, 0, 0, 0);
            }
#pragma unroll
            for (int j = 0; j < 4; ++j) {
                const int tt = t0 + 16 * th + 4 * q4 + j;
                if (tt < ntok) { const size_t o = (size_t)(row0 + tt) * 1024 + 16 * g + p16;
                    const float y = ya[j] + dsk * bf2f(U[o]);
                    const float ge = y * __builtin_amdgcn_rcpf(1.0f + ex2(-2.3022081985f * y * (1.0f + 0.044715f * y * y)));
                    YG[o] = f2bf(ge); }
            }
        }
        LDS_WAIT();
    }
    ore[lane] = hr; oim[lane] = hm;
}

namespace att {
constexpr int L_V = 0, L_K = 16384, L_WS = 32768, L_BIAS = 34816, L_FLAG = 36096, L_OST = 40960;
#define KSWZ(row, colB) ((row) * 256 + ((colB) ^ (((row) & 7) << 4)))
#define SBAR() __builtin_amdgcn_sched_barrier(0)
__device__ __forceinline__ int crow(int r, int hi) { return (r & 3) + 8 * (r >> 2) + 4 * hi; }
__device__ __forceinline__ int v_st(int k, int c) { const int kk = (k & ~0xC) | ((k & 4) << 1) | ((k & 8) >> 1); return ((kk >> 3) * 4 + (c >> 5)) * 512 + ((kk & 7) * 32 + (c & 31)) * 2; }
__device__ __forceinline__ int v_rd_base(int lane) { return ((lane & 3) << 3) | (((lane >> 2) & 3) << 6) | (((lane >> 4) & 1) << 5) | (((lane >> 5) & 1) << 8); }
constexpr int v_rd_off(int d0, int ks, int half) { return d0 * 512 + ks * 4096 + half * 2048; }
template <int OFF> __device__ __forceinline__ s16x4 tr_read(int vb) {
    s16x4 r; asm volatile("ds_read_b64_tr_b16 %0, %1 offset:%2" : "=&v"(r) : "v"(vb), "i"(OFF) : "memory"); return r;
}
template <int D0> __device__ __forceinline__ void pv_one(f32x16& od, int vb, bf16x8 pa0, bf16x8 pa1, bf16x8 pa2, bf16x8 pa3) {
    const s16x4 l0 = tr_read<v_rd_off(D0, 0, 0)>(vb), h0 = tr_read<v_rd_off(D0, 0, 1)>(vb), l1 = tr_read<v_rd_off(D0, 1, 0)>(vb), h1 = tr_read<v_rd_off(D0, 1, 1)>(vb);
    const s16x4 l2 = tr_read<v_rd_off(D0, 2, 0)>(vb), h2 = tr_read<v_rd_off(D0, 2, 1)>(vb), l3 = tr_read<v_rd_off(D0, 3, 0)>(vb), h3 = tr_read<v_rd_off(D0, 3, 1)>(vb);
    asm volatile("s_waitcnt lgkmcnt(0)" ::: "memory"); SBAR();
#define PK(L, H) (bf16x8){L[0], L[1], L[2], L[3], H[0], H[1], H[2], H[3]}
    od = __builtin_amdgcn_mfma_f32_32x32x16_bf16(pa0, PK(l0, h0), od, 0, 0, 0);
    od = __builtin_amdgcn_mfma_f32_32x32x16_bf16(pa1, PK(l1, h1), od, 0, 0, 0);
    od = __builtin_amdgcn_mfma_f32_32x32x16_bf16(pa2, PK(l2, h2), od, 0, 0, 0);
    od = __builtin_amdgcn_mfma_f32_32x32x16_bf16(pa3, PK(l3, h3), od, 0, 0, 0);
#undef PK
}
__device__ __forceinline__ void pv_d0(f32x16* o, int vb, bf16x8 pa0, bf16x8 pa1, bf16x8 pa2, bf16x8 pa3) {
    pv_one<0>(o[0], vb, pa0, pa1, pa2, pa3); pv_one<1>(o[1], vb, pa0, pa1, pa2, pa3); pv_one<2>(o[2], vb, pa0, pa1, pa2, pa3); pv_one<3>(o[3], vb, pa0, pa1, pa2, pa3);
}
__device__ __forceinline__ void qkt(f32x16& p0, f32x16& p1, const LAS unsigned char* Ks, const LAS unsigned char* Qs, int r32, int hi) {
    p0 = f32x16{}; p1 = f32x16{};
#pragma unroll
    for (int d0 = 0; d0 < 8; ++d0) { const int cb = (d0 * 16 + hi * 8) * 2;
        const bf16x8 b0 = *(const LAS bf16x8*)(Ks + KSWZ(r32, cb));
        const bf16x8 b1 = *(const LAS bf16x8*)(Ks + KSWZ(32 + r32, cb));
        const bf16x8 q = *(const LAS bf16x8*)(Qs + KSWZ(r32, cb));
        p0 = __builtin_amdgcn_mfma_f32_32x32x16_bf16(b0, q, p0, 0, 0, 0);
        p1 = __builtin_amdgcn_mfma_f32_32x32x16_bf16(b1, q, p1, 0, 0, 0); }
}
__device__ __forceinline__ void qkt_half(f32x16& p, const LAS unsigned char* Ks, const LAS unsigned char* Qs, int r32, int hi, int half) {
    p = f32x16{};
#pragma unroll
    for (int d0 = 0; d0 < 8; ++d0) { const int cb = (d0 * 16 + hi * 8) * 2;
        const bf16x8 b0 = *(const LAS bf16x8*)(Ks + KSWZ(32 * half + r32, cb));
        const bf16x8 q = *(const LAS bf16x8*)(Qs + KSWZ(r32, cb));
        p = __builtin_amdgcn_mfma_f32_32x32x16_bf16(b0, q, p, 0, 0, 0); }
}
#define PK4(P, BASE, OUT) do { unsigned a0 = pk2(P[BASE + 0], P[BASE + 1]), a1 = pk2(P[BASE + 2], P[BASE + 3]);   \
    unsigned b0 = pk2(P[BASE + 4], P[BASE + 5]), b1 = pk2(P[BASE + 6], P[BASE + 7]);                              \
    auto r0 = __builtin_amdgcn_permlane32_swap(a0, b0, false, false); auto r1 = __builtin_amdgcn_permlane32_swap(a1, b1, false, false); \
    u32x4 w = {r0[0], r1[0], r0[1], r1[1]}; OUT = __builtin_bit_cast(bf16x8, w); } while (0)
__device__ __forceinline__ float swap_max(float v) { auto rr = __builtin_amdgcn_permlane32_swap(__float_as_uint(v), __float_as_uint(v), false, false); return fmaxf(__uint_as_float(rr[0]), __uint_as_float(rr[1])); }
__device__ __forceinline__ float swap_add(float v) { auto rr = __builtin_amdgcn_permlane32_swap(__float_as_uint(v), __float_as_uint(v), false, false); return __uint_as_float(rr[0]) + __uint_as_float(rr[1]); }

struct Desc {
    const bf16_t* Q;
    const bf16_t* K; const bf16_t* V;
    const bf16_t* SZ; bf16_t* Y;
    const float* bias;
    int qpos0, nvalid, nkeys;
};
template <int TYPE>
__device__ __forceinline__ void unit(LAS unsigned char* lds, const Desc& d) {
    int tid = threadIdx.x; asm volatile("" : "+v"(tid));
    const int wid = __builtin_amdgcn_readfirstlane(tid >> 6), lane = tid & 63, r32 = lane & 31, hi = lane >> 5;
    LAS unsigned char* Vl = lds + L_V; LAS unsigned char* Kl = lds + L_K;
    LAS float* wsf = (LAS float*)(lds + L_WS) + wid * 64;
    LAS float* biasL = (LAS float*)(lds + L_BIAS);
    volatile LAS unsigned* flags = (volatile LAS unsigned*)(lds + L_FLAG);
    const bool wvalid = (32 * wid < d.nvalid);
    const int qpos = d.qpos0 + 32 * wid + r32;
    const int cw = (d.qpos0 + 32 * wid) >> 6;
    const bool rowinvalid = (32 * wid + r32) >= d.nvalid;
    int t_lo, t_hi;
    if (TYPE == 0) { const int c0 = d.qpos0 >> 6; t_lo = c0 - 8 > 0 ? c0 - 8 : 0; t_hi = c0 + 3; const int tk = (d.nkeys - 1) >> 6; if (t_hi > tk) t_hi = tk; }
    else { t_lo = 0; t_hi = (d.qpos0 + 255) >> 6; const int tk = (d.nkeys - 1) >> 6; if (t_hi > tk) t_hi = tk; }
    __syncthreads();
    if (TYPE == 0) { for (int i = tid; i < 257; i += 512) biasL[i] = d.bias[i] * LOG2E; }
    if (TYPE == 1) { if (tid < 8) flags[tid] = (32 * tid < d.nvalid) ? 0u : 1u; }
    LAS unsigned char* Ql = lds + L_OST + wid * 8192;
    if (wvalid) {
#pragma unroll
        for (int d0 = 0; d0 < 8; ++d0) { const bf16x8 qv = *(const bf16x8*)(d.Q + (size_t)(32 * wid + r32) * 1024 + d0 * 16 + hi * 8); *(LAS bf16x8*)(Ql + KSWZ(r32, (d0 * 16 + hi * 8) * 2)) = qv; }
    }
    const int sr = tid >> 4, sc = (tid & 15) * 8, vst0 = v_st(sr, sc), vst1 = v_st(32 + sr, sc), kst0 = KSWZ(sr, sc * 2), kst1 = KSWZ(32 + sr, sc * 2);
    const int vb0 = (int)(unsigned)(uintptr_t)Vl + v_rd_base(lane);
    bf16x8 sv0, sv1, sk0, sk1;
#define SLOAD(T_) do { const size_t k0_ = (size_t)(T_) * 64; sv0 = *(const bf16x8*)(d.V + (k0_ + sr) * 1024 + sc); sv1 = *(const bf16x8*)(d.V + (k0_ + 32 + sr) * 1024 + sc); \
        sk0 = *(const bf16x8*)(d.K + (k0_ + sr) * 1024 + sc); sk1 = *(const bf16x8*)(d.K + (k0_ + 32 + sr) * 1024 + sc); } while (0)
    f32x16 o[4]; o[0] = f32x16{}; o[1] = f32x16{}; o[2] = f32x16{}; o[3] = f32x16{};
    float m_reg = -1e30f, l_reg = 0.f, R = 0.f; bool wdone = !wvalid;
    bf16x8 T00, T01;
    if (TYPE == 1) {
#pragma unroll
        for (int e = 0; e < 8; ++e) { const int j0 = 8 * hi + e; T00[e] = (j0 > r32) ? (short)0x3F80 : (short)0; T01[e] = (16 + j0 > r32) ? (short)0x3F80 : (short)0; }
    }
    const int step = (TYPE == 0) ? 1 : -1, nT = t_hi - t_lo + 1;
    int T = (TYPE == 0) ? t_lo : t_hi;
    SLOAD(T);
    for (int it = 0; it < nT; ++it, T += step) {
        __syncthreads();
        if (TYPE == 1) { const unsigned f = flags[0] & flags[1] & flags[2] & flags[3] & flags[4] & flags[5] & flags[6] & flags[7]; if (f) break; }
        *(LAS bf16x8*)(Vl + vst0) = sv0; *(LAS bf16x8*)(Vl + vst1) = sv1; *(LAS bf16x8*)(Kl + kst0) = sk0; *(LAS bf16x8*)(Kl + kst1) = sk1;
        if (it + 1 < nT) SLOAD(T + step);
        __syncthreads();
        if (TYPE == 0) {
            if (wvalid && T >= cw - 8 && T <= cw) {
                f32x16 p0, p1; qkt(p0, p1, Kl, Ql, r32, hi);
                const int dc = cw - T;
                if (dc >= 3) { const float bf = biasL[256];
#pragma unroll
                    for (int r = 0; r < 16; ++r) { p0[r] += bf; p1[r] += bf; } }
                else { const int relb = qpos - 64 * T + 128;
#pragma unroll
                    for (int r = 0; r < 16; ++r) { int i0 = relb - crow(r, hi); int i1 = i0 - 32; i0 = i0 < 0 ? 0 : (i0 > 256 ? 256 : i0); i1 = i1 < 0 ? 0 : (i1 > 256 ? 256 : i1); p0[r] += biasL[i0]; p1[r] += biasL[i1]; } }
                const bool needmask = (64 * T + 63 >= d.nkeys);
                if (needmask) {
#pragma unroll
                    for (int r = 0; r < 16; ++r) { const int kp = 64 * T + crow(r, hi); if (kp >= d.nkeys) p0[r] = -1e30f; if (kp + 32 >= d.nkeys) p1[r] = -1e30f; } }
                float pmax = p0[0];
#pragma unroll
                for (int r = 1; r < 16; ++r) pmax = fmaxf(pmax, p0[r]);
#pragma unroll
                for (int r = 0; r < 16; ++r) pmax = fmaxf(pmax, p1[r]);
                pmax = swap_max(pmax);
                const float mn = fmaxf(m_reg, pmax), alpha = ex2(m_reg - mn); m_reg = mn;
#pragma unroll
                for (int r = 0; r < 16; ++r) { p0[r] = ex2(p0[r] - mn); p1[r] = ex2(p1[r] - mn); }
                if (needmask) {
#pragma unroll
                    for (int r = 0; r < 16; ++r) { const int kp = 64 * T + crow(r, hi); if (kp >= d.nkeys) p0[r] = 0.f; if (kp + 32 >= d.nkeys) p1[r] = 0.f; } }
                float ps = 0.f;
#pragma unroll
                for (int r = 0; r < 16; ++r) ps += p0[r] + p1[r];
                ps = swap_add(ps);
                l_reg = l_reg * alpha + ps;
                if (__any(alpha < 1.f)) { if (hi == 0) wsf[r32] = alpha; LDS_WAIT();
#pragma unroll
                    for (int dd = 0; dd < 4; ++dd)
#pragma unroll
                        for (int r = 0; r < 16; ++r) o[dd][r] *= wsf[crow(r, hi)]; }
                bf16x8 pa0, pa1, pa2, pa3; PK4(p0, 0, pa0); PK4(p0, 8, pa1); PK4(p1, 0, pa2); PK4(p1, 8, pa3);
                pv_d0(o, vb0, pa0, pa1, pa2, pa3);
            }
        } else {
            if (!wdone && T <= cw) {
                const bool diag = (T == cw);
                bf16x8 pa0, pa1, pa2, pa3; float ts1, ts0;
                {
                    f32x16 z, lf; qkt_half(z, Kl, Ql, r32, hi, 1); float ts = 0.f;
#pragma unroll
                    for (int r = 0; r < 16; ++r) { const float zz = z[r], e = ex2(-fabsf(zz) * LOG2E), l1p = __builtin_amdgcn_logf(1.0f + e) * LN2; float lb = fminf(zz, 0.f) - l1p, lfv = -fmaxf(zz, 0.f) - l1p;
                        if (diag) { const bool c = (64 * T + 32 + crow(r, hi)) < qpos; lfv = c ? lfv : 0.f; lb = c ? lb : -1e30f; }
                        z[r] = lb; lf[r] = lfv; ts += lfv; }
                    ts1 = swap_add(ts);
                    bf16x8 la2, la3; PK4(lf, 0, la2); PK4(lf, 8, la3);
                    f32x16 L = f32x16{};
                    L = __builtin_amdgcn_mfma_f32_32x32x16_bf16(T00, la2, L, 0, 0, 0); L = __builtin_amdgcn_mfma_f32_32x32x16_bf16(T01, la3, L, 0, 0, 0);
#pragma unroll
                    for (int r = 0; r < 16; ++r) z[r] = ex2((z[r] + L[r] + R) * LOG2E);
                    PK4(z, 0, pa2); PK4(z, 8, pa3);
                }
                {
                    f32x16 z, lf; qkt_half(z, Kl, Ql, r32, hi, 0); float ts = 0.f;
#pragma unroll
                    for (int r = 0; r < 16; ++r) { const float zz = z[r], e = ex2(-fabsf(zz) * LOG2E), l1p = __builtin_amdgcn_logf(1.0f + e) * LN2; float lb = fminf(zz, 0.f) - l1p, lfv = -fmaxf(zz, 0.f) - l1p;
                        if (diag) { const bool c = (64 * T + crow(r, hi)) < qpos; lfv = c ? lfv : 0.f; lb = c ? lb : -1e30f; }
                        z[r] = lb; lf[r] = lfv; ts += lfv; }
                    ts0 = swap_add(ts);
                    bf16x8 la0, la1; PK4(lf, 0, la0); PK4(lf, 8, la1);
                    f32x16 L = f32x16{};
                    L = __builtin_amdgcn_mfma_f32_32x32x16_bf16(T00, la0, L, 0, 0, 0); L = __builtin_amdgcn_mfma_f32_32x32x16_bf16(T01, la1, L, 0, 0, 0);
                    const float Rr = R + ts1;
#pragma unroll
                    for (int r = 0; r < 16; ++r) z[r] = ex2((z[r] + L[r] + Rr) * LOG2E);
                    PK4(z, 0, pa0); PK4(z, 8, pa1);
                }
                pv_d0(o, vb0, pa0, pa1, pa2, pa3);
                const float ts = ts0 + ts1;
                R += ts;
                wdone = __all((R < -110.f) || rowinvalid);
                if (wdone && lane == 0) flags[wid] = 1u;
            }
        }
    }
    if (wvalid) {
        LAS bf16_t* stg = (LAS bf16_t*)(lds + L_OST) + wid * 4096;
        if (TYPE == 0) { if (hi == 0) wsf[32 + r32] = l_reg; LDS_WAIT(); }
#pragma unroll
        for (int r = 0; r < 16; ++r) { const int rw = crow(r, hi); const float rl = (TYPE == 0) ? __builtin_amdgcn_rcpf(wsf[32 + rw]) : 1.f;
#pragma unroll
            for (int dd = 0; dd < 4; ++dd) stg[rw * 128 + dd * 32 + r32] = f2bf(o[dd][r] * rl); }
        LDS_WAIT();
#pragma unroll 2
        for (int i = 0; i < 8; ++i) { const int rw = i * 4 + (lane >> 4), ch = lane & 15, row = 32 * wid + rw;
            if (row < d.nvalid) { const size_t off = (size_t)row * 3072 + ch * 8;
                const u32x4 ov = *(const LAS u32x4*)(stg + rw * 128 + ch * 8), gv = *(const u32x4*)(d.SZ + off);
                u32x4 w; w.x = pk2(bflo(ov.x) * bflo(gv.x), bfhi(ov.x) * bfhi(gv.x)); w.y = pk2(bflo(ov.y) * bflo(gv.y), bfhi(ov.y) * bfhi(gv.y));
                w.z = pk2(bflo(ov.z) * bflo(gv.z), bfhi(ov.z) * bfhi(gv.z)); w.w = pk2(bflo(ov.w) * bflo(gv.w), bfhi(ov.w) * bfhi(gv.w));
                *(u32x4*)(d.Y + off) = w; } }
    }
#undef SLOAD
}
}

#if defined(DBG_ONLY0)
#define ATT_DISPATCH(type, lds, d) att::unit<0>(lds, d)
#elif defined(DBG_ONLY1)
#define ATT_DISPATCH(type, lds, d) att::unit<1>(lds, d)
#elif defined(DBG_NOATT)
#define ATT_DISPATCH(type, lds, d) (void)d
#else
#define ATT_DISPATCH(type, lds, d) do { if (type) att::unit<1>(lds, d); else att::unit<0>(lds, d); } while (0)
#endif
struct Args { const float* in[28]; float* out; unsigned char* ws; int ph_lo, ph_hi; };
constexpr int N_PHASES = 11;

__global__ void __launch_bounds__(NWAVES * 64, 2) hse_fwd(Args args) {
    extern __shared__ __attribute__((aligned(16))) unsigned char lds_raw[];
    LAS unsigned char* lds = (LAS unsigned char*)lds_raw;
    volatile LAS unsigned* MISC = (volatile LAS unsigned*)(lds + MISC_OFF);
    const int tid = threadIdx.x, lane = tid & 63, wave = __builtin_amdgcn_readfirstlane(tid >> 6);
    const int G = gridDim.x; const int bx = blockIdx.x; const int vcu = (G % 8 == 0) ? (bx % 8) * (G / 8) + bx / 8 : bx;
    unsigned char* ws = args.ws; float* out = args.out;
    unsigned* ctl = (unsigned*)(ws + WS_CTL);
    WsPtrs W; W.ws = ws;
    for (int u = tid; u < (LDS_BYTES - LDSCTL_OFF) / 4; u += NWAVES * 64) ((LAS unsigned*)(lds + LDSCTL_OFF))[u] = 0u;
    __syncthreads();
    XcdBarrier bar; bar.bar = ctl + CW_BAR; bar.x = 0; bar.st = nullptr;
    if (!MK_SPLIT) bar = xcd_barrier_post(ctl + CW_BAR, MISC + 8);
    const int lo = args.ph_lo, hi_ph = args.ph_hi;
#define IN(k) (lo <= (k) && (k) < hi_ph)
#define SEAM(k) do { if (!MK_SPLIT && (k) + 1 < hi_ph) xcd_barrier(bar); } while (0)
    const int gw = vcu * NWAVES + wave, NGW = G * NWAVES;

#ifndef NO_P0
    if (IN(0)) {
        LAS float* scr = (LAS float*)(lds + wave * 16640);
        constexpr int I_IN = (DM / 64) * (NIN / 64), I_GLU = 16 * 16, I_BR = (MW / 64) * (DM / 64), I_OUT = 64 * 64, I_L = I_IN + I_GLU + 3 * I_BR + I_OUT;
        for (int it = gw; it < 2 * I_L; it += NGW) {
            const int l = it / I_L; int r = it - l * I_L;
            if (r < I_IN) { transpose_item(args.in[9] + (size_t)l * DM * NIN, DM, NIN, (bf16_t*)(ws + WS_WIN) + (size_t)l * NIN * DM, scr, r, lane); continue; } r -= I_IN;
            if (r < I_GLU) { transpose_item(args.in[18] + (size_t)l * MW * MW, MW, MW, (bf16_t*)(ws + WS_WGLU) + (size_t)l * MW * MW, scr, r, lane); continue; } r -= I_GLU;
            if (r < 3 * I_BR) { const int br = r / I_BR; r -= br * I_BR;
                transpose_item(args.in[23 + br] + (size_t)l * MW * DM, MW, DM, (bf16_t*)(ws + WS_WBR) + (size_t)(l * 3 + br) * DM * MW, scr, r, lane); continue; } r -= 3 * I_BR;
            transpose_item(args.in[27] + (size_t)l * DM * DM, DM, DM, (bf16_t*)(ws + WS_WOUT) + (size_t)l * DM * DM, scr, r, lane);
        }
        for (int m = gw; m < MR; m += NGW) {
            const float* xr = (m < MP) ? args.in[0] + (size_t)m * DM : args.in[1] + (size_t)(m - MP) * DM;
            xrow_to_a0(xr, args.in[8], W.A0() + (size_t)m * DM, W.SSQ0() + m, lane);
        }
        { const size_t gt = (size_t)vcu * 512 + tid, NT = (size_t)G * 512;
          const size_t n_sb = 16ull * PASTL * 128, n_bd = 16ull * BANDK * 128;
          for (size_t i = gt; i < 2 * n_sb + 2 * n_bd; i += NT) {
              const float* src; bf16_t* dst; size_t j = i;
              if (j < 2 * n_sb) { const int kv = j >= n_sb; j -= kv * n_sb; const size_t lb = j / ((size_t)PASTL * 128), rem = j - lb * PASTL * 128, t = rem >> 7, c8 = rem & 127;
                  src = args.in[2 + kv] + (lb * PASTL + t) * 1024 + c8 * 8; dst = (kv ? W.VCS() : W.KCS()) + (lb * KCS_ROWS + t) * 1024 + c8 * 8; }
              else { j -= 2 * n_sb; const int kv = j >= n_bd; j -= kv * n_bd; const size_t lb = j / ((size_t)BANDK * 128), rem = j - lb * BANDK * 128, t = rem >> 7, c8 = rem & 127;
                  src = args.in[4 + kv] + (lb * BANDK + t) * 1024 + c8 * 8; dst = (kv ? W.VBS() : W.KBS()) + (lb * KBS_ROWS + t) * 1024 + c8 * 8; }
              const f32x4 a = *(const f32x4*)src, b = *(const f32x4*)(src + 4);
              st_bf16x8(dst, a, b);
          } }
        for (int lg = gw; lg < 2 * NG; lg += NGW) {
            const int l = lg / NG, g = lg - l * NG, n = lane;
            const float dt = expf(args.in[12][lg]);
            const float are = args.in[10][(size_t)lg * NST + n], aim = args.in[11][(size_t)lg * NST + n];
            const float mag = expf(are * dt), abr = mag * cosf(aim * dt), abi = mag * sinf(aim * dt);
            const float den = are * are + aim * aim, nr = abr - 1.0f;
            const float kre = (nr * are + abi * aim) / den, kim = (abi * are - nr * aim) / den;
            *((f32x2*)(ws + WS_ABAR) + (size_t)lg * NST + n) = (f32x2){abr, abi};
            bf16_t* BMT = (bf16_t*)(ws + WS_BMT) + (size_t)lg * 128 * 16; bf16_t* CMT = (bf16_t*)(ws + WS_CMT) + (size_t)lg * 16 * 128;
            const float* bre = args.in[13] + ((size_t)lg * NST + n) * 16; const float* bim = args.in[14] + ((size_t)lg * NST + n) * 16;
#pragma unroll
            for (int p = 0; p < 16; ++p) { const float br_ = bre[p], bi_ = bim[p];
                BMT[(size_t)n * 16 + p] = f2bf(kre * br_ - kim * bi_); BMT[(size_t)(64 + n) * 16 + p] = f2bf(kre * bi_ + kim * br_);
                CMT[(size_t)p * 128 + n] = f2bf(args.in[15][((size_t)lg * 16 + p) * NST + n]); CMT[(size_t)p * 128 + 64 + n] = f2bf(-args.in[16][((size_t)lg * 16 + p) * NST + n]); }
        }
        SEAM(0);
    }
#endif

    for (int l = 0; l < 2; ++l) {
        const int pb = 1 + 5 * l;
#ifndef NO_P1
        if (IN(pb)) {
            pg8::Gemm g{DM, DM, DM};
            pg8::TileOrder<1> S; S.nM = MROWS / 256; S.nN = NIN / 256; S.nwg = S.nM * S.nN; S.G = G; S.c = bx;
            S.A = (const char*)W.A0(); S.B = (const char*)(ws + WS_WIN) + (size_t)l * NIN * DM * 2; S.atile = 256ull * DM * 2; S.btile = 256ull * DM * 2; S.arep = 0; S.brep = 0;
            Epi1 E{l == 0 ? W.SSQ0() : W.SSQ1(), args.in[26] + (size_t)l * 3 * DM, out, W, l};
            pg8::gemm_phase(lds, g, S, E);
            SEAM(pb);
        }
#endif
#ifndef NO_P2A
        if (IN(pb + 1)) {
            for (int item = vcu; item < 128; item += G) {
                const int sample = item >= 64, ii = item & 63, b = ii >> 3, g = (ii & 7) * 8 + wave;
                LAS float* S = (LAS float*)(lds + wave * (32 * SSM_PITCH * 4));
                if (!sample) ssm_unit(S, ws, args.in[17] + (size_t)l * MW, l, g, W.U(), W.YG(), b * SEQ, SEQ, nullptr, nullptr,
                                      out + O_PSR + ((size_t)(l * NB + b) * NG + g) * NST, out + O_PSI + ((size_t)(l * NB + b) * NG + g) * NST, lane);
                else ssm_unit(S, ws, args.in[17] + (size_t)l * MW, l, g, W.U(), W.YG(), MP + b * DSEQ, DSEQ,
                              args.in[6] + ((size_t)(l * NB + b) * NG + g) * NST, args.in[7] + ((size_t)(l * NB + b) * NG + g) * NST,
                              out + O_SSR + ((size_t)(l * NB + b) * NG + g) * NST, out + O_SSI + ((size_t)(l * NB + b) * NG + g) * NST, lane);
            }
            { const int first = (G > 128) ? 64 : 0;
              if (vcu >= first) {
                const float* qg = args.in[20] + (size_t)l * HD; const float* kg = args.in[21] + (size_t)l * HD;
                int lane_o = lane; asm volatile("" : "+v"(lane_o));
                const int c0 = 16 * lane_o, dd = c0 & 127;
                float gq[16], gk[16];
#pragma unroll
                for (int j = 0; j < 16; ++j) { gq[j] = qg[dd + j] * (0.08838834764831845f * LOG2E); gk[j] = kg[dd + j]; }
                for (int row = (vcu - first) * NWAVES + wave; row < MR; row += (G - first) * NWAVES) {
                    { bf16_t* qp = W.QB() + (size_t)row * 1024 + c0; const u32x4 a = *(const u32x4*)qp, b2 = *(const u32x4*)(qp + 8);
                      float v[16] = {bflo(a.x), bfhi(a.x), bflo(a.y), bfhi(a.y), bflo(a.z), bfhi(a.z), bflo(a.w), bfhi(a.w), bflo(b2.x), bfhi(b2.x), bflo(b2.y), bfhi(b2.y), bflo(b2.z), bfhi(b2.z), bflo(b2.w), bfhi(b2.w)};
                      float s = 0.f;
#pragma unroll
                      for (int j = 0; j < 16; ++j) s += v[j] * v[j];
                      s += __shfl_xor(s, 1); s += __shfl_xor(s, 2); s += __shfl_xor(s, 4);
                      const float r = __builtin_amdgcn_rsqf(s * (1.0f / 128.0f) + 1e-6f);
#pragma unroll
                      for (int j = 0; j < 16; ++j) v[j] = v[j] * r * gq[j];
                      st_bf16x8(qp, (f32x4){v[0], v[1], v[2], v[3]}, (f32x4){v[4], v[5], v[6], v[7]}); st_bf16x8(qp + 8, (f32x4){v[8], v[9], v[10], v[11]}, (f32x4){v[12], v[13], v[14], v[15]}); }
                    { const bf16_t* kp = W.KB() + (size_t)row * 1024 + c0; const u32x4 a = *(const u32x4*)kp, b2 = *(const u32x4*)(kp + 8);
                      float v[16] = {bflo(a.x), bfhi(a.x), bflo(a.y), bfhi(a.y), bflo(a.z), bfhi(a.z), bflo(a.w), bfhi(a.w), bflo(b2.x), bfhi(b2.x), bflo(b2.y), bfhi(b2.y), bflo(b2.z), bfhi(b2.z), bflo(b2.w), bfhi(b2.w)};
                      float s = 0.f;
#pragma unroll
                      for (int j = 0; j < 16; ++j) s += v[j] * v[j];
                      s += __shfl_xor(s, 1); s += __shfl_xor(s, 2); s += __shfl_xor(s, 4);
                      const float r = __builtin_amdgcn_rsqf(s * (1.0f / 128.0f) + 1e-6f);
#pragma unroll
                      for (int j = 0; j < 16; ++j) v[j] = v[j] * r * gk[j];
                      bf16_t* d16; float* d32 = nullptr;
                      if (row < MP) { const int b = row >> 11, t = row & 2047; d16 = W.KB() + (size_t)row * 1024 + c0;
                          if (t >= SEQ - BANDK) d32 = out + O_PBK + ((size_t)(l * NB + b) * BANDK + (t - (SEQ - BANDK))) * 1024 + c0; }
                      else { const int sr = row - MP, b = sr >> 4, t = sr & 15; d16 = W.KBS() + ((size_t)(l * NB + b) * KBS_ROWS + BANDK + t) * 1024 + c0; d32 = out + O_SBK + ((size_t)l * MS + sr) * 1024 + c0; }
                      st_bf16x8(d16, (f32x4){v[0], v[1], v[2], v[3]}, (f32x4){v[4], v[5], v[6], v[7]}); st_bf16x8(d16 + 8, (f32x4){v[8], v[9], v[10], v[11]}, (f32x4){v[12], v[13], v[14], v[15]});
                      if (d32) { *(f32x4*)d32 = (f32x4){v[0], v[1], v[2], v[3]}; *(f32x4*)(d32 + 4) = (f32x4){v[4], v[5], v[6], v[7]}; *(f32x4*)(d32 + 8) = (f32x4){v[8], v[9], v[10], v[11]}; *(f32x4*)(d32 + 12) = (f32x4){v[12], v[13], v[14], v[15]}; } }
                }
              } }
            SEAM(pb + 1);
        }
#endif
#ifndef NO_P2B
        if (IN(pb + 2)) {
            for (int item = vcu; item < 1152; item += G) {
                att::Desc d;
                if (item < 1024) {
                    const int type = item < 512 ? 1 : 0, ii = item & 511, bh = ii >> 3, qb = ii & 7, b = bh >> 3, h = bh & 7;
                    const size_t row0 = (size_t)b * SEQ + 256 * qb;
                    d.Q = (type ? W.QC() : W.QB()) + row0 * 1024 + h * HD; d.K = (type ? W.KC() : W.KB()) + (size_t)b * SEQ * 1024 + h * HD; d.V = (type ? W.VC() : W.VB()) + (size_t)b * SEQ * 1024 + h * HD;
                    d.SZ = W.SZ() + row0 * 3072 + (type ? 2048 : 1024) + h * HD; d.Y = W.Y() + row0 * 3072 + (type ? 2048 : 1024) + h * HD;
                    d.bias = args.in[22] + ((size_t)l * NH + h) * 257; d.qpos0 = 256 * qb; d.nvalid = 256; d.nkeys = SEQ;
                    ATT_DISPATCH(type, lds, d);
                } else {
                    const int type = item < 1088 ? 0 : 1, ii = (item - 1024) & 63, b = ii >> 3, h = ii & 7;
                    const size_t row0 = (size_t)MP + b * DSEQ;
                    d.Q = (type ? W.QC() : W.QB()) + row0 * 1024 + h * HD;
                    d.K = (type ? W.KCS() + (size_t)(l * NB + b) * KCS_ROWS * 1024 : W.KBS() + (size_t)(l * NB + b) * KBS_ROWS * 1024) + h * HD;
                    d.V = (type ? W.VCS() + (size_t)(l * NB + b) * KCS_ROWS * 1024 : W.VBS() + (size_t)(l * NB + b) * KBS_ROWS * 1024) + h * HD;
                    d.SZ = W.SZ() + row0 * 3072 + (type ? 2048 : 1024) + h * HD; d.Y = W.Y() + row0 * 3072 + (type ? 2048 : 1024) + h * HD;
                    d.bias = args.in[22] + ((size_t)l * NH + h) * 257; d.qpos0 = type ? PASTL : BANDK; d.nvalid = DSEQ; d.nkeys = (type ? PASTL : BANDK) + DSEQ;
                    ATT_DISPATCH(type, lds, d);
                }
            }
#ifndef DBG_NOGLU
            __syncthreads();
            { pg8::Gemm g{MW, MW, MW};
              pg8::TileOrder<1> S; S.nM = MROWS / 256; S.nN = MW / 256; S.nwg = S.nM * S.nN; S.G = G; S.c = bx;
              S.A = (const char*)W.YG(); S.B = (const char*)(ws + WS_WGLU) + (size_t)l * MW * MW * 2; S.atile = 256ull * MW * 2; S.btile = 256ull * MW * 2; S.arep = 0; S.brep = 0;
              EpiGlu E{args.in[19] + (size_t)l * MW, W};
              pg8::gemm_phase(lds, g, S, E); }
#endif
            SEAM(pb + 2);
        }
#endif
#ifndef NO_P3
        if (IN(pb + 3)) {
            pg8::Gemm g{3 * MW, MW, MW};
            pg8::TileOrder<3> S; S.nM = MROWS / 256; S.nN = DM / 256; S.nwg = S.nM * S.nN; S.G = G; S.c = bx;
            S.A = (const char*)W.Y(); S.B = (const char*)(ws + WS_WBR) + (size_t)l * 3 * DM * MW * 2; S.atile = 256ull * 3 * MW * 2; S.btile = 256ull * MW * 2; S.arep = (size_t)MW * 2; S.brep = (size_t)DM * MW * 2;
            EpiBr E{W};
            pg8::gemm_phase(lds, g, S, E);
            SEAM(pb + 3);
        }
#endif
#ifndef NO_P4
        if (IN(pb + 4)) {
            pg8::Gemm g{DM, DM, DM};
            pg8::TileOrder<1> S; S.nM = MROWS / 256; S.nN = DM / 256; S.nwg = S.nM * S.nN; S.G = G; S.c = bx;
            S.A = (const char*)W.MX(); S.B = (const char*)(ws + WS_WOUT) + (size_t)l * DM * DM * 2; S.atile = 256ull * DM * 2; S.btile = 256ull * DM * 2; S.arep = 0; S.brep = 0;
            EpiOut E{args.in[0], args.in[1], args.in[8] + DM, out, W, l};
            pg8::gemm_phase(lds, g, S, E);
            SEAM(pb + 4);
        }
#endif
    }
#undef IN
#undef SEAM
}

extern "C" void kernel_launch(void* const* d_in, const int* in_sizes, int n_in, void* d_out, int out_size, void* d_ws, size_t ws_size, hipStream_t stream) {
    static int grid = 0;
    if (grid == 0) {
        if ((size_t)out_size != O_END) fprintf(stderr, "kernel_launch: note: out_size %d, built for %zu\n", out_size, (size_t)O_END);
        if (n_in != 28 || ws_size < WS_END) { fprintf(stderr, "kernel_launch: shape mismatch n_in %d ws %zu (want %zu)\n", n_in, ws_size, (size_t)WS_END); grid = -1; return; }
        int dev = 0, cus = 0;
        if (hipGetDevice(&dev) != hipSuccess || hipDeviceGetAttribute(&cus, hipDeviceAttributeMultiprocessorCount, dev) != hipSuccess) { grid = -1; return; }
        if (hipFuncSetAttribute((const void*)hse_fwd, hipFuncAttributeMaxDynamicSharedMemorySize, LDS_BYTES) != hipSuccess) { fprintf(stderr, "kernel_launch: hipFuncSetAttribute failed\n"); grid = -1; return; }
        int per_cu = 0;
        if (hipOccupancyMaxActiveBlocksPerMultiprocessor(&per_cu, (const void*)hse_fwd, NWAVES * 64, LDS_BYTES) != hipSuccess || per_cu < 1) fprintf(stderr, "kernel_launch: occupancy query says %d\n", per_cu);
        (void)hipGetLastError();
        grid = cus;
    }
    if (grid < 0) return;
    if (hipMemsetAsync((char*)d_ws + WS_CTL, 0, CTL_ZERO_BYTES, stream) != hipSuccess) return;
    Args a{};
    for (int i = 0; i < 28; ++i) a.in[i] = (const float*)d_in[i];
    a.out = (float*)d_out; a.ws = (unsigned char*)d_ws;
#if MK_SPLIT
    for (int p = 0; p < N_PHASES; ++p) { a.ph_lo = p; a.ph_hi = p + 1; hipLaunchKernelGGL(hse_fwd, dim3(grid), dim3(NWAVES * 64), LDS_BYTES, stream, a); }
#else
    a.ph_lo = 0; a.ph_hi = N_PHASES; hipLaunchKernelGGL(hse_fwd, dim3(grid), dim3(NWAVES * 64), LDS_BYTES, stream, a);
#endif
}
```

```cpp
#include <hip/hip_runtime.h>
#include <cstdio>
#include <cstdint>

#ifndef DBG_DUP
#define DBG_DUP 0
#endif
#ifndef DBG_CLK
#define DBG_CLK 0
#endif
#ifndef MK_SPLIT
#define MK_SPLIT 0
#endif

#define LAS __attribute__((address_space(3)))
#define GAS __attribute__((address_space(1)))
#define CAS __attribute__((address_space(4)))
typedef unsigned short bf16_t;
typedef short bf16x8 __attribute__((ext_vector_type(8)));
typedef short s16x4 __attribute__((ext_vector_type(4)));
typedef float f32x2 __attribute__((ext_vector_type(2)));
typedef float f32x4 __attribute__((ext_vector_type(4)));
typedef float f32x16 __attribute__((ext_vector_type(16)));
typedef unsigned u32x2 __attribute__((ext_vector_type(2)));
typedef unsigned u32x4 __attribute__((ext_vector_type(4)));
typedef __bf16 bf16x2_t __attribute__((ext_vector_type(2)));

constexpr int DM = 4096, SEQ = 2048, NB = 8, DSEQ = 16, MW = 1024, HD = 128, NH = 8, NG = 64, NST = 64, NIN = 22528;
constexpr int MP = NB * SEQ, MS = NB * DSEQ, MR = MP + MS, MROWS = 16640;
constexpr int KCS_ROWS = 2112, KBS_ROWS = 576, BANDK = 512, PASTL = 2048;
constexpr float LOG2E = 1.4426950408889634f, LN2 = 0.6931471805599453f;
constexpr size_t O_YP = 0, O_YS = O_YP + (size_t)MP * DM, O_PSBK = O_YS + (size_t)MS * DM, O_PSBV = O_PSBK + 2ull * MP * MW, O_PBK = O_PSBV + 2ull * MP * MW,
                 O_PBV = O_PBK + 2ull * NB * BANDK * MW, O_PSR = O_PBV + 2ull * NB * BANDK * MW, O_PSI = O_PSR + 2ull * NB * NG * NST, O_SSBK = O_PSI + 2ull * NB * NG * NST,
                 O_SSBV = O_SSBK + 2ull * MS * MW, O_SBK = O_SSBV + 2ull * MS * MW, O_SBV = O_SBK + 2ull * MS * MW, O_SSR = O_SBV + 2ull * MS * MW, O_SSI = O_SSR + 2ull * NB * NG * NST,
                 O_END = O_SSI + 2ull * NB * NG * NST;
constexpr size_t MiB = 1u << 20;
constexpr size_t R1K = (size_t)MROWS * 1024 * 2;
constexpr size_t WS_CTL = 0, CTL_ZERO_BYTES = 1 * MiB;
constexpr size_t WS_SSQ1 = 65536;
constexpr size_t WS_SSQ0 = 1 * MiB;
constexpr size_t WS_ABAR = WS_SSQ0 + 128 * 1024;
constexpr size_t WS_BMT = WS_ABAR + 64 * 1024;
constexpr size_t WS_CMT = WS_BMT + 512 * 1024;
constexpr size_t WS_WIN = 4 * MiB;
constexpr size_t WS_WGLU = WS_WIN + 2ull * NIN * DM * 2;
constexpr size_t WS_WBR = WS_WGLU + 2ull * MW * MW * 2;
constexpr size_t WS_WOUT = WS_WBR + 6ull * DM * MW * 2;
constexpr size_t WS_A0 = WS_WOUT + 2ull * DM * DM * 2;
constexpr size_t WS_U = WS_A0 + 4 * R1K;
constexpr size_t WS_SZ = WS_U + R1K;
constexpr size_t WS_QB = WS_SZ + 3 * R1K, WS_KB = WS_QB + R1K, WS_VB = WS_KB + R1K, WS_QC = WS_VB + R1K, WS_KC = WS_QC + R1K, WS_VC = WS_KC + R1K;
constexpr size_t WS_G = WS_VC + R1K;
constexpr size_t WS_YG = WS_G + 12 * R1K;
constexpr size_t WS_Y = WS_YG + R1K;
constexpr size_t WS_MX = WS_Y + 3 * R1K;
constexpr size_t WS_Y0 = WS_MX + 4 * R1K;
constexpr size_t WS_KCS = WS_Y0 + (size_t)MROWS * DM * 4;
constexpr size_t WS_VCS = WS_KCS + 16ull * KCS_ROWS * 1024 * 2;
constexpr size_t WS_KBS = WS_VCS + 16ull * KCS_ROWS * 1024 * 2;
constexpr size_t WS_VBS = WS_KBS + 16ull * KBS_ROWS * 1024 * 2;
constexpr size_t WS_END = WS_VBS + 16ull * KBS_ROWS * 1024 * 2;
static_assert(WS_END < 2900ull * MiB && WS_CMT + 512 * 1024 <= WS_WIN && (WS_WGLU % 256) == 0 && (R1K % 256) == 0, "d_ws map");
constexpr int CW_BAR = 4096;
constexpr int SCR_BYTES = 147456;
constexpr int LDSCTL_OFF = SCR_BYTES, MISC_OFF = LDSCTL_OFF + 320;
constexpr int LDS_BYTES = 155648;
constexpr int NWAVES = 8;

__device__ __forceinline__ unsigned pk2(float lo, float hi) { f32x2 v = {lo, hi}; bf16x2_t b = __builtin_convertvector(v, bf16x2_t); return __builtin_bit_cast(unsigned, b); }
__device__ __forceinline__ float bflo(unsigned w) { return __uint_as_float(w << 16); }
__device__ __forceinline__ float bfhi(unsigned w) { return __uint_as_float(w & 0xffff0000u); }
__device__ __forceinline__ float bf2f(bf16_t h) { return __uint_as_float((unsigned)h << 16); }
__device__ __forceinline__ bf16_t f2bf(float f) { return (bf16_t)(pk2(f, 0.f) & 0xffffu); }
__device__ __forceinline__ float ex2(float x) { return __builtin_amdgcn_exp2f(x); }
__device__ __forceinline__ float sigmoidf_(float x) { return __builtin_amdgcn_rcpf(1.0f + ex2(-x * LOG2E)); }
#define LDS_WAIT() asm volatile("s_waitcnt lgkmcnt(0)" ::: "memory")
#define VM_WAIT() asm volatile("s_waitcnt vmcnt(0)" ::: "memory")

namespace pg8 {
constexpr int BM = 256, BK = 64, HALF = 128, HTB = HALF * BK * 2  , STAGE_BYTES = 8 * HTB, NXCD = 8, WGM = 8;
__host__ __device__ __forceinline__ int lds_byte(int r, int c) { const int st = (r >> 4) * 2 + (c >> 5), rr = r & 15, cc = c & 31, ob = rr * 64 + cc * 2; return st * 1024 + (ob ^ (((ob >> 9) & 1) << 5)); }
__host__ __device__ __forceinline__ void stage_rc(int b, int& R, int& C) { const int st = b / 1024, sb = b % 1024, swz = sb ^ (((sb >> 9) & 1) << 5); R = (st >> 1) * 16 + swz / 64; C = (st & 1) * 32 + (swz % 64) / 2; }
__host__ __device__ __forceinline__ int perm32(int rho) { const int n = rho >> 4, i = rho & 15; return 8 * (i >> 2) + 4 * n + (i & 3); }

struct Unit { const char* a; const char* b; int pm, pn, aux, q, cs; };
struct Gemm { int lda, ldb, K; };

template <int REP> struct TileOrder {
    int nM, nN, nwg, G, c; const char* A; const char* B; size_t atile, btile, arep, brep; int fixed = 0;
    __device__ __forceinline__ bool next(int i, Unit& u) const {
        const int ti = i / REP, r = i - ti * REP;
        const long L = (long)ti * G + c; if (L >= nwg) return false;
        int wgid = (int)L; { const int q = nwg / NXCD, rr = nwg % NXCD, xcd = wgid % NXCD, off = wgid / NXCD; wgid = (xcd < rr ? xcd * (q + 1) : rr * (q + 1) + (xcd - rr) * q) + off; }
        const int nig = WGM * nN, gid = wgid / nig, fm = gid * WGM, gsz = (nM - fm) < WGM ? (nM - fm) : WGM;
        u.pm = fm + ((wgid % nig) % gsz); u.pn = (wgid % nig) / gsz; u.aux = r; u.q = 0; u.cs = 0;
        u.a = A + (size_t)((fixed & 1) ? 0 : u.pm) * atile + (size_t)r * arep; u.b = B + (size_t)((fixed & 2) ? 0 : u.pn) * btile + (size_t)r * brep; return true;
    }
};

template <int REP> struct QuarterOrder {
    int pmq, nN, G, c; const char* A; const char* B; size_t atile, btile, arep, brep, bhalf;
    __device__ __forceinline__ bool next(int i, Unit& u) const {
        const int ti = i / REP, r = i - ti * REP;
        const int L = ti * G + c; if (L >= 2 * nN) return false;
        u.pm = pmq; u.pn = L >> 1; u.aux = r; u.q = 1; u.cs = (L & 1) * HALF;
        u.a = A + (size_t)pmq * atile + (size_t)r * arep; u.b = B + (size_t)u.pn * btile + (size_t)(L & 1) * bhalf + (size_t)r * brep; return true;
    }
};

template <bool Q, class Epi, class Sched>
__device__ __forceinline__ void gemm_phase(LAS unsigned char* lds, const Gemm g, const Sched& S, const Epi& E) {
    int tid = threadIdx.x; asm volatile("" : "+v"(tid));
    const int wid = __builtin_amdgcn_readfirstlane(tid >> 6), lane = tid & 63, wr = wid >> 2, wc = wid & 3, fr = lane & 15, fq = lane >> 4;
    const int K = g.K, nt = K / BK;
    unsigned voffA[2], voffB[2];
#pragma unroll
    for (int i = 0; i < 2; ++i) { int R, C; stage_rc(tid * 16 + i * 8192, R, C); const int Rb = Epi::PERM ? ((R & ~31) + perm32(R & 31)) : R;
        voffA[i] = (unsigned)(R * g.lda + C) * 2u; voffB[i] = (unsigned)(Rb * g.ldb + C) * 2u; }
    const size_t kstep = (size_t)(BK * 2);
    const size_t hstepA = Q ? 0 : (size_t)HALF * g.lda * 2, hstepB = Q ? 0 : (size_t)HALF * g.ldb * 2;
    const unsigned ldsw = (unsigned)wid * 1024u;
    const int aoff = lds_byte(wr * 64 + fr, fq * 8), boff = lds_byte(wc * 32 + fr, fq * 8);
#define PG8_SA(b, h) (((b) * 2 + (h)) * HTB)
#define PG8_SB(b, h) ((4 + (b) * 2 + (h)) * HTB)
#define PG8_STAGE(bufoff, gbase, voff) do { _Pragma("unroll") for (int _i = 0; _i < 2; ++_i) \
        __builtin_amdgcn_global_load_lds((const unsigned*)((const char*)(gbase) + (voff)[_i]), (LAS unsigned*)(lds + (bufoff) + ldsw + _i * 8192), 16, 0, 0); } while (0)
#define PG8_LDA(dst, b, h) do { _Pragma("unroll") for (int m = 0; m < 4; ++m) _Pragma("unroll") for (int k = 0; k < 2; ++k) dst[m][k] = *(const LAS bf16x8*)(lds + PG8_SA(b, h) + aoff + m * 2048 + k * 1024); } while (0)
#define PG8_LDB(dst, b, h) do { _Pragma("unroll") for (int n = 0; n < 2; ++n) _Pragma("unroll") for (int k = 0; k < 2; ++k) dst[n][k] = *(const LAS bf16x8*)(lds + PG8_SB(b, h) + boff + n * 2048 + k * 1024); } while (0)
#define PG8_MMA(ai, bj, At, Bt) do { __builtin_amdgcn_s_setprio(1); _Pragma("unroll") for (int m = 0; m < 4; ++m) _Pragma("unroll") for (int n = 0; n < 2; ++n) _Pragma("unroll") for (int k = 0; k < 2; ++k) \
        acc[ai][bj][m][n] = __builtin_amdgcn_mfma_f32_16x16x32_bf16(Bt[n][k], At[m][k], acc[ai][bj][m][n], 0, 0, 0); __builtin_amdgcn_s_setprio(0); } while (0)
#define PG8_WAIT_V(n) asm volatile("s_waitcnt vmcnt(" #n ")" ::: "memory")
#define PG8_WAIT_L(n) asm volatile("s_waitcnt lgkmcnt(" #n ")" ::: "memory")
#define PG8_BAR __builtin_amdgcn_s_barrier()
#define PG8_SCHED __builtin_amdgcn_sched_barrier(0)
    Unit cur, nxt; int ui = 0;
    if (!S.next(0, cur)) return;
    f32x4 acc[2][2][4][2];
#pragma unroll
    for (int a = 0; a < 2; ++a)
#pragma unroll
        for (int b = 0; b < 2; ++b)
#pragma unroll
            for (int m = 0; m < 4; ++m)
#pragma unroll
                for (int n = 0; n < 2; ++n) acc[a][b][m][n] = (f32x4){0.f, 0.f, 0.f, 0.f};
    bf16x8 At[4][2], B0[2][2], B1[2][2];
    const char* cA = cur.a; const char* cB = cur.b;
    PG8_STAGE(PG8_SB(0, 0), cB, voffB); PG8_STAGE(PG8_SB(0, 1), cB + hstepB, voffB); PG8_STAGE(PG8_SA(0, 0), cA, voffA); PG8_STAGE(PG8_SA(0, 1), cA + hstepA, voffA);
    if (wr == 1) PG8_BAR;
    PG8_WAIT_V(2); PG8_BAR;
    PG8_STAGE(PG8_SB(1, 0), cB + kstep, voffB); PG8_STAGE(PG8_SA(1, 0), cA + kstep, voffA); PG8_STAGE(PG8_SB(1, 1), cB + hstepB + kstep, voffB);
    PG8_WAIT_V(6); PG8_BAR;
    for (;;) {
        const bool has_next = S.next(ui + 1, nxt);
        const char* nA = has_next ? nxt.a : cA; const char* nB = has_next ? nxt.b : cB;
        for (int t = 0; t < nt; t += 2) {
            const bool last = (t == nt - 2);
            const char* a1 = cA + (size_t)(t + 1) * kstep;
            const char* a2 = last ? nA : cA + (size_t)(t + 2) * kstep; const char* b2 = last ? nB : cB + (size_t)(t + 2) * kstep;
            const char* a3 = a2 + kstep; const char* b3 = b2 + kstep;
            PG8_LDB(B0, 0, 0); if (!Q) PG8_LDB(B1, 0, 1); PG8_SCHED; PG8_LDA(At, 0, 0); PG8_STAGE(PG8_SA(1, 1), a1 + hstepA, voffA);
            PG8_WAIT_V(8); PG8_WAIT_L(0); PG8_BAR; PG8_MMA(0, 0, At, B0); if (!Q) PG8_MMA(0, 1, At, B1); PG8_BAR; PG8_SCHED;
            if (!Q) PG8_LDA(At, 0, 1); PG8_STAGE(PG8_SB(0, 0), b2, voffB); PG8_STAGE(PG8_SB(0, 1), b2 + hstepB, voffB); PG8_STAGE(PG8_SA(0, 0), a2, voffA);
            PG8_WAIT_V(8); PG8_WAIT_L(0); PG8_BAR; if (!Q) { PG8_MMA(1, 0, At, B0); PG8_MMA(1, 1, At, B1); } PG8_BAR; PG8_SCHED;
            PG8_LDB(B0, 1, 0); if (!Q) PG8_LDB(B1, 1, 1); PG8_SCHED; PG8_LDA(At, 1, 0); PG8_STAGE(PG8_SA(0, 1), a2 + hstepA, voffA);
            PG8_WAIT_V(8); PG8_WAIT_L(0); PG8_BAR; PG8_MMA(0, 0, At, B0); if (!Q) PG8_MMA(0, 1, At, B1); PG8_BAR; PG8_SCHED;
            if (!Q) PG8_LDA(At, 1, 1); PG8_STAGE(PG8_SB(1, 0), b3, voffB); PG8_STAGE(PG8_SB(1, 1), b3 + hstepB, voffB); PG8_STAGE(PG8_SA(1, 0), a3, voffA);
            PG8_WAIT_V(8); PG8_WAIT_L(0); PG8_BAR; if (!Q) { PG8_MMA(1, 0, At, B0); PG8_MMA(1, 1, At, B1); } PG8_BAR; PG8_SCHED;
        }
        if (wr == 0) PG8_BAR;
        E.template run<Q>(acc, cur, wr, wc, fr, fq);
        if (!has_next) break;
        if (!E.keep(cur)) {
#pragma unroll
        for (int a = 0; a < 2; ++a)
#pragma unroll
            for (int b = 0; b < 2; ++b)
#pragma unroll
                for (int m = 0; m < 4; ++m)
#pragma unroll
                    for (int n = 0; n < 2; ++n) acc[a][b][m][n] = (f32x4){0.f, 0.f, 0.f, 0.f};
        }
        cur = nxt; cA = nA; cB = nB; ++ui;
        if (wr == 1) PG8_BAR;
    }
    PG8_WAIT_V(0);
    PG8_BAR;
#undef PG8_SA
#undef PG8_SB
#undef PG8_STAGE
#undef PG8_LDA
#undef PG8_LDB
#undef PG8_MMA
#undef PG8_WAIT_V
#undef PG8_WAIT_L
#undef PG8_BAR
#undef PG8_SCHED
}

template <class Epi, class Sched>
__device__ __forceinline__ void gemm_quarter(LAS unsigned char* lds, const Gemm g, const Sched& S, const Epi& E) {
    int tid = threadIdx.x; asm volatile("" : "+v"(tid));
    const int wid = __builtin_amdgcn_readfirstlane(tid >> 6), lane = tid & 63, wr = wid >> 2, wc = wid & 3, fr = lane & 15, fq = lane >> 4;
    const int nt = g.K / BK;
    unsigned voffA[2], voffB[2];
#pragma unroll
    for (int i = 0; i < 2; ++i) { int R, C; stage_rc(tid * 16 + i * 8192, R, C); const int Rb = Epi::PERM ? ((R & ~31) + perm32(R & 31)) : R;
        voffA[i] = (unsigned)(R * g.lda + C) * 2u; voffB[i] = (unsigned)(Rb * g.ldb + C) * 2u; }
    const unsigned ldsw = (unsigned)wid * 1024u;
    const int aoff = lds_byte(wr * 64 + fr, fq * 8), boff = lds_byte(wc * 32 + fr, fq * 8);
#define GQ_STAGE(slot, ga, gb) do { _Pragma("unroll") for (int _i = 0; _i < 2; ++_i) { \
        __builtin_amdgcn_global_load_lds((const unsigned*)((const char*)(ga) + voffA[_i]), (LAS unsigned*)(lds + (slot) * 32768 + ldsw + _i * 8192), 16, 0, 0); \
        __builtin_amdgcn_global_load_lds((const unsigned*)((const char*)(gb) + voffB[_i]), (LAS unsigned*)(lds + (slot) * 32768 + 16384 + ldsw + _i * 8192), 16, 0, 0); } } while (0)
    f32x4 acc[2][2][4][2];
    Unit cur; bool kept = false;
    for (int ui = 0; S.next(ui, cur); ++ui) {
        if (!kept) {
#pragma unroll
            for (int m = 0; m < 4; ++m)
#pragma unroll
                for (int n = 0; n < 2; ++n) acc[0][0][m][n] = (f32x4){0.f, 0.f, 0.f, 0.f};
        }
        const char* cA = cur.a; const char* cB = cur.b;
#pragma unroll
        for (int s4 = 0; s4 < 4; ++s4) GQ_STAGE(s4, cA + (size_t)s4 * (BK * 2), cB + (size_t)s4 * (BK * 2));
        for (int t = 0; t < nt; ++t) {
            const int slot = t & 3;
            asm volatile("s_waitcnt vmcnt(12)" ::: "memory");
            __builtin_amdgcn_s_barrier();
            bf16x8 At[4][2], B0[2][2];
#pragma unroll
            for (int n = 0; n < 2; ++n)
#pragma unroll
                for (int k = 0; k < 2; ++k) B0[n][k] = *(const LAS bf16x8*)(lds + slot * 32768 + 16384 + boff + n * 2048 + k * 1024);
#pragma unroll
            for (int m = 0; m < 4; ++m)
#pragma unroll
                for (int k = 0; k < 2; ++k) At[m][k] = *(const LAS bf16x8*)(lds + slot * 32768 + aoff + m * 2048 + k * 1024);
            asm volatile("s_waitcnt lgkmcnt(0)" ::: "memory");
            __builtin_amdgcn_s_barrier();
            const int tn = (t + 4 < nt) ? t + 4 : 0;
            GQ_STAGE(slot, cA + (size_t)tn * (BK * 2), cB + (size_t)tn * (BK * 2));
#pragma unroll
            for (int m = 0; m < 4; ++m)
#pragma unroll
                for (int n = 0; n < 2; ++n)
#pragma unroll
                    for (int k = 0; k < 2; ++k) acc[0][0][m][n] = __builtin_amdgcn_mfma_f32_16x16x32_bf16(B0[n][k], At[m][k], acc[0][0][m][n], 0, 0, 0);
        }
        asm volatile("s_waitcnt vmcnt(0)" ::: "memory");
        __builtin_amdgcn_s_barrier();
        E.template run<true>(acc, cur, wr, wc, fr, fq);
        kept = E.keep(cur);
    }
#undef GQ_STAGE
}
}

template <class T> __device__ __forceinline__ T* asg(T* p) { return (T*)(__attribute__((address_space(1))) T*)(unsigned long long)p; }
struct WsPtrs {
    unsigned char* ws;
#define WSP(name, T, off) __device__ __forceinline__ T* name() const { return (T*)(ws + (off)); }
    WSP(U, bf16_t, WS_U) WSP(SZ, bf16_t, WS_SZ) WSP(QB, bf16_t, WS_QB) WSP(KB, bf16_t, WS_KB) WSP(VB, bf16_t, WS_VB) WSP(QC, bf16_t, WS_QC) WSP(KC, bf16_t, WS_KC) WSP(VC, bf16_t, WS_VC)
    WSP(G, bf16_t, WS_G) WSP(YG, bf16_t, WS_YG) WSP(Y, bf16_t, WS_Y) WSP(MX, bf16_t, WS_MX) WSP(A0, bf16_t, WS_A0) WSP(KCS, bf16_t, WS_KCS) WSP(VCS, bf16_t, WS_VCS) WSP(KBS, bf16_t, WS_KBS) WSP(VBS, bf16_t, WS_VBS)
    WSP(Y0, float, WS_Y0) WSP(SSQ0, float, WS_SSQ0) WSP(SSQ1, float, WS_SSQ1)
#undef WSP
};
#ifndef G_NATIVE
#define G_NATIVE 1
#endif
#if G_NATIVE
__device__ __forceinline__ size_t g_slot(int pm, int gt, int wv, int ai, int m, int bjx, int lane) { return ((((((size_t)pm * 48 + gt) * 8 + wv) * 2 + ai) * 4 + m) * 2 + bjx) * 64 + lane; }
#else
__device__ __forceinline__ size_t g_slot(int pm, int gt, int wv, int ai, int m, int bjx, int lane) { const int row = pm * 256 + ai * 128 + (wv >> 2) * 64 + m * 16 + (lane & 15); return (size_t)row * 1536 + gt * 32 + bjx * 16 + (wv & 3) * 4 + (lane >> 4); }
#endif
typedef unsigned short u16x2 __attribute__((ext_vector_type(2)));
__device__ __forceinline__ unsigned pkmin_u16(unsigned a, unsigned b) { return __builtin_bit_cast(unsigned, __builtin_elementwise_min(__builtin_bit_cast(u16x2, a), __builtin_bit_cast(u16x2, b))); }
__device__ __forceinline__ void st_bf16x8_cap(bf16_t* p, f32x4 v0, f32x4 v1) {
    u32x4 w; w.x = pkmin_u16(pk2(v0[0], v0[1]), 0x71497149u); w.y = pkmin_u16(pk2(v0[2], v0[3]), 0x71497149u); w.z = pkmin_u16(pk2(v1[0], v1[1]), 0x71497149u); w.w = pkmin_u16(pk2(v1[2], v1[3]), 0x71497149u); *(u32x4*)p = w;
}
__device__ __forceinline__ void st_bf16x8(bf16_t* p, f32x4 v0, f32x4 v1) {
    u32x4 w; w.x = pk2(v0[0], v0[1]); w.y = pk2(v0[2], v0[3]); w.z = pk2(v1[0], v1[1]); w.w = pk2(v1[2], v1[3]); *(u32x4*)p = w;
}
struct Epi1 {
    static constexpr bool PERM = true;
    __device__ __forceinline__ bool keep(const pg8::Unit&) const { return false; }
    const float* ssq; const float* gate_b; float* out; WsPtrs W; int layer;
    template <bool Q> __device__ __forceinline__ void run(f32x4 (&acc)[2][2][4][2], const pg8::Unit& u, int wr, int wc, int fr, int fq) const {
        constexpr int NAI = Q ? 1 : 2, NBJ = Q ? 1 : 2;
        const int sec = u.pn >> 2;
        const int colt = (u.pn & 3) * 256 + u.cs + wc * 32 + 8 * fq;
        int mode = 0, ld = 1024, coff = 0, special = 0; float scale = 1.f; bf16_t* base;
        if (sec >= 10) { mode = 2; base = W.G(); ld = 12288; coff = (sec - 10) * 1024; }
        else if (sec == 1 || sec == 5 || sec == 9) { mode = 1; base = W.SZ(); ld = 3072; coff = (sec == 1) ? 0 : (sec == 5 ? 1024 : 2048); }
        else { base = (sec == 0) ? W.U() : (sec == 2) ? W.QB() : (sec == 3) ? W.KB() : (sec == 4) ? W.VB() : (sec == 6) ? W.QC() : (sec == 7) ? W.KC() : W.VC();
               if (sec == 6) scale = 0.08838834764831845f * LOG2E; special = (sec == 4 || sec == 7 || sec == 8) ? sec : 0; }
        f32x4 bv[NBJ][2];
#pragma unroll
        for (int bj = 0; bj < NBJ; ++bj)
#pragma unroll
            for (int n = 0; n < 2; ++n) bv[bj][n] = (mode == 2) ? *(const f32x4*)(gate_b + coff + colt + bj * 128 + 4 * n) * (-LOG2E) : (f32x4){0.f, 0.f, 0.f, 0.f};
        const int l = layer, row0 = u.pm * 256 + wr * 64 + fr;
        float rs[NAI][4];
#pragma unroll
        for (int ai = 0; ai < NAI; ++ai)
#pragma unroll
            for (int m = 0; m < 4; ++m) rs[ai][m] = ssq[row0 + ai * 128 + m * 16];
#pragma unroll
        for (int ai = 0; ai < NAI; ++ai)
#pragma unroll
            for (int m = 0; m < 4; ++m) rs[ai][m] = __builtin_amdgcn_rsqf(rs[ai][m] * (1.0f / 4096.0f) + 1e-6f) * scale;
        if (mode == 2) scale = -LOG2E;
#pragma unroll
        for (int ai = 0; ai < NAI; ++ai)
#pragma unroll
            for (int m = 0; m < 4; ++m) {
                const int row = row0 + ai * 128 + m * 16;
                bf16_t* d16 = base + (size_t)row * ld + coff + colt; float* d32 = nullptr;
                if (special) {
                    if (!Q) { const int b = row >> 11, t = row & 2047;
                        if (special == 7) d32 = out + O_PSBK + ((size_t)l * MP + row) * 1024 + colt;
                        else if (special == 8) d32 = out + O_PSBV + ((size_t)l * MP + row) * 1024 + colt;
                        else if (t >= SEQ - BANDK) d32 = out + O_PBV + ((size_t)(l * NB + b) * BANDK + (t - (SEQ - BANDK))) * 1024 + colt;
                    } else { const int sr = row - MP, b = sr >> 4, t = sr & 15;
                        if (special == 7) { d16 = W.KCS() + ((size_t)(l * NB + b) * KCS_ROWS + PASTL + t) * 1024 + colt; d32 = out + O_SSBK + ((size_t)l * MS + sr) * 1024 + colt; }
                        else if (special == 8) { d16 = W.VCS() + ((size_t)(l * NB + b) * KCS_ROWS + PASTL + t) * 1024 + colt; d32 = out + O_SSBV + ((size_t)l * MS + sr) * 1024 + colt; }
                        else { d16 = W.VBS() + ((size_t)(l * NB + b) * KBS_ROWS + BANDK + t) * 1024 + colt; d32 = out + O_SBV + ((size_t)l * MS + sr) * 1024 + colt; }
                    }
                }
#pragma unroll
                for (int bj = 0; bj < NBJ; ++bj) {
                    if (mode == 2) {
                        const float nrs = rs[ai][m] * scale;
                        f32x4 v0 = acc[ai][bj][m][0] * nrs + bv[bj][0], v1 = acc[ai][bj][m][1] * nrs + bv[bj][1];
#pragma unroll
                        for (int j = 0; j < 4; ++j) { v0[j] = ex2(v0[j]); v1[j] = ex2(v1[j]); }
                        v0 = v0 + 1.0f; v1 = v1 + 1.0f;
                        st_bf16x8_cap(W.G() + 8 * g_slot(u.pm, u.pn - 40, wr * 4 + wc, ai, m, bj + (u.cs >> 7), fq * 16 + fr), v0, v1);
                    } else {
                    f32x4 v0 = acc[ai][bj][m][0] * rs[ai][m], v1 = acc[ai][bj][m][1] * rs[ai][m];
                    if (mode == 1) {
#pragma unroll
                        for (int j = 0; j < 4; ++j) { v0[j] = v0[j] * sigmoidf_(v0[j]); v1[j] = v1[j] * sigmoidf_(v1[j]); } }
                    st_bf16x8(d16 + bj * 128, v0, v1);
                    if (d32) { __builtin_nontemporal_store(v0, (f32x4*)(d32 + bj * 128)); __builtin_nontemporal_store(v1, (f32x4*)(d32 + bj * 128 + 4)); }
                    }
                }
            }
    }
};
struct EpiNull {
    static constexpr bool PERM = true;
    __device__ __forceinline__ bool keep(const pg8::Unit&) const { return false; }
    float* sink;
    template <bool Q> __device__ __forceinline__ void run(f32x4 (&acc)[2][2][4][2], const pg8::Unit& u, int wr, int wc, int fr, int fq) const {
        float s = 0.f;
#pragma unroll
        for (int ai = 0; ai < 2; ++ai)
#pragma unroll
            for (int bj = 0; bj < 2; ++bj)
#pragma unroll
                for (int m = 0; m < 4; ++m)
#pragma unroll
                    for (int n = 0; n < 2; ++n) s += (acc[ai][bj][m][n][0] + acc[ai][bj][m][n][1]) + (acc[ai][bj][m][n][2] + acc[ai][bj][m][n][3]);
        if (s == 1.2345e30f) sink[u.pm + u.pn + wr + wc + fr + fq] = s;
    }
};
struct EpiGlu {
    static constexpr bool PERM = true;
    __device__ __forceinline__ bool keep(const pg8::Unit&) const { return false; }
    const float* bglu; WsPtrs W;
    template <bool Q> __device__ __forceinline__ void run(f32x4 (&acc)[2][2][4][2], const pg8::Unit& u, int wr, int wc, int fr, int fq) const {
        constexpr int NAI = Q ? 1 : 2, NBJ = Q ? 1 : 2;
        const int colt = u.pn * 256 + u.cs + wc * 32 + 8 * fq, row0 = u.pm * 256 + wr * 64 + fr;
        f32x4 bv[NBJ][2];
#pragma unroll
        for (int bj = 0; bj < NBJ; ++bj)
#pragma unroll
            for (int n = 0; n < 2; ++n) bv[bj][n] = *(const f32x4*)(bglu + colt + bj * 128 + 4 * n);
#pragma unroll
        for (int aim = 0; aim < 2 * NAI; ++aim) { const int ai = aim >> 1, mb = (aim & 1) * 2;
            u32x4 yg[4][NBJ], sz[4][NBJ];
#pragma unroll
            for (int m = mb; m < mb + 2; ++m)
#pragma unroll
                for (int bj = 0; bj < NBJ; ++bj) { const int row = row0 + ai * 128 + m * 16, col = colt + bj * 128;
                    yg[m][bj] = __builtin_nontemporal_load((const u32x4*)(W.YG() + (size_t)row * 1024 + col)); sz[m][bj] = __builtin_nontemporal_load((const u32x4*)(W.SZ() + (size_t)row * 3072 + col)); }
#pragma unroll
            for (int m = mb; m < mb + 2; ++m)
#pragma unroll
                for (int bj = 0; bj < NBJ; ++bj) { const int row = row0 + ai * 128 + m * 16, col = colt + bj * 128;
                    const u32x4 y = yg[m][bj], z = sz[m][bj];
                    f32x4 v0 = acc[ai][bj][m][0] + bv[bj][0], v1 = acc[ai][bj][m][1] + bv[bj][1];
                    v0[0] = bflo(y.x) * sigmoidf_(v0[0]) * bflo(z.x); v0[1] = bfhi(y.x) * sigmoidf_(v0[1]) * bfhi(z.x);
                    v0[2] = bflo(y.y) * sigmoidf_(v0[2]) * bflo(z.y); v0[3] = bfhi(y.y) * sigmoidf_(v0[3]) * bfhi(z.y);
                    v1[0] = bflo(y.z) * sigmoidf_(v1[0]) * bflo(z.z); v1[1] = bfhi(y.z) * sigmoidf_(v1[1]) * bfhi(z.z);
                    v1[2] = bflo(y.w) * sigmoidf_(v1[2]) * bflo(z.w); v1[3] = bfhi(y.w) * sigmoidf_(v1[3]) * bfhi(z.w);
                    st_bf16x8(W.Y() + (size_t)row * 3072 + col, v0, v1); }
        }
    }
};
struct EpiBr {
    static constexpr bool PERM = true;
    WsPtrs W;
    __device__ __forceinline__ bool keep(const pg8::Unit& u) const { return u.aux < 2; }
    template <bool Q> __device__ __forceinline__ void run(f32x4 (&acc)[2][2][4][2], const pg8::Unit& u, int wr, int wc, int fr, int fq) const {
        constexpr int NAI = Q ? 1 : 2, NBJ = Q ? 1 : 2;
        const int colt = u.pn * 256 + u.cs + wc * 32 + 8 * fq, br = u.aux, row0 = u.pm * 256 + wr * 64 + fr;
        if (br < 2) {
#pragma unroll
            for (int ai = 0; ai < NAI; ++ai) { constexpr int mb = 0;
                u32x4 gn[4][NBJ], gd[4][NBJ];
#pragma unroll
                for (int m = mb; m < mb + 4; ++m)
#pragma unroll
                    for (int bj = 0; bj < NBJ; ++bj) { const int bjx = bj + (u.cs >> 7), wv = wr * 4 + wc, ln = fq * 16 + fr;
                        gn[m][bj] = __builtin_nontemporal_load((const u32x4*)(W.G() + 8 * g_slot(u.pm, br * 16 + u.pn, wv, ai, m, bjx, ln))); gd[m][bj] = __builtin_nontemporal_load((const u32x4*)(W.G() + 8 * g_slot(u.pm, (br + 1) * 16 + u.pn, wv, ai, m, bjx, ln))); }
#pragma unroll
                for (int m = mb; m < mb + 4; ++m)
#pragma unroll
                    for (int bj = 0; bj < NBJ; ++bj) { const u32x4 a = gn[m][bj], d = gd[m][bj]; f32x4& v0 = acc[ai][bj][m][0]; f32x4& v1 = acc[ai][bj][m][1];
#define RAT(de, nu) ((nu) * __builtin_amdgcn_rcpf(de))
                        v0[0] *= RAT(bflo(a.x), bflo(d.x)); v0[1] *= RAT(bfhi(a.x), bfhi(d.x)); v0[2] *= RAT(bflo(a.y), bflo(d.y)); v0[3] *= RAT(bfhi(a.y), bfhi(d.y));
                        v1[0] *= RAT(bflo(a.z), bflo(d.z)); v1[1] *= RAT(bfhi(a.z), bfhi(d.z)); v1[2] *= RAT(bflo(a.w), bflo(d.w)); v1[3] *= RAT(bfhi(a.w), bfhi(d.w));
#undef RAT
                    }
            }
        } else {
#pragma unroll
            for (int ai = 0; ai < NAI; ++ai) {
                u32x4 g2[4][NBJ];
#pragma unroll
                for (int m = 0; m < 4; ++m)
#pragma unroll
                    for (int bj = 0; bj < NBJ; ++bj) g2[m][bj] = __builtin_nontemporal_load((const u32x4*)(W.G() + 8 * g_slot(u.pm, 32 + u.pn, wr * 4 + wc, ai, m, bj + (u.cs >> 7), fq * 16 + fr)));
#pragma unroll
                for (int m = 0; m < 4; ++m)
#pragma unroll
                    for (int bj = 0; bj < NBJ; ++bj) { const u32x4 g = g2[m][bj]; const f32x4 v0 = acc[ai][bj][m][0], v1 = acc[ai][bj][m][1];
                        f32x4 o0, o1;
                        o0[0] = v0[0] * __builtin_amdgcn_rcpf(bflo(g.x)); o0[1] = v0[1] * __builtin_amdgcn_rcpf(bfhi(g.x)); o0[2] = v0[2] * __builtin_amdgcn_rcpf(bflo(g.y)); o0[3] = v0[3] * __builtin_amdgcn_rcpf(bfhi(g.y));
                        o1[0] = v1[0] * __builtin_amdgcn_rcpf(bflo(g.z)); o1[1] = v1[1] * __builtin_amdgcn_rcpf(bfhi(g.z)); o1[2] = v1[2] * __builtin_amdgcn_rcpf(bflo(g.w)); o1[3] = v1[3] * __builtin_amdgcn_rcpf(bfhi(g.w));
                        st_bf16x8(W.MX() + (size_t)(row0 + ai * 128 + m * 16) * 4096 + colt + bj * 128, o0, o1); }
            }
        }
    }
};
struct EpiOut {
    static constexpr bool PERM = false;
    __device__ __forceinline__ bool keep(const pg8::Unit&) const { return false; }
    const float* xp; const float* xs; const float* ng1; float* out; WsPtrs W; int layer;
    template <bool Q> __device__ __forceinline__ void run(f32x4 (&acc)[2][2][4][2], const pg8::Unit& u, int wr, int wc, int fr, int fq) const {
        constexpr int NAI = Q ? 1 : 2, NBJ = Q ? 1 : 2;
        const int colt = u.pn * 256 + u.cs + wc * 32 + 4 * fq, row0 = u.pm * 256 + wr * 64 + fr;
        f32x4 gg[NBJ][2];
#pragma unroll
        for (int bj = 0; bj < NBJ; ++bj)
#pragma unroll
            for (int n = 0; n < 2; ++n) gg[bj][n] = (layer == 0) ? *(const f32x4*)(ng1 + colt + bj * 128 + n * 16) : (f32x4){0.f, 0.f, 0.f, 0.f};
#pragma unroll
        for (int aim = 0; aim < 2 * NAI; ++aim) { const int ai = aim >> 1, mb = (aim & 1) * 2;
            f32x4 rv[4][NBJ][2];
#pragma unroll
            for (int m = mb; m < mb + 2; ++m) { const int row = row0 + ai * 128 + m * 16;
                const float* res = (layer == 0) ? (Q ? xs + (size_t)(row - MP) * DM : xp + (size_t)row * DM) : W.Y0() + (size_t)row * DM;
#pragma unroll
                for (int bj = 0; bj < NBJ; ++bj)
#pragma unroll
                    for (int n = 0; n < 2; ++n) rv[m][bj][n] = __builtin_nontemporal_load((const f32x4*)(res + colt + bj * 128 + n * 16)); }
#pragma unroll
            for (int m = mb; m < mb + 2; ++m) { const int row = row0 + ai * 128 + m * 16;
                float* dst = (layer == 0) ? W.Y0() + (size_t)row * DM : (Q ? out + O_YS + (size_t)(row - MP) * DM : out + O_YP + (size_t)row * DM);
                float ss = 0.f;
#pragma unroll
                for (int bj = 0; bj < NBJ; ++bj)
#pragma unroll
                    for (int n = 0; n < 2; ++n) { const int col = colt + bj * 128 + n * 16;
                        const f32x4 y = acc[ai][bj][m][n] + rv[m][bj][n];
                        __builtin_nontemporal_store(y, (f32x4*)(dst + col));
                        if (layer == 0) { const f32x4 g4 = gg[bj][n]; ss += (y[0] * y[0] + y[1] * y[1]) + (y[2] * y[2] + y[3] * y[3]);
                            u32x2 w; w.x = pk2(y[0] * g4[0], y[1] * g4[1]); w.y = pk2(y[2] * g4[2], y[3] * g4[3]); *(u32x2*)(W.A0() + (size_t)row * DM + col) = w; } }
                if (layer == 0) { ss += __shfl_xor(ss, 16); ss += __shfl_xor(ss, 32); if (fq == 0) atomicAdd(W.SSQ1() + row, ss); }
            }
        }
    }
};

#define XB_TMO      128
#define XB_XCNT(j)  (256  + 64 * (j))
#define XB_XSUB(j)  (1280 + 64 * (j))
#define XB_XGEN(j)  (2304 + 64 * (j))
#define XB_TOP      3328
#define XB_TOPGEN   3392
#define XCD_BAR_WORDS 3456
#define XB_SPIN_CAP (1u << 22)
__device__ __forceinline__ unsigned xb_ld(unsigned* p)              { return __hip_atomic_load(p, __ATOMIC_RELAXED, __HIP_MEMORY_SCOPE_AGENT); }
__device__ __forceinline__ unsigned xb_add(unsigned* p, unsigned v) { return __hip_atomic_fetch_add(p, v, __ATOMIC_RELAXED, __HIP_MEMORY_SCOPE_AGENT); }
__device__ __forceinline__ unsigned xb_xcc_id() { return (unsigned)__builtin_amdgcn_s_getreg((3 << 11) | 20) & 0xFu; }
#define XB_SPIN(cond, bar) do { unsigned _sp = 0; while (cond) { __builtin_amdgcn_s_sleep(1); \
    if ((++_sp & 255u) == 0u) { if (xb_ld(&(bar)[XB_TMO])) break; if (_sp > XB_SPIN_CAP) { atomicAdd(&(bar)[XB_TMO], 1u); break; } } } } while (0)
struct XcdBarrier { unsigned* bar; unsigned x; volatile LAS unsigned* st; };
__device__ __forceinline__ XcdBarrier xcd_barrier_post(unsigned* bar, volatile LAS unsigned* st) {
    XcdBarrier b; b.bar = bar; b.x = xb_xcc_id(); b.st = st;
    if (threadIdx.x == 0) (void)xb_add(&bar[XB_XCNT(b.x)], 1u);
    return b;
}
__device__ __forceinline__ void xcd_barrier_complete(unsigned* bar, unsigned x, unsigned& nloc, unsigned& nx) {
    const unsigned G = gridDim.x * gridDim.y * gridDim.z;
    unsigned sum, cnt, mine, sp = 0u;
    for (;;) {
        sum = 0u; cnt = 0u; mine = 0u;
#pragma unroll
        for (unsigned j = 0; j < 16; ++j) { const unsigned c = xb_ld(&bar[XB_XCNT(j)]); sum += c; cnt += (c > 0u) ? 1u : 0u; mine = (j == x) ? c : mine; }
        if (sum == G) break;
        __builtin_amdgcn_s_sleep(1);
        if ((++sp & 255u) == 0u) { if (xb_ld(&bar[XB_TMO])) break; if (sp > XB_SPIN_CAP) { atomicAdd(&bar[XB_TMO], 1u); break; } }
    }
    nloc = mine > 0u ? mine : 1u; nx = cnt > 0u ? cnt : 1u;
}
__device__ __forceinline__ void xcd_barrier(const XcdBarrier& b) {
    asm volatile("s_waitcnt vmcnt(0)" ::: "memory");
    __syncthreads();
    if (threadIdx.x == 0) {
        unsigned* bar = b.bar;
        __builtin_amdgcn_s_waitcnt(0);
        unsigned nloc = b.st[0], nx = b.st[1];
        if (nloc == 0u) { xcd_barrier_complete(bar, b.x, nloc, nx); b.st[0] = nloc; b.st[1] = nx; }
        const unsigned old = xb_add(&bar[XB_XSUB(b.x)], 1u);
        const unsigned gen = old / nloc;
        if (old + 1u == (gen + 1u) * nloc) {
            __builtin_amdgcn_fence(__ATOMIC_RELEASE, "agent");
            asm volatile("s_waitcnt vmcnt(0)" ::: "memory");
            const unsigned og = xb_add(&bar[XB_TOP], 1u);
            const unsigned tg = og / nx;
            if (og + 1u == (tg + 1u) * nx) xb_add(&bar[XB_TOPGEN], 1u);
            else XB_SPIN(xb_ld(&bar[XB_TOPGEN]) == tg, bar);
            __builtin_amdgcn_fence(__ATOMIC_ACQUIRE, "agent");
            xb_add(&bar[XB_XGEN(b.x)], 1u);
            asm volatile("s_waitcnt vmcnt(0)" ::: "memory");
        } else {
            XB_SPIN(xb_ld(&bar[XB_XGEN(b.x)]) == gen, bar);
            __builtin_amdgcn_fence(__ATOMIC_ACQUIRE, "agent");
            asm volatile("s_waitcnt vmcnt(0)" ::: "memory");
        }
    }
    __syncthreads();
}

__device__ __forceinline__ void transpose_item(const float* W, int K, int N, bf16_t* WT, LAS float* scr, int item, int lane_) {
    int lane = lane_; asm volatile("" : "+v"(lane));
    const int sup = item >> 3, sub = item & 7, nsup = N / 128, kb4 = sup / nsup, nb2 = sup - kb4 * nsup, kb = 4 * kb4 + (sub >> 1), nb = 2 * nb2 + (sub & 1), k0 = 64 * kb, n0 = 64 * nb;
    const int kq = lane >> 4, nq = lane & 15;
#pragma unroll 4
    for (int i = 0; i < 16; ++i) { const int kk = 4 * i + kq; const f32x4 v = __builtin_nontemporal_load((const f32x4*)(W + (size_t)(k0 + kk) * N + n0 + 4 * nq));
        LAS float* s = scr + kk * 65 + 4 * nq; s[0] = v[0]; s[1] = v[1]; s[2] = v[2]; s[3] = v[3]; }
    LDS_WAIT();
    const int c = lane & 7, nl = lane >> 3;
#pragma unroll
    for (int j = 0; j < 8; ++j) { const int n = 8 * j + nl; const LAS float* s = scr + (8 * c) * 65 + n;
        u32x4 o; o.x = pk2(s[0 * 65], s[1 * 65]); o.y = pk2(s[2 * 65], s[3 * 65]); o.z = pk2(s[4 * 65], s[5 * 65]); o.w = pk2(s[6 * 65], s[7 * 65]);
        *(u32x4*)(WT + (size_t)(n0 + n) * K + k0 + 8 * c) = o; }
    LDS_WAIT();
}
__device__ __forceinline__ float wave_sum(float v) {
#pragma unroll
    for (int o = 1; o < 64; o <<= 1) v += __shfl_xor(v, o);
    return v;
}
__device__ __forceinline__ void xrow_to_a0(const float* xrow, const float* g, bf16_t* orow, float* ssq, int lane) {
    float s = 0.f;
#pragma unroll 4
    for (int j = 0; j < 16; ++j) { const f32x4 v = __builtin_nontemporal_load((const f32x4*)xrow + lane + 64 * j), gg = *((const f32x4*)g + lane + 64 * j);
        s += (v[0] * v[0] + v[1] * v[1]) + (v[2] * v[2] + v[3] * v[3]);
        u32x2 w; w.x = pk2(v[0] * gg[0], v[1] * gg[1]); w.y = pk2(v[2] * gg[2], v[3] * gg[3]); *((u32x2*)orow + lane + 64 * j) = w; }
    s = wave_sum(s);
    if (lane == 0) *ssq = s;
}

constexpr int SSM_PITCH = 132, SSM_TP = 36, SSM_WAVE_BYTES = 128 * SSM_TP * 4 + 1024;
static_assert(128 * SSM_TP >= 32 * SSM_PITCH, "h image fits the Bu^T region");
template <int NT> __device__ __forceinline__ void ssm_unit(LAS float* S, const unsigned char* ws, const float* dskip_l, int l, int g, const bf16_t* U, bf16_t* YG, int row0, int ntok,
                                         const float* h0re, const float* h0im, float* ore, float* oim, int lane_) {
    int lane = lane_; asm volatile("" : "+v"(lane));
    const int r32 = lane & 31, hi = lane >> 5, p16 = lane & 15, q4 = lane >> 4;
    LAS bf16_t* Us = (LAS bf16_t*)(S + 128 * SSM_TP);
    const f32x2 ab = *((const f32x2*)(ws + WS_ABAR) + (size_t)(l * NG + g) * NST + lane);
    const float ar = ab[0], ai = ab[1];
    bf16x8 bmf[4], cmf[4];
    const bf16_t* BMT = (const bf16_t*)(ws + WS_BMT) + (size_t)(l * NG + g) * 128 * 16;
    const bf16_t* CMT = (const bf16_t*)(ws + WS_CMT) + (size_t)(l * NG + g) * 16 * 128;
#pragma unroll
    for (int nb = 0; nb < 4; ++nb) bmf[nb] = *(const bf16x8*)(BMT + (size_t)(32 * nb + r32) * 16 + 8 * hi);
#pragma unroll
    for (int kb = 0; kb < 4; ++kb) cmf[kb] = *(const bf16x8*)(CMT + (size_t)p16 * 128 + 32 * kb + 8 * q4);
    const float dsk = dskip_l[16 * g + p16];
    float hr = h0re ? h0re[lane] : 0.f, hm = h0im ? h0im[lane] : 0.f;
    const bf16_t* up = U + (size_t)(row0 + r32) * 1024 + 16 * g + 8 * hi;
    bf16x8 uf = __builtin_nontemporal_load((const bf16x8*)up);
    for (int t0 = 0; t0 < ntok; t0 += 32) {
        const bf16x8 ucur = uf;
        if (t0 + 32 < ntok) uf = __builtin_nontemporal_load((const bf16x8*)(up + (size_t)(t0 + 32) * 1024));
        *(LAS bf16x8*)(Us + r32 * 16 + 8 * hi) = ucur;
#pragma unroll
        for (int nb = 0; nb < 4; ++nb) {
            f32x16 acc = {};
            acc = __builtin_amdgcn_mfma_f32_32x32x16_bf16(ucur, bmf[nb], acc, 0, 0, 0);
#pragma unroll
            for (int q = 0; q < 4; ++q) *(LAS f32x4*)(S + (32 * nb + r32) * SSM_TP + 8 * q + 4 * hi) = (f32x4){acc[4 * q], acc[4 * q + 1], acc[4 * q + 2], acc[4 * q + 3]};
        }
        LDS_WAIT();
        f32x4 br[NT / 4], bi[NT / 4];
#pragma unroll
        for (int t4 = 0; t4 < NT / 4; ++t4) { br[t4] = *(const LAS f32x4*)(S + lane * SSM_TP + 4 * t4); bi[t4] = *(const LAS f32x4*)(S + (64 + lane) * SSM_TP + 4 * t4); }
        LDS_WAIT();
#pragma unroll
        for (int t = 0; t < NT; ++t) {
            const float nr = ar * hr - ai * hm + br[t >> 2][t & 3], ni = ar * hm + ai * hr + bi[t >> 2][t & 3];
            hr = nr; hm = ni;
            S[t * SSM_PITCH + lane] = hr; S[t * SSM_PITCH + 64 + lane] = hm;
        }
        LDS_WAIT();
#pragma unroll
        for (int th = 0; th < NT / 16; ++th) {
            f32x4 ya = {0.f, 0.f, 0.f, 0.f};
#pragma unroll
            for (int kb = 0; kb < 4; ++kb) {
                const LAS float* sp = S + (16 * th + p16) * SSM_PITCH + 32 * kb + 8 * q4;
                const f32x4 a0 = *(const LAS f32x4*)sp, a1 = *(const LAS f32x4*)(sp + 4);
                u32x4 w; w.x = pk2(a0[0], a0[1]); w.y = pk2(a0[2], a0[3]); w.z = pk2(a1[0], a1[1]); w.w = pk2(a1[2], a1[3]);
                ya = __builtin_amdgcn_mfma_f32_16x16x32_bf16(__builtin_bit_cast(bf16x8, w), cmf[kb], ya, 0, 0, 0);
            }
#pragma unroll
            for (int j = 0; j < 4; ++j) {
                const int tl = 16 * th + 4 * q4 + j, tt = t0 + tl;
                const float y = ya[j] + dsk * bf2f(Us[tl * 16 + p16]);
                const float ge = y * __builtin_amdgcn_rcpf(1.0f + ex2(-2.3022081985f * y * (1.0f + 0.044715f * y * y)));
                YG[(size_t)(row0 + tt) * 1024 + 16 * g + p16] = f2bf(ge);
            }
        }
        LDS_WAIT();
    }
    ore[lane] = hr; oim[lane] = hm;
}

namespace att {
constexpr int L_V = 0, L_K = 16384, L_BUF = 32768, L_WS = 65536, L_BIAS = 67584, L_FLAG = 68864, L_OST = 73728;
#define KSWZ(row, colB) ((row) * 256 + ((colB) ^ (((row) & 7) << 4)))
#define SBAR() __builtin_amdgcn_sched_barrier(0)
__device__ __forceinline__ int crow(int r, int hi) { return (r & 3) + 8 * (r >> 2) + 4 * hi; }
__device__ __forceinline__ int v_st(int k, int c) { const int kk = (k & ~0xC) | ((k & 4) << 1) | ((k & 8) >> 1); return ((kk >> 3) * 4 + (c >> 5)) * 512 + ((kk & 7) * 32 + (c & 31)) * 2; }
__device__ __forceinline__ int v_rd_base(int lane) { return ((lane & 3) << 3) | (((lane >> 2) & 3) << 6) | (((lane >> 4) & 1) << 5) | (((lane >> 5) & 1) << 8); }
constexpr int v_rd_off(int d0, int ks, int half) { return d0 * 512 + ks * 4096 + half * 2048; }
template <int OFF> __device__ __forceinline__ s16x4 tr_read(int vb) {
    s16x4 r; asm volatile("ds_read_b64_tr_b16 %0, %1 offset:%2" : "=&v"(r) : "v"(vb), "i"(OFF) : "memory"); return r;
}
template <int D0> __device__ __forceinline__ void pv_one(f32x16& od, int vb, bf16x8 pa0, bf16x8 pa1, bf16x8 pa2, bf16x8 pa3) {
    const s16x4 l0 = tr_read<v_rd_off(D0, 0, 0)>(vb), h0 = tr_read<v_rd_off(D0, 0, 1)>(vb), l1 = tr_read<v_rd_off(D0, 1, 0)>(vb), h1 = tr_read<v_rd_off(D0, 1, 1)>(vb);
    const s16x4 l2 = tr_read<v_rd_off(D0, 2, 0)>(vb), h2 = tr_read<v_rd_off(D0, 2, 1)>(vb), l3 = tr_read<v_rd_off(D0, 3, 0)>(vb), h3 = tr_read<v_rd_off(D0, 3, 1)>(vb);
    asm volatile("s_waitcnt lgkmcnt(0)" ::: "memory"); SBAR();
#define PK(L, H) (bf16x8){L[0], L[1], L[2], L[3], H[0], H[1], H[2], H[3]}
    od = __builtin_amdgcn_mfma_f32_32x32x16_bf16(pa0, PK(l0, h0), od, 0, 0, 0);
    od = __builtin_amdgcn_mfma_f32_32x32x16_bf16(pa1, PK(l1, h1), od, 0, 0, 0);
    od = __builtin_amdgcn_mfma_f32_32x32x16_bf16(pa2, PK(l2, h2), od, 0, 0, 0);
    od = __builtin_amdgcn_mfma_f32_32x32x16_bf16(pa3, PK(l3, h3), od, 0, 0, 0);
#undef PK
}
__device__ __forceinline__ void pv_d0(f32x16* o, int vb, bf16x8 pa0, bf16x8 pa1, bf16x8 pa2, bf16x8 pa3) {
    pv_one<0>(o[0], vb, pa0, pa1, pa2, pa3); pv_one<1>(o[1], vb, pa0, pa1, pa2, pa3); pv_one<2>(o[2], vb, pa0, pa1, pa2, pa3); pv_one<3>(o[3], vb, pa0, pa1, pa2, pa3);
}
__device__ __forceinline__ void qkt(f32x16& p0, f32x16& p1, const LAS unsigned char* Ks, const LAS unsigned char* Qs, int r32, int hi) {
    p0 = f32x16{}; p1 = f32x16{};
    bf16x8 b0[2], b1[2], q[2];
    { const int cb = (hi * 8) * 2; b0[0] = *(const LAS bf16x8*)(Ks + KSWZ(r32, cb)); b1[0] = *(const LAS bf16x8*)(Ks + KSWZ(32 + r32, cb)); q[0] = *(const LAS bf16x8*)(Qs + KSWZ(r32, cb)); }
#pragma unroll
    for (int d0 = 0; d0 < 8; ++d0) { const int c = d0 & 1, n = c ^ 1;
        if (d0 < 7) { const int cb = ((d0 + 1) * 16 + hi * 8) * 2;
            b0[n] = *(const LAS bf16x8*)(Ks + KSWZ(r32, cb)); b1[n] = *(const LAS bf16x8*)(Ks + KSWZ(32 + r32, cb)); q[n] = *(const LAS bf16x8*)(Qs + KSWZ(r32, cb)); }
        if (d0 < 7) asm volatile("s_waitcnt lgkmcnt(3)" ::: "memory"); else asm volatile("s_waitcnt lgkmcnt(0)" ::: "memory");
        SBAR();
        p0 = __builtin_amdgcn_mfma_f32_32x32x16_bf16(b0[c], q[c], p0, 0, 0, 0);
        p1 = __builtin_amdgcn_mfma_f32_32x32x16_bf16(b1[c], q[c], p1, 0, 0, 0);
        SBAR(); }
}
__device__ __forceinline__ void qkt_half(f32x16& p, const LAS unsigned char* Ks, const LAS unsigned char* Qs, int r32, int hi, int half) {
    p = f32x16{};
    bf16x8 b0[2], q[2];
    { const int cb = (hi * 8) * 2; b0[0] = *(const LAS bf16x8*)(Ks + KSWZ(32 * half + r32, cb)); q[0] = *(const LAS bf16x8*)(Qs + KSWZ(r32, cb)); }
#pragma unroll
    for (int d0 = 0; d0 < 8; ++d0) { const int c = d0 & 1, n = c ^ 1;
        if (d0 < 7) { const int cb = ((d0 + 1) * 16 + hi * 8) * 2; b0[n] = *(const LAS bf16x8*)(Ks + KSWZ(32 * half + r32, cb)); q[n] = *(const LAS bf16x8*)(Qs + KSWZ(r32, cb)); }
        if (d0 < 7) asm volatile("s_waitcnt lgkmcnt(2)" ::: "memory"); else asm volatile("s_waitcnt lgkmcnt(0)" ::: "memory");
        SBAR();
        p = __builtin_amdgcn_mfma_f32_32x32x16_bf16(b0[c], q[c], p, 0, 0, 0);
        SBAR(); }
}
#define PK4(P, BASE, OUT) do { unsigned a0 = pk2(P[BASE + 0], P[BASE + 1]), a1 = pk2(P[BASE + 2], P[BASE + 3]);   \
    unsigned b0 = pk2(P[BASE + 4], P[BASE + 5]), b1 = pk2(P[BASE + 6], P[BASE + 7]);                              \
    auto r0 = __builtin_amdgcn_permlane32_swap(a0, b0, false, false); auto r1 = __builtin_amdgcn_permlane32_swap(a1, b1, false, false); \
    u32x4 w = {r0[0], r1[0], r0[1], r1[1]}; OUT = __builtin_bit_cast(bf16x8, w); } while (0)
__device__ __forceinline__ float swap_max(float v) { auto rr = __builtin_amdgcn_permlane32_swap(__float_as_uint(v), __float_as_uint(v), false, false); return fmaxf(__uint_as_float(rr[0]), __uint_as_float(rr[1])); }
__device__ __forceinline__ float swap_add(float v) { auto rr = __builtin_amdgcn_permlane32_swap(__float_as_uint(v), __float_as_uint(v), false, false); return __uint_as_float(rr[0]) + __uint_as_float(rr[1]); }

struct Desc {
    const bf16_t* Q;
    const bf16_t* K; const bf16_t* V;
    const bf16_t* SZ; bf16_t* Y;
    const float* bias;
    int qpos0, nvalid, nkeys;
};
template <int TYPE>
__device__ __forceinline__ void unit(LAS unsigned char* lds, const Desc& d) {
    int tid = threadIdx.x; asm volatile("" : "+v"(tid));
    const int wid = __builtin_amdgcn_readfirstlane(tid >> 6), lane = tid & 63, r32 = lane & 31, hi = lane >> 5;
    LAS float* wsf = (LAS float*)(lds + L_WS) + wid * 64;
    LAS float* biasL = (LAS float*)(lds + L_BIAS);
    volatile LAS unsigned* flags = (volatile LAS unsigned*)(lds + L_FLAG);
    const bool wvalid = (32 * wid < d.nvalid);
    const int qpos = d.qpos0 + 32 * wid + r32;
    const int cw = (d.qpos0 + 32 * wid) >> 6;
    const bool rowinvalid = (32 * wid + r32) >= d.nvalid;
    int t_lo, t_hi;
    if (TYPE == 0) { const int c0 = d.qpos0 >> 6; t_lo = c0 - 8 > 0 ? c0 - 8 : 0; t_hi = c0 + 3; const int tk = (d.nkeys - 1) >> 6; if (t_hi > tk) t_hi = tk; }
    else { t_lo = 0; t_hi = (d.qpos0 + 255) >> 6; const int tk = (d.nkeys - 1) >> 6; if (t_hi > tk) t_hi = tk; }
    __syncthreads();
    if (TYPE == 0) { for (int i = tid; i < 257; i += 512) biasL[i] = d.bias[i] * LOG2E; }
    if (TYPE == 1) { if (tid < 16) flags[tid] = (32 * (tid & 7) < d.nvalid) ? 0u : 1u; }
    LAS unsigned char* Ql = lds + L_OST + wid * 8192;
    if (wvalid) {
#pragma unroll
        for (int d0 = 0; d0 < 8; ++d0) { const bf16x8 qv = __builtin_nontemporal_load((const bf16x8*)(d.Q + (size_t)(32 * wid + r32) * 1024 + d0 * 16 + hi * 8)); *(LAS bf16x8*)(Ql + KSWZ(r32, (d0 * 16 + hi * 8) * 2)) = qv; }
    }
    const int sr = tid >> 4, sc = (tid & 15) * 8, vst0 = v_st(sr, sc), vst1 = v_st(32 + sr, sc), kst0 = KSWZ(sr, sc * 2), kst1 = KSWZ(32 + sr, sc * 2);
    const int vbase = (int)(unsigned)(uintptr_t)(lds + L_V) + v_rd_base(lane);
    bf16x8 sv0, sv1, sk0, sk1;
#define SLOAD(T_) do { const size_t k0_ = (size_t)(T_) * 64; sv0 = *(const bf16x8*)(d.V + (k0_ + sr) * 1024 + sc); sv1 = *(const bf16x8*)(d.V + (k0_ + 32 + sr) * 1024 + sc); \
        sk0 = *(const bf16x8*)(d.K + (k0_ + sr) * 1024 + sc); sk1 = *(const bf16x8*)(d.K + (k0_ + 32 + sr) * 1024 + sc); } while (0)
    f32x16 o[4]; o[0] = f32x16{}; o[1] = f32x16{}; o[2] = f32x16{}; o[3] = f32x16{};
    float m_reg = -1e30f, l_reg = 0.f, R = 0.f; bool wdone = !wvalid;
    bf16x8 T00, T01;
    if (TYPE == 1) {
#pragma unroll
        for (int e = 0; e < 8; ++e) { const int j0 = 8 * hi + e; T00[e] = (j0 > r32) ? (short)0x3F80 : (short)0; T01[e] = (16 + j0 > r32) ? (short)0x3F80 : (short)0; }
    }
    const int step = (TYPE == 0) ? 1 : -1, nT = t_hi - t_lo + 1;
    int T = (TYPE == 0) ? t_lo : t_hi;
#define SWRITE(B_) do { LAS unsigned char* vb_ = lds + (B_) * L_BUF + L_V; LAS unsigned char* kb_ = lds + (B_) * L_BUF + L_K; \
        *(LAS bf16x8*)(vb_ + vst0) = sv0; *(LAS bf16x8*)(vb_ + vst1) = sv1; *(LAS bf16x8*)(kb_ + kst0) = sk0; *(LAS bf16x8*)(kb_ + kst1) = sk1; } while (0)
    SLOAD(T); SWRITE(0);
    if (nT > 1) SLOAD(T + step);
    __syncthreads();
    if (wid < 4) __builtin_amdgcn_s_setprio(1);
    for (int it = 0; it < nT; ++it, T += step) {
        const int cur = it & 1;
        if (TYPE == 1) { volatile LAS unsigned* fl = flags + 8 * (cur ^ 1); const unsigned f = fl[0] & fl[1] & fl[2] & fl[3] & fl[4] & fl[5] & fl[6] & fl[7]; if (f) break; }
        if (it + 1 < nT) SWRITE(cur ^ 1);
        if (it + 2 < nT) SLOAD(T + 2 * step);
        const LAS unsigned char* Kl = lds + cur * L_BUF + L_K; const int vb0 = vbase + cur * L_BUF;
        if (TYPE == 0) {
            if (wvalid && T >= cw - 8 && T <= cw) {
                f32x16 p0, p1; qkt(p0, p1, Kl, Ql, r32, hi);
                const int dc = cw - T;
                if (dc >= 3) { const float bf = biasL[256];
#pragma unroll
                    for (int r = 0; r < 16; ++r) { p0[r] += bf; p1[r] += bf; } }
                else { const int relb = qpos - 64 * T + 128;
#pragma unroll
                    for (int r = 0; r < 16; ++r) { int i0 = relb - crow(r, hi); int i1 = i0 - 32; i0 = i0 < 0 ? 0 : (i0 > 256 ? 256 : i0); i1 = i1 < 0 ? 0 : (i1 > 256 ? 256 : i1); p0[r] += biasL[i0]; p1[r] += biasL[i1]; } }
                const bool needmask = (64 * T + 63 >= d.nkeys);
                if (needmask) {
#pragma unroll
                    for (int r = 0; r < 16; ++r) { const int kp = 64 * T + crow(r, hi); if (kp >= d.nkeys) p0[r] = -1e30f; if (kp + 32 >= d.nkeys) p1[r] = -1e30f; } }
                float pmax = p0[0];
#pragma unroll
                for (int r = 1; r < 16; ++r) pmax = fmaxf(pmax, p0[r]);
#pragma unroll
                for (int r = 0; r < 16; ++r) pmax = fmaxf(pmax, p1[r]);
                pmax = swap_max(pmax);
                float alpha = 1.f; const bool grow = __any(pmax > m_reg + 8.0f);
                if (grow) { const float mx = fmaxf(m_reg, pmax); alpha = ex2(m_reg - mx); m_reg = mx; }
                const float mn = m_reg;
#pragma unroll
                for (int r = 0; r < 16; ++r) { p0[r] = ex2(p0[r] - mn); p1[r] = ex2(p1[r] - mn); }
                if (needmask) {
#pragma unroll
                    for (int r = 0; r < 16; ++r) { const int kp = 64 * T + crow(r, hi); if (kp >= d.nkeys) p0[r] = 0.f; if (kp + 32 >= d.nkeys) p1[r] = 0.f; } }
                float ps = 0.f;
#pragma unroll
                for (int r = 0; r < 16; ++r) ps += p0[r] + p1[r];
                ps = swap_add(ps);
                l_reg = l_reg * alpha + ps;
                if (grow && __any(alpha < 1.f)) { if (hi == 0) wsf[r32] = alpha; LDS_WAIT();
#pragma unroll
                    for (int dd = 0; dd < 4; ++dd)
#pragma unroll
                        for (int r = 0; r < 16; ++r) o[dd][r] *= wsf[crow(r, hi)]; }
                bf16x8 pa0, pa1, pa2, pa3; PK4(p0, 0, pa0); PK4(p0, 8, pa1); PK4(p1, 0, pa2); PK4(p1, 8, pa3);
                pv_d0(o, vb0, pa0, pa1, pa2, pa3);
            }
        } else {
            if (!wdone && T <= cw) {
                const bool diag = (T == cw);
                bf16x8 pa0, pa1, pa2, pa3; float ts1, ts0;
                {
                    f32x16 z, lf; qkt_half(z, Kl, Ql, r32, hi, 1); float ts = 0.f;
#pragma unroll
                    for (int r = 0; r < 16; ++r) { const float zz = z[r], e = ex2(-fabsf(zz)), l1p = __builtin_amdgcn_logf(1.0f + e); float lb = fminf(zz, 0.f) - l1p, lfv = -fmaxf(zz, 0.f) - l1p;
                        if (diag) { const bool c = (64 * T + 32 + crow(r, hi)) < qpos; lfv = c ? lfv : 0.f; lb = c ? lb : -1e30f; }
                        z[r] = lb; lf[r] = lfv; ts += lfv; }
                    ts1 = swap_add(ts);
                    bf16x8 la2, la3; PK4(lf, 0, la2); PK4(lf, 8, la3);
                    f32x16 L = f32x16{};
                    L = __builtin_amdgcn_mfma_f32_32x32x16_bf16(T00, la2, L, 0, 0, 0); L = __builtin_amdgcn_mfma_f32_32x32x16_bf16(T01, la3, L, 0, 0, 0);
#pragma unroll
                    for (int r = 0; r < 16; ++r) z[r] = ex2(z[r] + L[r] + R);
                    PK4(z, 0, pa2); PK4(z, 8, pa3);
                }
                {
                    f32x16 z, lf; qkt_half(z, Kl, Ql, r32, hi, 0); float ts = 0.f;
#pragma unroll
                    for (int r = 0; r < 16; ++r) { const float zz = z[r], e = ex2(-fabsf(zz)), l1p = __builtin_amdgcn_logf(1.0f + e); float lb = fminf(zz, 0.f) - l1p, lfv = -fmaxf(zz, 0.f) - l1p;
                        if (diag) { const bool c = (64 * T + crow(r, hi)) < qpos; lfv = c ? lfv : 0.f; lb = c ? lb : -1e30f; }
                        z[r] = lb; lf[r] = lfv; ts += lfv; }
                    ts0 = swap_add(ts);
                    bf16x8 la0, la1; PK4(lf, 0, la0); PK4(lf, 8, la1);
                    f32x16 L = f32x16{};
                    L = __builtin_amdgcn_mfma_f32_32x32x16_bf16(T00, la0, L, 0, 0, 0); L = __builtin_amdgcn_mfma_f32_32x32x16_bf16(T01, la1, L, 0, 0, 0);
                    const float Rr = R + ts1;
#pragma unroll
                    for (int r = 0; r < 16; ++r) z[r] = ex2(z[r] + L[r] + Rr);
                    PK4(z, 0, pa0); PK4(z, 8, pa1);
                }
                pv_d0(o, vb0, pa0, pa1, pa2, pa3);
                const float ts = ts0 + ts1;
                R += ts;
                wdone = __all((R < -160.f) || rowinvalid);
            }
            if (lane == 0) flags[8 * cur + wid] = wdone ? 1u : 0u;
        }
        __syncthreads();
    }
    __builtin_amdgcn_s_setprio(0);
    if (wvalid) {
        LAS bf16_t* stg = (LAS bf16_t*)(lds + L_OST) + wid * 4096;
        if (TYPE == 0) { if (hi == 0) wsf[32 + r32] = l_reg; LDS_WAIT(); }
#pragma unroll
        for (int r = 0; r < 16; ++r) { const int rw = crow(r, hi); const float rl = (TYPE == 0) ? __builtin_amdgcn_rcpf(wsf[32 + rw]) : 1.f;
#pragma unroll
            for (int dd = 0; dd < 4; ++dd) stg[rw * 128 + dd * 32 + r32] = f2bf(o[dd][r] * rl); }
        LDS_WAIT();
#pragma unroll 2
        for (int i = 0; i < 8; ++i) { const int rw = i * 4 + (lane >> 4), ch = lane & 15, row = 32 * wid + rw;
            if (row < d.nvalid) { const size_t off = (size_t)row * 3072 + ch * 8;
                const u32x4 ov = *(const LAS u32x4*)(stg + rw * 128 + ch * 8), gv = __builtin_nontemporal_load((const u32x4*)(d.SZ + off));
                u32x4 w; w.x = pk2(bflo(ov.x) * bflo(gv.x), bfhi(ov.x) * bfhi(gv.x)); w.y = pk2(bflo(ov.y) * bflo(gv.y), bfhi(ov.y) * bfhi(gv.y));
                w.z = pk2(bflo(ov.z) * bflo(gv.z), bfhi(ov.z) * bfhi(gv.z)); w.w = pk2(bflo(ov.w) * bflo(gv.w), bfhi(ov.w) * bfhi(gv.w));
                *(u32x4*)(d.Y + off) = w; } }
    }
#undef SLOAD
#undef SWRITE
}
}

#if defined(DBG_ONLY0)
#define ATT_DISPATCH(type, lds, d) att::unit<0>(lds, d)
#elif defined(DBG_ONLY1)
#define ATT_DISPATCH(type, lds, d) att::unit<1>(lds, d)
#elif defined(DBG_NOATT)
#define ATT_DISPATCH(type, lds, d) (void)d
#else
#define ATT_DISPATCH(type, lds, d) do { if (type) att::unit<1>(lds, d); else att::unit<0>(lds, d); } while (0)
#endif
struct Args { const float* in[28]; float* out; unsigned char* ws; int ph_lo, ph_hi; };
constexpr int I_IN = (DM / 64) * (NIN / 64), I_GLU = 16 * 16, I_BR = (MW / 64) * (DM / 64), I_OUT = 64 * 64, I_L = I_IN + I_GLU + 3 * I_BR + I_OUT;
__device__ __forceinline__ void weight_item(const float* w_in, const float* w_glu, const float* w_br0, const float* w_br1, const float* w_br2, const float* w_out, unsigned char* ws, int l, int r, LAS float* scr, int lane) {
    if (r < I_IN) { transpose_item(w_in + (size_t)l * DM * NIN, DM, NIN, (bf16_t*)(ws + WS_WIN) + (size_t)l * NIN * DM, scr, r, lane); return; } r -= I_IN;
    if (r < I_GLU) { transpose_item(w_glu + (size_t)l * MW * MW, MW, MW, (bf16_t*)(ws + WS_WGLU) + (size_t)l * MW * MW, scr, r, lane); return; } r -= I_GLU;
    if (r < 3 * I_BR) { const int br = r / I_BR; r -= br * I_BR;
        transpose_item((br == 0 ? w_br0 : br == 1 ? w_br1 : w_br2) + (size_t)l * MW * DM, MW, DM, (bf16_t*)(ws + WS_WBR) + (size_t)(l * 3 + br) * DM * MW, scr, r, lane); return; } r -= 3 * I_BR;
    transpose_item(w_out + (size_t)l * DM * DM, DM, DM, (bf16_t*)(ws + WS_WOUT) + (size_t)l * DM * DM, scr, r, lane);
}
__device__ __forceinline__ void convert_caches(const float* sbk, const float* sbv, const float* bdk, const float* bdv, const WsPtrs W, int l, int wg, int nwg, int gsz) {
    int t_ = threadIdx.x; asm volatile("" : "+v"(t_));
    const size_t gt = (size_t)wg * gsz + (t_ & (gsz - 1)), NT = (size_t)nwg * gsz;
    const size_t n_sb = 8ull * PASTL * 128, n_bd = 8ull * BANDK * 128;
    const size_t total = 2 * n_sb + 2 * n_bd;
    for (size_t i0 = gt; i0 < total; i0 += 4 * NT) {
        f32x4 a[4], b[4]; bf16_t* dsts[4];
#pragma unroll
        for (int u = 0; u < 4; ++u) {
            const size_t i = i0 + u * NT; size_t j = i < total ? i : total - 1; const float* src;
            if (j < 2 * n_sb) { const int kv = j >= n_sb; j -= kv * n_sb; const size_t lb = (size_t)l * NB + j / ((size_t)PASTL * 128), rem = j % ((size_t)PASTL * 128), t = rem >> 7, c8 = rem & 127;
                src = (kv ? sbv : sbk) + (lb * PASTL + t) * 1024 + c8 * 8; dsts[u] = (kv ? W.VCS() : W.KCS()) + (lb * KCS_ROWS + t) * 1024 + c8 * 8; }
            else { j -= 2 * n_sb; const int kv = j >= n_bd; j -= kv * n_bd; const size_t lb = (size_t)l * NB + j / ((size_t)BANDK * 128), rem = j % ((size_t)BANDK * 128), t = rem >> 7, c8 = rem & 127;
                src = (kv ? bdv : bdk) + (lb * BANDK + t) * 1024 + c8 * 8; dsts[u] = (kv ? W.VBS() : W.KBS()) + (lb * KBS_ROWS + t) * 1024 + c8 * 8; }
            a[u] = __builtin_nontemporal_load((const f32x4*)src); b[u] = __builtin_nontemporal_load((const f32x4*)(src + 4));
        }
#pragma unroll
        for (int u = 0; u < 4; ++u) if (i0 + u * NT < total) st_bf16x8(dsts[u], a[u], b[u]);
    }
}
constexpr int N_PHASES = 11;

__global__ void __launch_bounds__(NWAVES * 64, 2) hse_fwd(Args args) {
    extern __shared__ __attribute__((aligned(16))) unsigned char lds_raw[];
    LAS unsigned char* lds = (LAS unsigned char*)lds_raw;
    volatile LAS unsigned* MISC = (volatile LAS unsigned*)(lds + MISC_OFF);
    const int tid = threadIdx.x, lane = tid & 63, wave = __builtin_amdgcn_readfirstlane(tid >> 6);
    const int G = gridDim.x; const int bx = blockIdx.x; const int vcu = (G % 8 == 0) ? (bx % 8) * (G / 8) + bx / 8 : bx;
    unsigned char* ws = args.ws; float* out = args.out;
    const CAS Args* const kargs = (const CAS Args*)__builtin_amdgcn_kernarg_segment_ptr();
#define KARGS() const CAS Args* KA = kargs; asm volatile("" : "+s"(KA))
#define PHASE_BEGIN() KARGS(); unsigned char* ws_o_ = ws; float* out_o_ = out; asm volatile("" : "+s"(ws_o_), "+s"(out_o_)); unsigned char* const ws = asg(ws_o_); float* const out = asg(out_o_); WsPtrs W; W.ws = ws; (void)out; (void)KA; \
    int G_o_ = G, bx_o_ = bx, vcu_o_ = vcu; asm volatile("" : "+s"(G_o_), "+s"(bx_o_), "+s"(vcu_o_)); const int G = G_o_, bx = bx_o_, vcu = vcu_o_; (void)G; (void)bx; (void)vcu
    unsigned* ctl = (unsigned*)(ws + WS_CTL);
    WsPtrs W; W.ws = ws;
    for (int u = tid; u < (LDS_BYTES - LDSCTL_OFF) / 4; u += NWAVES * 64) ((LAS unsigned*)(lds + LDSCTL_OFF))[u] = 0u;
    __syncthreads();
    XcdBarrier bar; bar.bar = ctl + CW_BAR; bar.x = 0; bar.st = nullptr;
    if (!MK_SPLIT) bar = xcd_barrier_post(ctl + CW_BAR, MISC + 8);
    const int lo = args.ph_lo, hi_ph = args.ph_hi;
#define IN(k) (lo <= (k) && (k) < hi_ph)
#define SEAM(k) do { if (!MK_SPLIT && (k) + 1 < hi_ph) xcd_barrier(bar); } while (0)
    const int gw = vcu * NWAVES + wave, NGW = G * NWAVES;

#ifndef NO_P0
    if (IN(0)) {
        PHASE_BEGIN();
        for (int lg = NGW - 1 - gw; lg < 2 * NG; lg += NGW) {
            const int l = lg / NG, g = lg - l * NG, n = lane;
            const float dt = expf(KA->in[12][lg]);
            const float are = KA->in[10][(size_t)lg * NST + n], aim = KA->in[11][(size_t)lg * NST + n];
            const float mag = expf(are * dt), abr = mag * cosf(aim * dt), abi = mag * sinf(aim * dt);
            const float den = are * are + aim * aim, nr = abr - 1.0f;
            const float kre = (nr * are + abi * aim) / den, kim = (abi * are - nr * aim) / den;
            *((f32x2*)(ws + WS_ABAR) + (size_t)lg * NST + n) = (f32x2){abr, abi};
            bf16_t* BMT = (bf16_t*)(ws + WS_BMT) + (size_t)lg * 128 * 16; bf16_t* CMT = (bf16_t*)(ws + WS_CMT) + (size_t)lg * 16 * 128;
            const float* bre = KA->in[13] + ((size_t)lg * NST + n) * 16; const float* bim = KA->in[14] + ((size_t)lg * NST + n) * 16;
#pragma unroll
            for (int p = 0; p < 16; ++p) { const float br_ = bre[p], bi_ = bim[p];
                BMT[(size_t)n * 16 + p] = f2bf(kre * br_ - kim * bi_); BMT[(size_t)(64 + n) * 16 + p] = f2bf(kre * bi_ + kim * br_);
                CMT[(size_t)p * 128 + n] = f2bf(KA->in[15][((size_t)lg * 16 + p) * NST + n]); CMT[(size_t)p * 128 + 64 + n] = f2bf(-KA->in[16][((size_t)lg * 16 + p) * NST + n]); }
        }
        LAS float* scr = (LAS float*)(lds + wave * 16640);
        for (int rep_ = 0; rep_ < ((DBG_DUP & 1) ? 2 : 1); ++rep_)
        for (int it = gw; it < I_L; it += NGW) weight_item(KA->in[9], KA->in[18], KA->in[23], KA->in[24], KA->in[25], KA->in[27], ws, 0, it, scr, lane);
        for (int m = gw; m < MR; m += NGW) {
            const float* xr = (m < MP) ? KA->in[0] + (size_t)m * DM : KA->in[1] + (size_t)(m - MP) * DM;
            xrow_to_a0(xr, KA->in[8], W.A0() + (size_t)m * DM, W.SSQ0() + m, lane);
        }
        convert_caches(KA->in[2], KA->in[3], KA->in[4], KA->in[5], W, 0, vcu, G, 512);
        for (int i = gw; i < 16 * 96 * 2; i += NGW) { const int kv = i & 1, j = i >> 1, lb = j / 96, rr = j - lb * 96;
            bf16_t* p = (rr < 48) ? (kv ? W.VCS() : W.KCS()) + ((size_t)lb * KCS_ROWS + PASTL + DSEQ + rr) * 1024 : (kv ? W.VBS() : W.KBS()) + ((size_t)lb * KBS_ROWS + BANDK + DSEQ + (rr - 48)) * 1024;
            *((u32x4*)p + lane) = (u32x4){0u, 0u, 0u, 0u}; *((u32x4*)p + 64 + lane) = (u32x4){0u, 0u, 0u, 0u}; }
        SEAM(0);
    }
#endif

    for (int l = 0; l < 2; ++l) {
        const int pb = 1 + 5 * l;
#ifndef NO_P1
        if (IN(pb)) {
            PHASE_BEGIN();
            pg8::Gemm g{DM, DM, DM};
            pg8::TileOrder<1> S; S.nM = MP / 256; S.nN = NIN / 256; S.nwg = S.nM * S.nN; S.G = G; S.c = bx;
            S.A = (const char*)W.A0(); S.B = (const char*)(ws + WS_WIN) + (size_t)l * NIN * DM * 2; S.atile = 256ull * DM * 2; S.btile = 256ull * DM * 2; S.arep = 0; S.brep = 0;
            pg8::QuarterOrder<1> SQ; SQ.pmq = MP / 256; SQ.nN = S.nN; SQ.G = G; SQ.c = bx; SQ.A = S.A; SQ.B = S.B; SQ.atile = S.atile; SQ.btile = S.btile; SQ.arep = 0; SQ.brep = 0; SQ.bhalf = 128ull * DM * 2;
            Epi1 E{l == 0 ? W.SSQ0() : W.SSQ1(), KA->in[26] + (size_t)l * 3 * DM, out, W, l};
            long long ck0 = 0, rt0 = 0; if (DBG_CLK == 1 && l == 0 && bx == 0) { ck0 = clock64(); rt0 = wall_clock64(); }
            pg8::gemm_phase<false>(lds, g, S, E);
            pg8::gemm_quarter(lds, g, SQ, E);
            if (DBG_CLK == 1 && l == 0 && bx == 0 && tid == 0) { const long long dc = clock64() - ck0, dr = wall_clock64() - rt0; ((long long*)(ws + WS_CTL + 32768))[0] = dc; ((long long*)(ws + WS_CTL + 32768))[1] = dr; }
            if (DBG_DUP & 2) { pg8::gemm_phase<false>(lds, g, S, E); pg8::gemm_quarter(lds, g, SQ, E); }
            if (DBG_DUP & 0xF00) { EpiNull EN{(float*)(ws + WS_CTL + 49152)}; S.fixed = (DBG_DUP >> 9) & 3; pg8::gemm_phase<false>(lds, g, S, EN); }
            if (DBG_CLK == 2 && l == 0 && tid == 0) { const unsigned long long t_ = (unsigned long long)wall_clock64(); atomicMax((unsigned long long*)(ws + WS_CTL + 40960), t_); atomicMax((unsigned long long*)(ws + WS_CTL + 40960) + 8, ~t_); }
            SEAM(pb);
            if (DBG_CLK == 2 && l == 0 && bx == 0 && tid == 0) { const unsigned long long mx = *((unsigned long long*)(ws + WS_CTL + 40960)), mn = ~*((unsigned long long*)(ws + WS_CTL + 40960) + 8);
                ((long long*)(ws + WS_CTL + 32768))[0] = (long long)(mx - mn) * 10; ((long long*)(ws + WS_CTL + 32768))[1] = 1; }
        }
#endif
#ifndef NO_P2A
        if (IN(pb + 1)) {
            PHASE_BEGIN();
            constexpr int NSW = 2, NHWV = NWAVES - NSW;
            if (wave < NSW) {
                LAS float* S = (LAS float*)(lds + wave * SSM_WAVE_BYTES);
                __builtin_amdgcn_s_setprio(2);
                for (int st = vcu * NSW + wave; st < 1024; st += G * NSW) {
                    const int sample = st >= 512, ii = st & 511, b = ii >> 6, g = ii & 63;
                    if (!sample) ssm_unit<32>(S, ws, KA->in[17] + (size_t)l * MW, l, g, W.U(), W.YG(), b * SEQ, SEQ, nullptr, nullptr,
                                          out + O_PSR + ((size_t)(l * NB + b) * NG + g) * NST, out + O_PSI + ((size_t)(l * NB + b) * NG + g) * NST, lane);
                    else ssm_unit<16>(S, ws, KA->in[17] + (size_t)l * MW, l, g, W.U(), W.YG(), MP + b * DSEQ, DSEQ,
                                  KA->in[6] + ((size_t)(l * NB + b) * NG + g) * NST, KA->in[7] + ((size_t)(l * NB + b) * NG + g) * NST,
                                  out + O_SSR + ((size_t)(l * NB + b) * NG + g) * NST, out + O_SSI + ((size_t)(l * NB + b) * NG + g) * NST, lane);
                }
                __builtin_amdgcn_s_setprio(0);
            } else
            { const int hw = vcu * NHWV + (wave - NSW), NHW = G * NHWV;
              {
                const float* qg = KA->in[20] + (size_t)l * HD; const float* kg = KA->in[21] + (size_t)l * HD;
                int lane_o = lane; asm volatile("" : "+v"(lane_o));
                const int c0 = 16 * lane_o, dd = c0 & 127;
                float gq[16], gk[16];
#pragma unroll
                for (int j = 0; j < 16; ++j) { gq[j] = qg[dd + j] * (0.08838834764831845f * LOG2E); gk[j] = kg[dd + j]; }
                auto norm16 = [&](const u32x4 a, const u32x4 b2, const float (&gv)[16], float (&v)[16]) __attribute__((always_inline)) {
                    v[0] = bflo(a.x); v[1] = bfhi(a.x); v[2] = bflo(a.y); v[3] = bfhi(a.y); v[4] = bflo(a.z); v[5] = bfhi(a.z); v[6] = bflo(a.w); v[7] = bfhi(a.w);
                    v[8] = bflo(b2.x); v[9] = bfhi(b2.x); v[10] = bflo(b2.y); v[11] = bfhi(b2.y); v[12] = bflo(b2.z); v[13] = bfhi(b2.z); v[14] = bflo(b2.w); v[15] = bfhi(b2.w);
                    float s = 0.f;
#pragma unroll
                    for (int j = 0; j < 16; ++j) s += v[j] * v[j];
                    s += __shfl_xor(s, 1); s += __shfl_xor(s, 2); s += __shfl_xor(s, 4);
                    const float r = __builtin_amdgcn_rsqf(s * (1.0f / 128.0f) + 1e-6f);
#pragma unroll
                    for (int j = 0; j < 16; ++j) v[j] = v[j] * r * gv[j];
                };
                auto do_row = [&](int row, const u32x4 qa, const u32x4 qb2, const u32x4 ka, const u32x4 kb2) __attribute__((always_inline)) {
                    float v[16];
                    norm16(qa, qb2, gq, v);
                    { bf16_t* qp = W.QB() + (size_t)row * 1024 + c0;
                      st_bf16x8(qp, (f32x4){v[0], v[1], v[2], v[3]}, (f32x4){v[4], v[5], v[6], v[7]}); st_bf16x8(qp + 8, (f32x4){v[8], v[9], v[10], v[11]}, (f32x4){v[12], v[13], v[14], v[15]}); }
                    norm16(ka, kb2, gk, v);
                    bf16_t* d16; float* d32 = nullptr;
                    if (row < MP) { const int b = row >> 11, t = row & 2047; d16 = W.KB() + (size_t)row * 1024 + c0;
                        if (t >= SEQ - BANDK) d32 = out + O_PBK + ((size_t)(l * NB + b) * BANDK + (t - (SEQ - BANDK))) * 1024 + c0; }
                    else { const int sr = row - MP, b = sr >> 4, t = sr & 15; d16 = W.KBS() + ((size_t)(l * NB + b) * KBS_ROWS + BANDK + t) * 1024 + c0; d32 = out + O_SBK + ((size_t)l * MS + sr) * 1024 + c0; }
                    st_bf16x8(d16, (f32x4){v[0], v[1], v[2], v[3]}, (f32x4){v[4], v[5], v[6], v[7]}); st_bf16x8(d16 + 8, (f32x4){v[8], v[9], v[10], v[11]}, (f32x4){v[12], v[13], v[14], v[15]});
                    if (d32) { *(f32x4*)d32 = (f32x4){v[0], v[1], v[2], v[3]}; *(f32x4*)(d32 + 4) = (f32x4){v[4], v[5], v[6], v[7]}; *(f32x4*)(d32 + 8) = (f32x4){v[8], v[9], v[10], v[11]}; *(f32x4*)(d32 + 12) = (f32x4){v[12], v[13], v[14], v[15]}; }
                };
                for (int r0 = hw; r0 < MR; r0 += 2 * NHW) {
                    const int r1 = r0 + NHW; const bool h1 = r1 < MR; const int r1c = h1 ? r1 : r0;
                    const bf16_t* q0 = W.QB() + (size_t)r0 * 1024 + c0; const bf16_t* k0p = W.KB() + (size_t)r0 * 1024 + c0;
                    const bf16_t* q1 = W.QB() + (size_t)r1c * 1024 + c0; const bf16_t* k1p = W.KB() + (size_t)r1c * 1024 + c0;
                    const u32x4 qa0 = __builtin_nontemporal_load((const u32x4*)q0), qb0 = __builtin_nontemporal_load((const u32x4*)(q0 + 8)), ka0 = __builtin_nontemporal_load((const u32x4*)k0p), kb0 = __builtin_nontemporal_load((const u32x4*)(k0p + 8));
                    const u32x4 qa1 = __builtin_nontemporal_load((const u32x4*)q1), qb1 = __builtin_nontemporal_load((const u32x4*)(q1 + 8)), ka1 = __builtin_nontemporal_load((const u32x4*)k1p), kb1 = __builtin_nontemporal_load((const u32x4*)(k1p + 8));
                    do_row(r0, qa0, qb0, ka0, kb0);
                    if (h1) do_row(r1, qa1, qb1, ka1, kb1);
                }
                if (l == 0) { LAS float* scr = (LAS float*)(lds + NSW * SSM_WAVE_BYTES + (wave - NSW) * 16640);
                    for (int it = hw; it < I_IN; it += NHW) weight_item(KA->in[9], KA->in[18], KA->in[23], KA->in[24], KA->in[25], KA->in[27], ws, 1, it, scr, lane); }
                else { convert_caches(KA->in[2], KA->in[3], KA->in[4], KA->in[5], W, 1, hw, NHW, 64);
                    LAS float* scr = (LAS float*)(lds + NSW * SSM_WAVE_BYTES + (wave - NSW) * 16640);
                    for (int it = I_IN + hw; it < I_L; it += NHW) weight_item(KA->in[9], KA->in[18], KA->in[23], KA->in[24], KA->in[25], KA->in[27], ws, 1, it, scr, lane); }
              } }
            SEAM(pb + 1);
        }
#endif
#ifndef NO_P2B
        if (IN(pb + 2)) {
            PHASE_BEGIN();
            for (int rep_ = 0; rep_ < ((DBG_DUP & 8) ? 2 : 1); ++rep_) {
            const int nit = (G == 256) ? (((vcu & 7) <= 1 || (vcu & 7) >= 6) ? 5 : 4) : (1152 + G - 1 - vcu) / G;
            for (int k = 0; k < nit; ++k) {
                int item;
                if (G == 256) { const int q = vcu & 7, bq = vcu >> 3;
                    if (k < 4) { const int second = k & 1, ty = k >> 1; item = ty * 512 + (second ? ((32 + bq) << 3) + (7 - q) : (bq << 3) + q); }
                    else item = 1024 + ((q == 0 || q == 7) ? 0 : 64) + ((q == 0 || q == 1) ? 0 : 32) + bq; }
                else item = vcu + k * G;
                att::Desc d;
                if (item < 1024) {
                    const int type = item < 512 ? 1 : 0, ii = item & 511, bh = ii >> 3, qb = ii & 7, b = bh >> 3, h = bh & 7;
                    const size_t row0 = (size_t)b * SEQ + 256 * qb;
                    d.Q = (type ? W.QC() : W.QB()) + row0 * 1024 + h * HD; d.K = (type ? W.KC() : W.KB()) + (size_t)b * SEQ * 1024 + h * HD; d.V = (type ? W.VC() : W.VB()) + (size_t)b * SEQ * 1024 + h * HD;
                    d.SZ = W.SZ() + row0 * 3072 + (type ? 2048 : 1024) + h * HD; d.Y = W.Y() + row0 * 3072 + (type ? 2048 : 1024) + h * HD;
                    d.bias = KA->in[22] + ((size_t)l * NH + h) * 257; d.qpos0 = 256 * qb; d.nvalid = 256; d.nkeys = SEQ;
                    ATT_DISPATCH(type, lds, d);
                    if ((DBG_DUP & 64) && type == 1) att::unit<1>(lds, d);
                    if ((DBG_DUP & 128) && type == 0) att::unit<0>(lds, d);
                } else {
                    const int type = item < 1088 ? 0 : 1, ii = (item - 1024) & 63, b = ii >> 3, h = ii & 7;
                    const size_t row0 = (size_t)MP + b * DSEQ;
                    d.Q = (type ? W.QC() : W.QB()) + row0 * 1024 + h * HD;
                    d.K = (type ? W.KCS() + (size_t)(l * NB + b) * KCS_ROWS * 1024 : W.KBS() + (size_t)(l * NB + b) * KBS_ROWS * 1024) + h * HD;
                    d.V = (type ? W.VCS() + (size_t)(l * NB + b) * KCS_ROWS * 1024 : W.VBS() + (size_t)(l * NB + b) * KBS_ROWS * 1024) + h * HD;
                    d.SZ = W.SZ() + row0 * 3072 + (type ? 2048 : 1024) + h * HD; d.Y = W.Y() + row0 * 3072 + (type ? 2048 : 1024) + h * HD;
                    d.bias = KA->in[22] + ((size_t)l * NH + h) * 257; d.qpos0 = type ? PASTL : BANDK; d.nvalid = DSEQ; d.nkeys = (type ? PASTL : BANDK) + DSEQ;
                    ATT_DISPATCH(type, lds, d);
                }
            }
#ifndef DBG_NOGLU
            __syncthreads();
            { pg8::Gemm g{MW, MW, MW};
              pg8::TileOrder<1> S; S.nM = MP / 256; S.nN = MW / 256; S.nwg = S.nM * S.nN; S.G = G; S.c = bx;
              S.A = (const char*)W.YG(); S.B = (const char*)(ws + WS_WGLU) + (size_t)l * MW * MW * 2; S.atile = 256ull * MW * 2; S.btile = 256ull * MW * 2; S.arep = 0; S.brep = 0;
              pg8::QuarterOrder<1> SQ; SQ.pmq = MP / 256; SQ.nN = S.nN; SQ.G = G; SQ.c = (vcu + G / 2) % G; SQ.A = S.A; SQ.B = S.B; SQ.atile = S.atile; SQ.btile = S.btile; SQ.arep = 0; SQ.brep = 0; SQ.bhalf = 128ull * MW * 2;
              EpiGlu E{KA->in[19] + (size_t)l * MW, W};
              pg8::gemm_phase<false>(lds, g, S, E);
              pg8::gemm_quarter(lds, g, SQ, E); }
#endif
            }
            SEAM(pb + 2);
        }
#endif
#ifndef NO_P3
        if (IN(pb + 3)) {
            PHASE_BEGIN();
            pg8::Gemm g{3 * MW, MW, MW};
            pg8::TileOrder<3> S; S.nM = MP / 256; S.nN = DM / 256; S.nwg = S.nM * S.nN; S.G = G; S.c = bx;
            S.A = (const char*)W.Y(); S.B = (const char*)(ws + WS_WBR) + (size_t)l * 3 * DM * MW * 2; S.atile = 256ull * 3 * MW * 2; S.btile = 256ull * MW * 2; S.arep = (size_t)MW * 2; S.brep = (size_t)DM * MW * 2;
            pg8::QuarterOrder<3> SQ; SQ.pmq = MP / 256; SQ.nN = S.nN; SQ.G = G; SQ.c = bx; SQ.A = S.A; SQ.B = S.B; SQ.atile = S.atile; SQ.btile = S.btile; SQ.arep = S.arep; SQ.brep = S.brep; SQ.bhalf = 128ull * MW * 2;
            EpiBr E{W};
            pg8::gemm_phase<false>(lds, g, S, E);
            pg8::gemm_quarter(lds, g, SQ, E);
            if (DBG_DUP & 16) { pg8::gemm_phase<false>(lds, g, S, E); pg8::gemm_quarter(lds, g, SQ, E); }
            if (DBG_DUP & 2048) { EpiNull EN{(float*)(ws + WS_CTL + 49152)}; pg8::gemm_phase<false>(lds, g, S, EN); }
            if (DBG_DUP & 4096) pg8::gemm_phase<false>(lds, g, S, E);
            SEAM(pb + 3);
        }
#endif
#ifndef NO_P4
        if (IN(pb + 4)) {
            PHASE_BEGIN();
            pg8::Gemm g{DM, DM, DM};
            pg8::TileOrder<1> S; S.nM = MP / 256; S.nN = DM / 256; S.nwg = S.nM * S.nN; S.G = G; S.c = bx;
            S.A = (const char*)W.MX(); S.B = (const char*)(ws + WS_WOUT) + (size_t)l * DM * DM * 2; S.atile = 256ull * DM * 2; S.btile = 256ull * DM * 2; S.arep = 0; S.brep = 0;
            pg8::QuarterOrder<1> SQ; SQ.pmq = MP / 256; SQ.nN = S.nN; SQ.G = G; SQ.c = bx; SQ.A = S.A; SQ.B = S.B; SQ.atile = S.atile; SQ.btile = S.btile; SQ.arep = 0; SQ.brep = 0; SQ.bhalf = 128ull * DM * 2;
            EpiOut E{KA->in[0], KA->in[1], KA->in[8] + DM, out, W, l};
            pg8::gemm_phase<false>(lds, g, S, E);
            pg8::gemm_quarter(lds, g, SQ, E);
            if ((DBG_DUP & 32) && l == 1) { pg8::gemm_phase<false>(lds, g, S, E); pg8::gemm_quarter(lds, g, SQ, E); }
            SEAM(pb + 4);
        }
#endif
    }
    if (DBG_CLK && bx == 0 && tid == 0) { const long long dc = ((long long*)(ws + WS_CTL + 32768))[0], dr = ((long long*)(ws + WS_CTL + 32768))[1];
        const long long ticks = (DBG_CLK == 2) ? dc : (dc * 10000) / (dr > 0 ? dr : 1); const long long t0 = wall_clock64(); while (wall_clock64() - t0 < ticks) __builtin_amdgcn_s_sleep(8); }
#undef IN
#undef SEAM
}

extern "C" void kernel_launch(void* const* d_in, const int* in_sizes, int n_in, void* d_out, int out_size, void* d_ws, size_t ws_size, hipStream_t stream) {
    static int grid = 0;
    if (grid == 0) {
        if ((size_t)out_size != O_END) fprintf(stderr, "kernel_launch: note: out_size %d, built for %zu\n", out_size, (size_t)O_END);
        if (n_in != 28 || ws_size < WS_END) { fprintf(stderr, "kernel_launch: shape mismatch n_in %d ws %zu (want %zu)\n", n_in, ws_size, (size_t)WS_END); grid = -1; return; }
        int dev = 0, cus = 0;
        if (hipGetDevice(&dev) != hipSuccess || hipDeviceGetAttribute(&cus, hipDeviceAttributeMultiprocessorCount, dev) != hipSuccess) { grid = -1; return; }
        if (hipFuncSetAttribute((const void*)hse_fwd, hipFuncAttributeMaxDynamicSharedMemorySize, LDS_BYTES) != hipSuccess) { fprintf(stderr, "kernel_launch: hipFuncSetAttribute failed\n"); grid = -1; return; }
        int per_cu = 0;
        if (hipOccupancyMaxActiveBlocksPerMultiprocessor(&per_cu, (const void*)hse_fwd, NWAVES * 64, LDS_BYTES) != hipSuccess || per_cu < 1) fprintf(stderr, "kernel_launch: occupancy query says %d\n", per_cu);
        (void)hipGetLastError();
        grid = cus;
    }
    if (grid < 0) return;
    if (hipMemsetAsync((char*)d_ws + WS_CTL, 0, CTL_ZERO_BYTES, stream) != hipSuccess) return;
    Args a{};
    for (int i = 0; i < 28; ++i) a.in[i] = (const float*)d_in[i];
    a.out = (float*)d_out; a.ws = (unsigned char*)d_ws;
#if MK_SPLIT
    for (int p = 0; p < N_PHASES; ++p) { a.ph_lo = p; a.ph_hi = p + 1; hipLaunchKernelGGL(hse_fwd, dim3(grid), dim3(NWAVES * 64), LDS_BYTES, stream, a); }
#else
    a.ph_lo = 0; a.ph_hi = N_PHASES; hipLaunchKernelGGL(hse_fwd, dim3(grid), dim3(NWAVES * 64), LDS_BYTES, stream, a);
#endif
}
```

```cpp
#include <hip/hip_runtime.h>
#include <cstdio>
#include <cstdint>

#ifndef DBG_DUP
#define DBG_DUP 0
#endif
#ifndef DBG_CLK
#define DBG_CLK 0
#endif
#ifndef MK_SPLIT
#define MK_SPLIT 0
#endif

#define LAS __attribute__((address_space(3)))
#define GAS __attribute__((address_space(1)))
#define CAS __attribute__((address_space(4)))
typedef unsigned short bf16_t;
typedef short bf16x8 __attribute__((ext_vector_type(8)));
typedef short s16x4 __attribute__((ext_vector_type(4)));
typedef float f32x2 __attribute__((ext_vector_type(2)));
typedef float f32x4 __attribute__((ext_vector_type(4)));
typedef float f32x16 __attribute__((ext_vector_type(16)));
typedef unsigned u32x2 __attribute__((ext_vector_type(2)));
typedef unsigned u32x4 __attribute__((ext_vector_type(4)));
typedef __bf16 bf16x2_t __attribute__((ext_vector_type(2)));

constexpr int DM = 4096, SEQ = 2048, NB = 8, DSEQ = 16, MW = 1024, HD = 128, NH = 8, NG = 64, NST = 64, NIN = 22528;
constexpr int MP = NB * SEQ, MS = NB * DSEQ, MR = MP + MS, MROWS = 16640;
constexpr int KCS_ROWS = 2112, KBS_ROWS = 576, BANDK = 512, PASTL = 2048;
constexpr float LOG2E = 1.4426950408889634f, LN2 = 0.6931471805599453f;
constexpr size_t O_YP = 0, O_YS = O_YP + (size_t)MP * DM, O_PSBK = O_YS + (size_t)MS * DM, O_PSBV = O_PSBK + 2ull * MP * MW, O_PBK = O_PSBV + 2ull * MP * MW,
                 O_PBV = O_PBK + 2ull * NB * BANDK * MW, O_PSR = O_PBV + 2ull * NB * BANDK * MW, O_PSI = O_PSR + 2ull * NB * NG * NST, O_SSBK = O_PSI + 2ull * NB * NG * NST,
                 O_SSBV = O_SSBK + 2ull * MS * MW, O_SBK = O_SSBV + 2ull * MS * MW, O_SBV = O_SBK + 2ull * MS * MW, O_SSR = O_SBV + 2ull * MS * MW, O_SSI = O_SSR + 2ull * NB * NG * NST,
                 O_END = O_SSI + 2ull * NB * NG * NST;
constexpr size_t MiB = 1u << 20;
constexpr size_t R1K = (size_t)MROWS * 1024 * 2;
constexpr size_t WS_CTL = 0, CTL_ZERO_BYTES = 1 * MiB;
constexpr size_t WS_SSQ1 = 65536;
constexpr size_t WS_SSQ0 = 1 * MiB;
constexpr size_t WS_ABAR = WS_SSQ0 + 128 * 1024;
constexpr size_t WS_BMT = WS_ABAR + 64 * 1024;
constexpr size_t WS_CMT = WS_BMT + 512 * 1024;
constexpr size_t WS_WIN = 4 * MiB;
constexpr size_t WS_WGLU = WS_WIN + 2ull * NIN * DM * 2;
constexpr size_t WS_WBR = WS_WGLU + 2ull * MW * MW * 2;
constexpr size_t WS_WOUT = WS_WBR + 6ull * DM * MW * 2;
constexpr size_t WS_A0 = WS_WOUT + 2ull * DM * DM * 2;
constexpr size_t WS_U = WS_A0 + 4 * R1K;
constexpr size_t WS_SZ = WS_U + R1K;
constexpr size_t WS_QB = WS_SZ + 3 * R1K, WS_KB = WS_QB + R1K, WS_VB = WS_KB + R1K, WS_QC = WS_VB + R1K, WS_KC = WS_QC + R1K, WS_VC = WS_KC + R1K;
constexpr size_t WS_G = WS_VC + R1K;
constexpr size_t WS_YG = WS_G + 12 * R1K;
constexpr size_t WS_Y = WS_YG + R1K;
constexpr size_t WS_MX = WS_Y + 3 * R1K;
constexpr size_t WS_Y0 = WS_MX + 4 * R1K;
constexpr size_t WS_KCS = WS_Y0 + (size_t)MROWS * DM * 4;
constexpr size_t WS_VCS = WS_KCS + 16ull * KCS_ROWS * 1024 * 2;
constexpr size_t WS_KBS = WS_VCS + 16ull * KCS_ROWS * 1024 * 2;
constexpr size_t WS_VBS = WS_KBS + 16ull * KBS_ROWS * 1024 * 2;
constexpr size_t WS_END = WS_VBS + 16ull * KBS_ROWS * 1024 * 2;
static_assert(WS_END < 2900ull * MiB && WS_CMT + 512 * 1024 <= WS_WIN && (WS_WGLU % 256) == 0 && (R1K % 256) == 0, "d_ws map");
constexpr int CW_BAR = 4096;
constexpr int SCR_BYTES = 147456;
constexpr int LDSCTL_OFF = SCR_BYTES, MISC_OFF = LDSCTL_OFF + 320;
constexpr int LDS_BYTES = 155648;
constexpr int NWAVES = 8;

__device__ __forceinline__ unsigned pk2(float lo, float hi) { f32x2 v = {lo, hi}; bf16x2_t b = __builtin_convertvector(v, bf16x2_t); return __builtin_bit_cast(unsigned, b); }
__device__ __forceinline__ float bflo(unsigned w) { return __uint_as_float(w << 16); }
__device__ __forceinline__ float bfhi(unsigned w) { return __uint_as_float(w & 0xffff0000u); }
__device__ __forceinline__ float bf2f(bf16_t h) { return __uint_as_float((unsigned)h << 16); }
__device__ __forceinline__ bf16_t f2bf(float f) { return (bf16_t)(pk2(f, 0.f) & 0xffffu); }
__device__ __forceinline__ float ex2(float x) { return __builtin_amdgcn_exp2f(x); }
__device__ __forceinline__ float sigmoidf_(float x) { return __builtin_amdgcn_rcpf(1.0f + ex2(-x * LOG2E)); }
#define LDS_WAIT() asm volatile("s_waitcnt lgkmcnt(0)" ::: "memory")
#define VM_WAIT() asm volatile("s_waitcnt vmcnt(0)" ::: "memory")

namespace pg8 {
constexpr int BM = 256, BK = 64, HALF = 128, HTB = HALF * BK * 2  , STAGE_BYTES = 8 * HTB, NXCD = 8, WGM = 8;
__host__ __device__ __forceinline__ int lds_byte(int r, int c) { const int st = (r >> 4) * 2 + (c >> 5), rr = r & 15, cc = c & 31, ob = rr * 64 + cc * 2; return st * 1024 + (ob ^ (((ob >> 9) & 1) << 5)); }
__host__ __device__ __forceinline__ void stage_rc(int b, int& R, int& C) { const int st = b / 1024, sb = b % 1024, swz = sb ^ (((sb >> 9) & 1) << 5); R = (st >> 1) * 16 + swz / 64; C = (st & 1) * 32 + (swz % 64) / 2; }
__host__ __device__ __forceinline__ int perm32(int rho) { const int n = rho >> 4, i = rho & 15; return 8 * (i >> 2) + 4 * n + (i & 3); }

struct Unit { const char* a; const char* b; int pm, pn, aux, q, cs; };
struct Gemm { int lda, ldb, K; };

template <int REP> struct TileOrder {
    int nM, nN, nwg, G, c; const char* A; const char* B; size_t atile, btile, arep, brep; int fixed = 0;
    __device__ __forceinline__ bool next(int i, Unit& u) const {
        const int ti = i / REP, r = i - ti * REP;
        const long L = (long)ti * G + c; if (L >= nwg) return false;
        int wgid = (int)L; { const int q = nwg / NXCD, rr = nwg % NXCD, xcd = wgid % NXCD, off = wgid / NXCD; wgid = (xcd < rr ? xcd * (q + 1) : rr * (q + 1) + (xcd - rr) * q) + off; }
        const int nig = WGM * nN, gid = wgid / nig, fm = gid * WGM, gsz = (nM - fm) < WGM ? (nM - fm) : WGM;
        u.pm = fm + ((wgid % nig) % gsz); u.pn = (wgid % nig) / gsz; u.aux = r; u.q = 0; u.cs = 0;
        u.a = A + (size_t)((fixed & 1) ? 0 : u.pm) * atile + (size_t)r * arep; u.b = B + (size_t)((fixed & 2) ? 0 : u.pn) * btile + (size_t)r * brep; return true;
    }
};

template <int REP> struct QuarterOrder {
    int pmq, nN, G, c; const char* A; const char* B; size_t atile, btile, arep, brep, bhalf;
    __device__ __forceinline__ bool next(int i, Unit& u) const {
        const int ti = i / REP, r = i - ti * REP;
        const int L = ti * G + c; if (L >= 2 * nN) return false;
        u.pm = pmq; u.pn = L >> 1; u.aux = r; u.q = 1; u.cs = (L & 1) * HALF;
        u.a = A + (size_t)pmq * atile + (size_t)r * arep; u.b = B + (size_t)u.pn * btile + (size_t)(L & 1) * bhalf + (size_t)r * brep; return true;
    }
};

template <bool Q, class Epi, class Sched>
__device__ __forceinline__ void gemm_phase(LAS unsigned char* lds, const Gemm g, const Sched& S, const Epi& E) {
    int tid = threadIdx.x; asm volatile("" : "+v"(tid));
    const int wid = __builtin_amdgcn_readfirstlane(tid >> 6), lane = tid & 63, wr = wid >> 2, wc = wid & 3, fr = lane & 15, fq = lane >> 4;
    const int K = g.K, nt = K / BK;
    unsigned voffA[2], voffB[2];
#pragma unroll
    for (int i = 0; i < 2; ++i) { int R, C; stage_rc(tid * 16 + i * 8192, R, C); const int Rb = Epi::PERM ? ((R & ~31) + perm32(R & 31)) : R;
        voffA[i] = (unsigned)(R * g.lda + C) * 2u; voffB[i] = (unsigned)(Rb * g.ldb + C) * 2u; }
    const size_t kstep = (size_t)(BK * 2);
    const size_t hstepA = Q ? 0 : (size_t)HALF * g.lda * 2, hstepB = Q ? 0 : (size_t)HALF * g.ldb * 2;
    const unsigned ldsw = (unsigned)wid * 1024u;
    const int aoff = lds_byte(wr * 64 + fr, fq * 8), boff = lds_byte(wc * 32 + fr, fq * 8);
#define PG8_SA(b, h) (((b) * 2 + (h)) * HTB)
#define PG8_SB(b, h) ((4 + (b) * 2 + (h)) * HTB)
#define PG8_STAGE(bufoff, gbase, voff) do { _Pragma("unroll") for (int _i = 0; _i < 2; ++_i) \
        __builtin_amdgcn_global_load_lds((const unsigned*)((const char*)(gbase) + (voff)[_i]), (LAS unsigned*)(lds + (bufoff) + ldsw + _i * 8192), 16, 0, 0); } while (0)
#define PG8_LDA(dst, b, h) do { _Pragma("unroll") for (int m = 0; m < 4; ++m) _Pragma("unroll") for (int k = 0; k < 2; ++k) dst[m][k] = *(const LAS bf16x8*)(lds + PG8_SA(b, h) + aoff + m * 2048 + k * 1024); } while (0)
#define PG8_LDB(dst, b, h) do { _Pragma("unroll") for (int n = 0; n < 2; ++n) _Pragma("unroll") for (int k = 0; k < 2; ++k) dst[n][k] = *(const LAS bf16x8*)(lds + PG8_SB(b, h) + boff + n * 2048 + k * 1024); } while (0)
#define PG8_MMA(ai, bj, At, Bt) do { __builtin_amdgcn_s_setprio(1); _Pragma("unroll") for (int m = 0; m < 4; ++m) _Pragma("unroll") for (int n = 0; n < 2; ++n) _Pragma("unroll") for (int k = 0; k < 2; ++k) \
        acc[ai][bj][m][n] = __builtin_amdgcn_mfma_f32_16x16x32_bf16(Bt[n][k], At[m][k], acc[ai][bj][m][n], 0, 0, 0); __builtin_amdgcn_s_setprio(0); } while (0)
#define PG8_WAIT_V(n) asm volatile("s_waitcnt vmcnt(" #n ")" ::: "memory")
#define PG8_WAIT_L(n) asm volatile("s_waitcnt lgkmcnt(" #n ")" ::: "memory")
#define PG8_BAR __builtin_amdgcn_s_barrier()
#define PG8_SCHED __builtin_amdgcn_sched_barrier(0)
    Unit cur, nxt; int ui = 0;
    if (!S.next(0, cur)) return;
    f32x4 acc[2][2][4][2];
#pragma unroll
    for (int a = 0; a < 2; ++a)
#pragma unroll
        for (int b = 0; b < 2; ++b)
#pragma unroll
            for (int m = 0; m < 4; ++m)
#pragma unroll
                for (int n = 0; n < 2; ++n) acc[a][b][m][n] = (f32x4){0.f, 0.f, 0.f, 0.f};
    bf16x8 At[4][2], B0[2][2], B1[2][2];
    const char* cA = cur.a; const char* cB = cur.b;
    PG8_STAGE(PG8_SB(0, 0), cB, voffB); PG8_STAGE(PG8_SB(0, 1), cB + hstepB, voffB); PG8_STAGE(PG8_SA(0, 0), cA, voffA); PG8_STAGE(PG8_SA(0, 1), cA + hstepA, voffA);
    if (wr == 1) PG8_BAR;
    PG8_WAIT_V(2); PG8_BAR;
    PG8_STAGE(PG8_SB(1, 0), cB + kstep, voffB); PG8_STAGE(PG8_SA(1, 0), cA + kstep, voffA); PG8_STAGE(PG8_SB(1, 1), cB + hstepB + kstep, voffB);
    PG8_WAIT_V(6); PG8_BAR;
    for (;;) {
        const bool has_next = S.next(ui + 1, nxt);
        const char* nA = has_next ? nxt.a : cA; const char* nB = has_next ? nxt.b : cB;
        for (int t = 0; t < nt; t += 2) {
            const bool last = (t == nt - 2);
            const char* a1 = cA + (size_t)(t + 1) * kstep;
            const char* a2 = last ? nA : cA + (size_t)(t + 2) * kstep; const char* b2 = last ? nB : cB + (size_t)(t + 2) * kstep;
            const char* a3 = a2 + kstep; const char* b3 = b2 + kstep;
            PG8_LDB(B0, 0, 0); if (!Q) PG8_LDB(B1, 0, 1); PG8_SCHED; PG8_LDA(At, 0, 0); PG8_STAGE(PG8_SA(1, 1), a1 + hstepA, voffA);
            PG8_WAIT_V(8); PG8_WAIT_L(0); PG8_BAR; PG8_MMA(0, 0, At, B0); if (!Q) PG8_MMA(0, 1, At, B1); PG8_BAR; PG8_SCHED;
            if (!Q) PG8_LDA(At, 0, 1); PG8_STAGE(PG8_SB(0, 0), b2, voffB); PG8_STAGE(PG8_SB(0, 1), b2 + hstepB, voffB); PG8_STAGE(PG8_SA(0, 0), a2, voffA);
            PG8_WAIT_V(8); PG8_WAIT_L(0); PG8_BAR; if (!Q) { PG8_MMA(1, 0, At, B0); PG8_MMA(1, 1, At, B1); } PG8_BAR; PG8_SCHED;
            PG8_LDB(B0, 1, 0); if (!Q) PG8_LDB(B1, 1, 1); PG8_SCHED; PG8_LDA(At, 1, 0); PG8_STAGE(PG8_SA(0, 1), a2 + hstepA, voffA);
            PG8_WAIT_V(8); PG8_WAIT_L(0); PG8_BAR; PG8_MMA(0, 0, At, B0); if (!Q) PG8_MMA(0, 1, At, B1); PG8_BAR; PG8_SCHED;
            if (!Q) PG8_LDA(At, 1, 1); PG8_STAGE(PG8_SB(1, 0), b3, voffB); PG8_STAGE(PG8_SB(1, 1), b3 + hstepB, voffB); PG8_STAGE(PG8_SA(1, 0), a3, voffA);
            PG8_WAIT_V(8); PG8_WAIT_L(0); PG8_BAR; if (!Q) { PG8_MMA(1, 0, At, B0); PG8_MMA(1, 1, At, B1); } PG8_BAR; PG8_SCHED;
        }
        if (wr == 0) PG8_BAR;
        E.template run<Q>(acc, cur, wr, wc, fr, fq);
        if (!has_next) break;
        if (!E.keep(cur)) {
#pragma unroll
        for (int a = 0; a < 2; ++a)
#pragma unroll
            for (int b = 0; b < 2; ++b)
#pragma unroll
                for (int m = 0; m < 4; ++m)
#pragma unroll
                    for (int n = 0; n < 2; ++n) acc[a][b][m][n] = (f32x4){0.f, 0.f, 0.f, 0.f};
        }
        cur = nxt; cA = nA; cB = nB; ++ui;
        if (wr == 1) PG8_BAR;
    }
    PG8_WAIT_V(0);
    PG8_BAR;
#undef PG8_SA
#undef PG8_SB
#undef PG8_STAGE
#undef PG8_LDA
#undef PG8_LDB
#undef PG8_MMA
#undef PG8_WAIT_V
#undef PG8_WAIT_L
#undef PG8_BAR
#undef PG8_SCHED
}

template <class Epi, class Sched>
__device__ __forceinline__ void gemm_quarter(LAS unsigned char* lds, const Gemm g, const Sched& S, const Epi& E) {
    int tid = threadIdx.x; asm volatile("" : "+v"(tid));
    const int wid = __builtin_amdgcn_readfirstlane(tid >> 6), lane = tid & 63, wr = wid >> 2, wc = wid & 3, fr = lane & 15, fq = lane >> 4;
    const int nt = g.K / BK;
    unsigned voffA[2], voffB[2];
#pragma unroll
    for (int i = 0; i < 2; ++i) { int R, C; stage_rc(tid * 16 + i * 8192, R, C); const int Rb = Epi::PERM ? ((R & ~31) + perm32(R & 31)) : R;
        voffA[i] = (unsigned)(R * g.lda + C) * 2u; voffB[i] = (unsigned)(Rb * g.ldb + C) * 2u; }
    const unsigned ldsw = (unsigned)wid * 1024u;
    const int aoff = lds_byte(wr * 64 + fr, fq * 8), boff = lds_byte(wc * 32 + fr, fq * 8);
#define GQ_STAGE(slot, ga, gb) do { _Pragma("unroll") for (int _i = 0; _i < 2; ++_i) { \
        __builtin_amdgcn_global_load_lds((const unsigned*)((const char*)(ga) + voffA[_i]), (LAS unsigned*)(lds + (slot) * 32768 + ldsw + _i * 8192), 16, 0, 0); \
        __builtin_amdgcn_global_load_lds((const unsigned*)((const char*)(gb) + voffB[_i]), (LAS unsigned*)(lds + (slot) * 32768 + 16384 + ldsw + _i * 8192), 16, 0, 0); } } while (0)
    f32x4 acc[2][2][4][2];
    Unit cur; bool kept = false;
    for (int ui = 0; S.next(ui, cur); ++ui) {
        if (!kept) {
#pragma unroll
            for (int m = 0; m < 4; ++m)
#pragma unroll
                for (int n = 0; n < 2; ++n) acc[0][0][m][n] = (f32x4){0.f, 0.f, 0.f, 0.f};
        }
        const char* cA = cur.a; const char* cB = cur.b;
#pragma unroll
        for (int s4 = 0; s4 < 4; ++s4) GQ_STAGE(s4, cA + (size_t)s4 * (BK * 2), cB + (size_t)s4 * (BK * 2));
        for (int t = 0; t < nt; ++t) {
            const int slot = t & 3;
            asm volatile("s_waitcnt vmcnt(12)" ::: "memory");
            __builtin_amdgcn_s_barrier();
            bf16x8 At[4][2], B0[2][2];
#pragma unroll
            for (int n = 0; n < 2; ++n)
#pragma unroll
                for (int k = 0; k < 2; ++k) B0[n][k] = *(const LAS bf16x8*)(lds + slot * 32768 + 16384 + boff + n * 2048 + k * 1024);
#pragma unroll
            for (int m = 0; m < 4; ++m)
#pragma unroll
                for (int k = 0; k < 2; ++k) At[m][k] = *(const LAS bf16x8*)(lds + slot * 32768 + aoff + m * 2048 + k * 1024);
            asm volatile("s_waitcnt lgkmcnt(0)" ::: "memory");
            __builtin_amdgcn_s_barrier();
            const int tn = (t + 4 < nt) ? t + 4 : 0;
            GQ_STAGE(slot, cA + (size_t)tn * (BK * 2), cB + (size_t)tn * (BK * 2));
#pragma unroll
            for (int m = 0; m < 4; ++m)
#pragma unroll
                for (int n = 0; n < 2; ++n)
#pragma unroll
                    for (int k = 0; k < 2; ++k) acc[0][0][m][n] = __builtin_amdgcn_mfma_f32_16x16x32_bf16(B0[n][k], At[m][k], acc[0][0][m][n], 0, 0, 0);
        }
        asm volatile("s_waitcnt vmcnt(0)" ::: "memory");
        __builtin_amdgcn_s_barrier();
        E.template run<true>(acc, cur, wr, wc, fr, fq);
        kept = E.keep(cur);
    }
#undef GQ_STAGE
}
}

template <class T> __device__ __forceinline__ T* asg(T* p) { return (T*)(__attribute__((address_space(1))) T*)(unsigned long long)p; }
struct WsPtrs {
    unsigned char* ws;
#define WSP(name, T, off) __device__ __forceinline__ T* name() const { return (T*)(ws + (off)); }
    WSP(U, bf16_t, WS_U) WSP(SZ, bf16_t, WS_SZ) WSP(QB, bf16_t, WS_QB) WSP(KB, bf16_t, WS_KB) WSP(VB, bf16_t, WS_VB) WSP(QC, bf16_t, WS_QC) WSP(KC, bf16_t, WS_KC) WSP(VC, bf16_t, WS_VC)
    WSP(G, bf16_t, WS_G) WSP(YG, bf16_t, WS_YG) WSP(Y, bf16_t, WS_Y) WSP(MX, bf16_t, WS_MX) WSP(A0, bf16_t, WS_A0) WSP(KCS, bf16_t, WS_KCS) WSP(VCS, bf16_t, WS_VCS) WSP(KBS, bf16_t, WS_KBS) WSP(VBS, bf16_t, WS_VBS)
    WSP(Y0, float, WS_Y0) WSP(SSQ0, float, WS_SSQ0) WSP(SSQ1, float, WS_SSQ1)
#undef WSP
};
#ifndef G_NATIVE
#define G_NATIVE 1
#endif
#if G_NATIVE
__device__ __forceinline__ size_t g_slot(int pm, int gt, int wv, int ai, int m, int bjx, int lane) { return ((((((size_t)pm * 48 + gt) * 8 + wv) * 2 + ai) * 4 + m) * 2 + bjx) * 64 + lane; }
#else
__device__ __forceinline__ size_t g_slot(int pm, int gt, int wv, int ai, int m, int bjx, int lane) { const int row = pm * 256 + ai * 128 + (wv >> 2) * 64 + m * 16 + (lane & 15); return (size_t)row * 1536 + gt * 32 + bjx * 16 + (wv & 3) * 4 + (lane >> 4); }
#endif
typedef unsigned short u16x2 __attribute__((ext_vector_type(2)));
__device__ __forceinline__ unsigned pkmin_u16(unsigned a, unsigned b) { return __builtin_bit_cast(unsigned, __builtin_elementwise_min(__builtin_bit_cast(u16x2, a), __builtin_bit_cast(u16x2, b))); }
__device__ __forceinline__ void st_bf16x8_cap(bf16_t* p, f32x4 v0, f32x4 v1) {
    u32x4 w; w.x = pkmin_u16(pk2(v0[0], v0[1]), 0x71497149u); w.y = pkmin_u16(pk2(v0[2], v0[3]), 0x71497149u); w.z = pkmin_u16(pk2(v1[0], v1[1]), 0x71497149u); w.w = pkmin_u16(pk2(v1[2], v1[3]), 0x71497149u); *(u32x4*)p = w;
}
__device__ __forceinline__ void st_bf16x8(bf16_t* p, f32x4 v0, f32x4 v1) {
    u32x4 w; w.x = pk2(v0[0], v0[1]); w.y = pk2(v0[2], v0[3]); w.z = pk2(v1[0], v1[1]); w.w = pk2(v1[2], v1[3]); *(u32x4*)p = w;
}
struct Epi1 {
    static constexpr bool PERM = true;
    __device__ __forceinline__ bool keep(const pg8::Unit&) const { return false; }
    const float* ssq; const float* gate_b; float* out; WsPtrs W; int layer;
    template <bool Q> __device__ __forceinline__ void run(f32x4 (&acc)[2][2][4][2], const pg8::Unit& u, int wr, int wc, int fr, int fq) const {
        constexpr int NAI = Q ? 1 : 2, NBJ = Q ? 1 : 2;
        const int sec = u.pn >> 2;
        const int colt = (u.pn & 3) * 256 + u.cs + wc * 32 + 8 * fq;
        int mode = 0, ld = 1024, coff = 0, special = 0; float scale = 1.f; bf16_t* base;
        if (sec >= 10) { mode = 2; base = W.G(); ld = 12288; coff = (sec - 10) * 1024; }
        else if (sec == 1 || sec == 5 || sec == 9) { mode = 1; base = W.SZ(); ld = 3072; coff = (sec == 1) ? 0 : (sec == 5 ? 1024 : 2048); }
        else { base = (sec == 0) ? W.U() : (sec == 2) ? W.QB() : (sec == 3) ? W.KB() : (sec == 4) ? W.VB() : (sec == 6) ? W.QC() : (sec == 7) ? W.KC() : W.VC();
               if (sec == 6) scale = 0.08838834764831845f * LOG2E; special = (sec == 4 || sec == 7 || sec == 8) ? sec : 0; }
        f32x4 bv[NBJ][2];
#pragma unroll
        for (int bj = 0; bj < NBJ; ++bj)
#pragma unroll
            for (int n = 0; n < 2; ++n) bv[bj][n] = (mode == 2) ? *(const f32x4*)(gate_b + coff + colt + bj * 128 + 4 * n) * (-LOG2E) : (f32x4){0.f, 0.f, 0.f, 0.f};
        const int l = layer, row0 = u.pm * 256 + wr * 64 + fr;
        float rs[NAI][4];
#pragma unroll
        for (int ai = 0; ai < NAI; ++ai)
#pragma unroll
            for (int m = 0; m < 4; ++m) rs[ai][m] = ssq[row0 + ai * 128 + m * 16];
#pragma unroll
        for (int ai = 0; ai < NAI; ++ai)
#pragma unroll
            for (int m = 0; m < 4; ++m) rs[ai][m] = __builtin_amdgcn_rsqf(rs[ai][m] * (1.0f / 4096.0f) + 1e-6f) * scale;
        if (mode == 2) scale = -LOG2E;
        bf16_t* const drow0 = base + (size_t)row0 * ld + coff + colt; const size_t rstep = (size_t)ld * 16;
#pragma unroll
        for (int ai = 0; ai < NAI; ++ai)
#pragma unroll
            for (int m = 0; m < 4; ++m) {
                const int row = row0 + ai * 128 + m * 16;
                bf16_t* d16 = drow0 + (size_t)(ai * 8 + m) * rstep; float* d32 = nullptr;
                if (special) {
                    if (!Q) { const int b = row >> 11, t = row & 2047;
                        if (special == 7) d32 = out + O_PSBK + ((size_t)l * MP + row) * 1024 + colt;
                        else if (special == 8) d32 = out + O_PSBV + ((size_t)l * MP + row) * 1024 + colt;
                        else if (t >= SEQ - BANDK) d32 = out + O_PBV + ((size_t)(l * NB + b) * BANDK + (t - (SEQ - BANDK))) * 1024 + colt;
                    } else { const int sr = row - MP, b = sr >> 4, t = sr & 15;
                        if (special == 7) { d16 = W.KCS() + ((size_t)(l * NB + b) * KCS_ROWS + PASTL + t) * 1024 + colt; d32 = out + O_SSBK + ((size_t)l * MS + sr) * 1024 + colt; }
                        else if (special == 8) { d16 = W.VCS() + ((size_t)(l * NB + b) * KCS_ROWS + PASTL + t) * 1024 + colt; d32 = out + O_SSBV + ((size_t)l * MS + sr) * 1024 + colt; }
                        else { d16 = W.VBS() + ((size_t)(l * NB + b) * KBS_ROWS + BANDK + t) * 1024 + colt; d32 = out + O_SBV + ((size_t)l * MS + sr) * 1024 + colt; }
                    }
                }
#pragma unroll
                for (int bj = 0; bj < NBJ; ++bj) {
                    if (mode == 2) {
                        const float nrs = rs[ai][m] * scale;
                        f32x4 v0 = acc[ai][bj][m][0] * nrs + bv[bj][0], v1 = acc[ai][bj][m][1] * nrs + bv[bj][1];
#pragma unroll
                        for (int j = 0; j < 4; ++j) { v0[j] = ex2(v0[j]); v1[j] = ex2(v1[j]); }
                        v0 = v0 + 1.0f; v1 = v1 + 1.0f;
                        st_bf16x8_cap(W.G() + 8 * g_slot(u.pm, u.pn - 40, wr * 4 + wc, ai, m, bj + (u.cs >> 7), fq * 16 + fr), v0, v1);
                    } else {
                    f32x4 v0 = acc[ai][bj][m][0] * rs[ai][m], v1 = acc[ai][bj][m][1] * rs[ai][m];
                    if (mode == 1) {
#pragma unroll
                        for (int j = 0; j < 4; ++j) { v0[j] = v0[j] * sigmoidf_(v0[j]); v1[j] = v1[j] * sigmoidf_(v1[j]); } }
                    st_bf16x8(d16 + bj * 128, v0, v1);
                    if (d32) { __builtin_nontemporal_store(v0, (f32x4*)(d32 + bj * 128)); __builtin_nontemporal_store(v1, (f32x4*)(d32 + bj * 128 + 4)); }
                    }
                }
            }
    }
};
struct EpiNull {
    static constexpr bool PERM = true;
    __device__ __forceinline__ bool keep(const pg8::Unit&) const { return false; }
    float* sink;
    template <bool Q> __device__ __forceinline__ void run(f32x4 (&acc)[2][2][4][2], const pg8::Unit& u, int wr, int wc, int fr, int fq) const {
        float s = 0.f;
#pragma unroll
        for (int ai = 0; ai < 2; ++ai)
#pragma unroll
            for (int bj = 0; bj < 2; ++bj)
#pragma unroll
                for (int m = 0; m < 4; ++m)
#pragma unroll
                    for (int n = 0; n < 2; ++n) s += (acc[ai][bj][m][n][0] + acc[ai][bj][m][n][1]) + (acc[ai][bj][m][n][2] + acc[ai][bj][m][n][3]);
        if (s == 1.2345e30f) sink[u.pm + u.pn + wr + wc + fr + fq] = s;
    }
};
struct EpiGlu {
    static constexpr bool PERM = true;
    __device__ __forceinline__ bool keep(const pg8::Unit&) const { return false; }
    const float* bglu; WsPtrs W;
    template <bool Q> __device__ __forceinline__ void run(f32x4 (&acc)[2][2][4][2], const pg8::Unit& u, int wr, int wc, int fr, int fq) const {
        constexpr int NAI = Q ? 1 : 2, NBJ = Q ? 1 : 2;
        const int colt = u.pn * 256 + u.cs + wc * 32 + 8 * fq, row0 = u.pm * 256 + wr * 64 + fr;
        f32x4 bv[NBJ][2];
#pragma unroll
        for (int bj = 0; bj < NBJ; ++bj)
#pragma unroll
            for (int n = 0; n < 2; ++n) bv[bj][n] = *(const f32x4*)(bglu + colt + bj * 128 + 4 * n);
#pragma unroll
        for (int aim = 0; aim < 2 * NAI; ++aim) { const int ai = aim >> 1, mb = (aim & 1) * 2;
            u32x4 yg[4][NBJ], sz[4][NBJ];
#pragma unroll
            for (int m = mb; m < mb + 2; ++m)
#pragma unroll
                for (int bj = 0; bj < NBJ; ++bj) { const int row = row0 + ai * 128 + m * 16, col = colt + bj * 128;
                    yg[m][bj] = __builtin_nontemporal_load((const u32x4*)(W.YG() + (size_t)row * 1024 + col)); sz[m][bj] = __builtin_nontemporal_load((const u32x4*)(W.SZ() + (size_t)row * 3072 + col)); }
#pragma unroll
            for (int m = mb; m < mb + 2; ++m)
#pragma unroll
                for (int bj = 0; bj < NBJ; ++bj) { const int row = row0 + ai * 128 + m * 16, col = colt + bj * 128;
                    const u32x4 y = yg[m][bj], z = sz[m][bj];
                    f32x4 v0 = acc[ai][bj][m][0] + bv[bj][0], v1 = acc[ai][bj][m][1] + bv[bj][1];
                    v0[0] = bflo(y.x) * sigmoidf_(v0[0]) * bflo(z.x); v0[1] = bfhi(y.x) * sigmoidf_(v0[1]) * bfhi(z.x);
                    v0[2] = bflo(y.y) * sigmoidf_(v0[2]) * bflo(z.y); v0[3] = bfhi(y.y) * sigmoidf_(v0[3]) * bfhi(z.y);
                    v1[0] = bflo(y.z) * sigmoidf_(v1[0]) * bflo(z.z); v1[1] = bfhi(y.z) * sigmoidf_(v1[1]) * bfhi(z.z);
                    v1[2] = bflo(y.w) * sigmoidf_(v1[2]) * bflo(z.w); v1[3] = bfhi(y.w) * sigmoidf_(v1[3]) * bfhi(z.w);
                    st_bf16x8(W.Y() + (size_t)row * 3072 + col, v0, v1); }
        }
    }
};
struct EpiBr {
    static constexpr bool PERM = true;
    WsPtrs W;
    __device__ __forceinline__ bool keep(const pg8::Unit& u) const { return u.aux < 2; }
    template <bool Q> __device__ __forceinline__ void run(f32x4 (&acc)[2][2][4][2], const pg8::Unit& u, int wr, int wc, int fr, int fq) const {
        constexpr int NAI = Q ? 1 : 2, NBJ = Q ? 1 : 2;
        const int colt = u.pn * 256 + u.cs + wc * 32 + 8 * fq, br = u.aux, row0 = u.pm * 256 + wr * 64 + fr;
        if (br < 2) {
#pragma unroll
            for (int ai = 0; ai < NAI; ++ai) { constexpr int mb = 0;
                u32x4 gn[4][NBJ], gd[4][NBJ];
#pragma unroll
                for (int m = mb; m < mb + 4; ++m)
#pragma unroll
                    for (int bj = 0; bj < NBJ; ++bj) { const int bjx = bj + (u.cs >> 7), wv = wr * 4 + wc, ln = fq * 16 + fr;
                        gn[m][bj] = __builtin_nontemporal_load((const u32x4*)(W.G() + 8 * g_slot(u.pm, br * 16 + u.pn, wv, ai, m, bjx, ln))); gd[m][bj] = __builtin_nontemporal_load((const u32x4*)(W.G() + 8 * g_slot(u.pm, (br + 1) * 16 + u.pn, wv, ai, m, bjx, ln))); }
#pragma unroll
                for (int m = mb; m < mb + 4; ++m)
#pragma unroll
                    for (int bj = 0; bj < NBJ; ++bj) { const u32x4 a = gn[m][bj], d = gd[m][bj]; f32x4& v0 = acc[ai][bj][m][0]; f32x4& v1 = acc[ai][bj][m][1];
#define RAT(de, nu) ((nu) * __builtin_amdgcn_rcpf(de))
                        v0[0] *= RAT(bflo(a.x), bflo(d.x)); v0[1] *= RAT(bfhi(a.x), bfhi(d.x)); v0[2] *= RAT(bflo(a.y), bflo(d.y)); v0[3] *= RAT(bfhi(a.y), bfhi(d.y));
                        v1[0] *= RAT(bflo(a.z), bflo(d.z)); v1[1] *= RAT(bfhi(a.z), bfhi(d.z)); v1[2] *= RAT(bflo(a.w), bflo(d.w)); v1[3] *= RAT(bfhi(a.w), bfhi(d.w));
#undef RAT
                    }
            }
        } else {
#pragma unroll
            for (int ai = 0; ai < NAI; ++ai) {
                u32x4 g2[4][NBJ];
#pragma unroll
                for (int m = 0; m < 4; ++m)
#pragma unroll
                    for (int bj = 0; bj < NBJ; ++bj) g2[m][bj] = __builtin_nontemporal_load((const u32x4*)(W.G() + 8 * g_slot(u.pm, 32 + u.pn, wr * 4 + wc, ai, m, bj + (u.cs >> 7), fq * 16 + fr)));
#pragma unroll
                for (int m = 0; m < 4; ++m)
#pragma unroll
                    for (int bj = 0; bj < NBJ; ++bj) { const u32x4 g = g2[m][bj]; const f32x4 v0 = acc[ai][bj][m][0], v1 = acc[ai][bj][m][1];
                        f32x4 o0, o1;
                        o0[0] = v0[0] * __builtin_amdgcn_rcpf(bflo(g.x)); o0[1] = v0[1] * __builtin_amdgcn_rcpf(bfhi(g.x)); o0[2] = v0[2] * __builtin_amdgcn_rcpf(bflo(g.y)); o0[3] = v0[3] * __builtin_amdgcn_rcpf(bfhi(g.y));
                        o1[0] = v1[0] * __builtin_amdgcn_rcpf(bflo(g.z)); o1[1] = v1[1] * __builtin_amdgcn_rcpf(bfhi(g.z)); o1[2] = v1[2] * __builtin_amdgcn_rcpf(bflo(g.w)); o1[3] = v1[3] * __builtin_amdgcn_rcpf(bfhi(g.w));
                        st_bf16x8(W.MX() + (size_t)(row0 + ai * 128 + m * 16) * 4096 + colt + bj * 128, o0, o1); }
            }
        }
    }
};
struct EpiOut {
    static constexpr bool PERM = false;
    __device__ __forceinline__ bool keep(const pg8::Unit&) const { return false; }
    const float* xp; const float* xs; const float* ng1; float* out; WsPtrs W; int layer;
    template <bool Q> __device__ __forceinline__ void run(f32x4 (&acc)[2][2][4][2], const pg8::Unit& u, int wr, int wc, int fr, int fq) const {
        constexpr int NAI = Q ? 1 : 2, NBJ = Q ? 1 : 2;
        const int colt = u.pn * 256 + u.cs + wc * 32 + 4 * fq, row0 = u.pm * 256 + wr * 64 + fr;
        f32x4 gg[NBJ][2];
#pragma unroll
        for (int bj = 0; bj < NBJ; ++bj)
#pragma unroll
            for (int n = 0; n < 2; ++n) gg[bj][n] = (layer == 0) ? *(const f32x4*)(ng1 + colt + bj * 128 + n * 16) : (f32x4){0.f, 0.f, 0.f, 0.f};
#pragma unroll
        for (int aim = 0; aim < 2 * NAI; ++aim) { const int ai = aim >> 1, mb = (aim & 1) * 2;
            f32x4 rv[4][NBJ][2];
#pragma unroll
            for (int m = mb; m < mb + 2; ++m) { const int row = row0 + ai * 128 + m * 16;
                const float* res = (layer == 0) ? (Q ? xs + (size_t)(row - MP) * DM : xp + (size_t)row * DM) : W.Y0() + (size_t)row * DM;
#pragma unroll
                for (int bj = 0; bj < NBJ; ++bj)
#pragma unroll
                    for (int n = 0; n < 2; ++n) rv[m][bj][n] = __builtin_nontemporal_load((const f32x4*)(res + colt + bj * 128 + n * 16)); }
#pragma unroll
            for (int m = mb; m < mb + 2; ++m) { const int row = row0 + ai * 128 + m * 16;
                float* dst = (layer == 0) ? W.Y0() + (size_t)row * DM : (Q ? out + O_YS + (size_t)(row - MP) * DM : out + O_YP + (size_t)row * DM);
                float ss = 0.f;
#pragma unroll
                for (int bj = 0; bj < NBJ; ++bj)
#pragma unroll
                    for (int n = 0; n < 2; ++n) { const int col = colt + bj * 128 + n * 16;
                        const f32x4 y = acc[ai][bj][m][n] + rv[m][bj][n];
                        __builtin_nontemporal_store(y, (f32x4*)(dst + col));
                        if (layer == 0) { const f32x4 g4 = gg[bj][n]; ss += (y[0] * y[0] + y[1] * y[1]) + (y[2] * y[2] + y[3] * y[3]);
                            u32x2 w; w.x = pk2(y[0] * g4[0], y[1] * g4[1]); w.y = pk2(y[2] * g4[2], y[3] * g4[3]); *(u32x2*)(W.A0() + (size_t)row * DM + col) = w; } }
                if (layer == 0) { ss += __shfl_xor(ss, 16); ss += __shfl_xor(ss, 32); if (fq == 0) atomicAdd(W.SSQ1() + row, ss); }
            }
        }
    }
};

#define XB_TMO      128
#define XB_XCNT(j)  (256  + 64 * (j))
#define XB_XSUB(j)  (1280 + 64 * (j))
#define XB_XGEN(j)  (2304 + 64 * (j))
#define XB_TOP      3328
#define XB_TOPGEN   3392
#define XCD_BAR_WORDS 3456
#define XB_SPIN_CAP (1u << 22)
__device__ __forceinline__ unsigned xb_ld(unsigned* p)              { return __hip_atomic_load(p, __ATOMIC_RELAXED, __HIP_MEMORY_SCOPE_AGENT); }
__device__ __forceinline__ unsigned xb_add(unsigned* p, unsigned v) { return __hip_atomic_fetch_add(p, v, __ATOMIC_RELAXED, __HIP_MEMORY_SCOPE_AGENT); }
__device__ __forceinline__ unsigned xb_xcc_id() { return (unsigned)__builtin_amdgcn_s_getreg((3 << 11) | 20) & 0xFu; }
#define XB_SPIN(cond, bar) do { unsigned _sp = 0; while (cond) { __builtin_amdgcn_s_sleep(1); \
    if ((++_sp & 255u) == 0u) { if (xb_ld(&(bar)[XB_TMO])) break; if (_sp > XB_SPIN_CAP) { atomicAdd(&(bar)[XB_TMO], 1u); break; } } } } while (0)
struct XcdBarrier { unsigned* bar; unsigned x; volatile LAS unsigned* st; };
__device__ __forceinline__ XcdBarrier xcd_barrier_post(unsigned* bar, volatile LAS unsigned* st) {
    XcdBarrier b; b.bar = bar; b.x = xb_xcc_id(); b.st = st;
    if (threadIdx.x == 0) (void)xb_add(&bar[XB_XCNT(b.x)], 1u);
    return b;
}
__device__ __forceinline__ void xcd_barrier_complete(unsigned* bar, unsigned x, unsigned& nloc, unsigned& nx) {
    const unsigned G = gridDim.x * gridDim.y * gridDim.z;
    unsigned sum, cnt, mine, sp = 0u;
    for (;;) {
        sum = 0u; cnt = 0u; mine = 0u;
#pragma unroll
        for (unsigned j = 0; j < 16; ++j) { const unsigned c = xb_ld(&bar[XB_XCNT(j)]); sum += c; cnt += (c > 0u) ? 1u : 0u; mine = (j == x) ? c : mine; }
        if (sum == G) break;
        __builtin_amdgcn_s_sleep(1);
        if ((++sp & 255u) == 0u) { if (xb_ld(&bar[XB_TMO])) break; if (sp > XB_SPIN_CAP) { atomicAdd(&bar[XB_TMO], 1u); break; } }
    }
    nloc = mine > 0u ? mine : 1u; nx = cnt > 0u ? cnt : 1u;
}
__device__ __forceinline__ void xcd_barrier(const XcdBarrier& b) {
    asm volatile("s_waitcnt vmcnt(0)" ::: "memory");
    __syncthreads();
    if (threadIdx.x == 0) {
        unsigned* bar = b.bar;
        __builtin_amdgcn_s_waitcnt(0);
        unsigned nloc = b.st[0], nx = b.st[1];
        if (nloc == 0u) { xcd_barrier_complete(bar, b.x, nloc, nx); b.st[0] = nloc; b.st[1] = nx; }
        const unsigned old = xb_add(&bar[XB_XSUB(b.x)], 1u);
        const unsigned gen = old / nloc;
        if (old + 1u == (gen + 1u) * nloc) {
            __builtin_amdgcn_fence(__ATOMIC_RELEASE, "agent");
            asm volatile("s_waitcnt vmcnt(0)" ::: "memory");
            const unsigned og = xb_add(&bar[XB_TOP], 1u);
            const unsigned tg = og / nx;
            if (og + 1u == (tg + 1u) * nx) xb_add(&bar[XB_TOPGEN], 1u);
            else XB_SPIN(xb_ld(&bar[XB_TOPGEN]) == tg, bar);
            __builtin_amdgcn_fence(__ATOMIC_ACQUIRE, "agent");
            xb_add(&bar[XB_XGEN(b.x)], 1u);
            asm volatile("s_waitcnt vmcnt(0)" ::: "memory");
        } else {
            XB_SPIN(xb_ld(&bar[XB_XGEN(b.x)]) == gen, bar);
            __builtin_amdgcn_fence(__ATOMIC_ACQUIRE, "agent");
            asm volatile("s_waitcnt vmcnt(0)" ::: "memory");
        }
    }
    __syncthreads();
}

__device__ __forceinline__ void transpose_item(const float* W, int K, int N, bf16_t* WT, LAS float* scr, int item, int lane_) {
    int lane = lane_; asm volatile("" : "+v"(lane));
    const int sup = item >> 3, sub = item & 7, nsup = N / 128, kb4 = sup / nsup, nb2 = sup - kb4 * nsup, kb = 4 * kb4 + (sub >> 1), nb = 2 * nb2 + (sub & 1), k0 = 64 * kb, n0 = 64 * nb;
    const int kq = lane >> 4, nq = lane & 15;
    f32x4 tv[16];
#pragma unroll
    for (int i = 0; i < 16; ++i) tv[i] = __builtin_nontemporal_load((const f32x4*)(W + (size_t)(k0 + 4 * i + kq) * N + n0 + 4 * nq));
#pragma unroll
    for (int i = 0; i < 16; ++i) { const int kk = 4 * i + kq; const f32x4 v = tv[i];
        LAS float* s = scr + kk * 65 + 4 * nq; s[0] = v[0]; s[1] = v[1]; s[2] = v[2]; s[3] = v[3]; }
    LDS_WAIT();
    const int c = lane & 7, nl = lane >> 3;
#pragma unroll
    for (int j = 0; j < 8; ++j) { const int n = 8 * j + nl; const LAS float* s = scr + (8 * c) * 65 + n;
        u32x4 o; o.x = pk2(s[0 * 65], s[1 * 65]); o.y = pk2(s[2 * 65], s[3 * 65]); o.z = pk2(s[4 * 65], s[5 * 65]); o.w = pk2(s[6 * 65], s[7 * 65]);
        *(u32x4*)(WT + (size_t)(n0 + n) * K + k0 + 8 * c) = o; }
    LDS_WAIT();
}
__device__ __forceinline__ float wave_sum(float v) {
#pragma unroll
    for (int o = 1; o < 64; o <<= 1) v += __shfl_xor(v, o);
    return v;
}
__device__ __forceinline__ void xrow_to_a0(const float* xrow, const float* g, bf16_t* orow, float* ssq, int lane) {
    float s = 0.f;
#pragma unroll 4
    for (int j = 0; j < 16; ++j) { const f32x4 v = __builtin_nontemporal_load((const f32x4*)xrow + lane + 64 * j), gg = *((const f32x4*)g + lane + 64 * j);
        s += (v[0] * v[0] + v[1] * v[1]) + (v[2] * v[2] + v[3] * v[3]);
        u32x2 w; w.x = pk2(v[0] * gg[0], v[1] * gg[1]); w.y = pk2(v[2] * gg[2], v[3] * gg[3]); *((u32x2*)orow + lane + 64 * j) = w; }
    s = wave_sum(s);
    if (lane == 0) *ssq = s;
}

constexpr int SSM_PITCH = 132, SSM_TP = 36, SSM_WAVE_BYTES = 128 * SSM_TP * 4 + 1024;
static_assert(128 * SSM_TP >= 32 * SSM_PITCH, "h image fits the Bu^T region");
template <int NT> __device__ __forceinline__ void ssm_unit(LAS float* S, const unsigned char* ws, const float* dskip_l, int l, int g, const bf16_t* U, bf16_t* YG, int row0, int ntok,
                                         const float* h0re, const float* h0im, float* ore, float* oim, int lane_) {
    int lane = lane_; asm volatile("" : "+v"(lane));
    const int r32 = lane & 31, hi = lane >> 5, p16 = lane & 15, q4 = lane >> 4;
    LAS bf16_t* Us = (LAS bf16_t*)(S + 128 * SSM_TP);
    const f32x2 ab = *((const f32x2*)(ws + WS_ABAR) + (size_t)(l * NG + g) * NST + lane);
    const float ar = ab[0], ai = ab[1];
    bf16x8 bmf[4], cmf[4];
    const bf16_t* BMT = (const bf16_t*)(ws + WS_BMT) + (size_t)(l * NG + g) * 128 * 16;
    const bf16_t* CMT = (const bf16_t*)(ws + WS_CMT) + (size_t)(l * NG + g) * 16 * 128;
#pragma unroll
    for (int nb = 0; nb < 4; ++nb) bmf[nb] = *(const bf16x8*)(BMT + (size_t)(32 * nb + r32) * 16 + 8 * hi);
#pragma unroll
    for (int kb = 0; kb < 4; ++kb) cmf[kb] = *(const bf16x8*)(CMT + (size_t)p16 * 128 + 32 * kb + 8 * q4);
    const float dsk = dskip_l[16 * g + p16];
    float hr = h0re ? h0re[lane] : 0.f, hm = h0im ? h0im[lane] : 0.f;
    const bf16_t* up = U + (size_t)(row0 + r32) * 1024 + 16 * g + 8 * hi;
    bf16x8 uf = __builtin_nontemporal_load((const bf16x8*)up);
    for (int t0 = 0; t0 < ntok; t0 += 32) {
        const bf16x8 ucur = uf;
        if (t0 + 32 < ntok) uf = __builtin_nontemporal_load((const bf16x8*)(up + (size_t)(t0 + 32) * 1024));
        *(LAS bf16x8*)(Us + r32 * 16 + 8 * hi) = ucur;
#pragma unroll
        for (int nb = 0; nb < 4; ++nb) {
            f32x16 acc = {};
            acc = __builtin_amdgcn_mfma_f32_32x32x16_bf16(ucur, bmf[nb], acc, 0, 0, 0);
#pragma unroll
            for (int q = 0; q < 4; ++q) *(LAS f32x4*)(S + (32 * nb + r32) * SSM_TP + 8 * q + 4 * hi) = (f32x4){acc[4 * q], acc[4 * q + 1], acc[4 * q + 2], acc[4 * q + 3]};
        }
        LDS_WAIT();
        f32x4 br[NT / 4], bi[NT / 4];
#pragma unroll
        for (int t4 = 0; t4 < NT / 4; ++t4) { br[t4] = *(const LAS f32x4*)(S + lane * SSM_TP + 4 * t4); bi[t4] = *(const LAS f32x4*)(S + (64 + lane) * SSM_TP + 4 * t4); }
        LDS_WAIT();
#pragma unroll
        for (int t = 0; t < NT; ++t) {
            const float nr = ar * hr - ai * hm + br[t >> 2][t & 3], ni = ar * hm + ai * hr + bi[t >> 2][t & 3];
            hr = nr; hm = ni;
            S[t * SSM_PITCH + lane] = hr; S[t * SSM_PITCH + 64 + lane] = hm;
        }
        LDS_WAIT();
#pragma unroll
        for (int th = 0; th < NT / 16; ++th) {
            f32x4 ya = {0.f, 0.f, 0.f, 0.f};
#pragma unroll
            for (int kb = 0; kb < 4; ++kb) {
                const LAS float* sp = S + (16 * th + p16) * SSM_PITCH + 32 * kb + 8 * q4;
                const f32x4 a0 = *(const LAS f32x4*)sp, a1 = *(const LAS f32x4*)(sp + 4);
                u32x4 w; w.x = pk2(a0[0], a0[1]); w.y = pk2(a0[2], a0[3]); w.z = pk2(a1[0], a1[1]); w.w = pk2(a1[2], a1[3]);
                ya = __builtin_amdgcn_mfma_f32_16x16x32_bf16(__builtin_bit_cast(bf16x8, w), cmf[kb], ya, 0, 0, 0);
            }
#pragma unroll
            for (int j = 0; j < 4; ++j) {
                const int tl = 16 * th + 4 * q4 + j, tt = t0 + tl;
                const float y = ya[j] + dsk * bf2f(Us[tl * 16 + p16]);
                const float ge = y * __builtin_amdgcn_rcpf(1.0f + ex2(-2.3022081985f * y * (1.0f + 0.044715f * y * y)));
                YG[(size_t)(row0 + tt) * 1024 + 16 * g + p16] = f2bf(ge);
            }
        }
        LDS_WAIT();
    }
    ore[lane] = hr; oim[lane] = hm;
}

namespace att {
constexpr int L_V = 0, L_K = 16384, L_BUF = 32768, L_WS = 65536, L_BIAS = 67584, L_FLAG = 68864, L_OST = 73728;
#define KSWZ(row, colB) ((row) * 256 + ((colB) ^ (((row) & 7) << 4)))
#define SBAR() __builtin_amdgcn_sched_barrier(0)
__device__ __forceinline__ int crow(int r, int hi) { return (r & 3) + 8 * (r >> 2) + 4 * hi; }
__device__ __forceinline__ int v_st(int k, int c) { const int kk = (k & ~0xC) | ((k & 4) << 1) | ((k & 8) >> 1); return ((kk >> 3) * 4 + (c >> 5)) * 512 + ((kk & 7) * 32 + (c & 31)) * 2; }
__device__ __forceinline__ int v_rd_base(int lane) { return ((lane & 3) << 3) | (((lane >> 2) & 3) << 6) | (((lane >> 4) & 1) << 5) | (((lane >> 5) & 1) << 8); }
constexpr int v_rd_off(int d0, int ks, int half) { return d0 * 512 + ks * 4096 + half * 2048; }
template <int OFF> __device__ __forceinline__ s16x4 tr_read(int vb) {
    s16x4 r; asm volatile("ds_read_b64_tr_b16 %0, %1 offset:%2" : "=&v"(r) : "v"(vb), "i"(OFF) : "memory"); return r;
}
template <int D0> __device__ __forceinline__ void pv_one(f32x16& od, int vb, bf16x8 pa0, bf16x8 pa1, bf16x8 pa2, bf16x8 pa3) {
    const s16x4 l0 = tr_read<v_rd_off(D0, 0, 0)>(vb), h0 = tr_read<v_rd_off(D0, 0, 1)>(vb), l1 = tr_read<v_rd_off(D0, 1, 0)>(vb), h1 = tr_read<v_rd_off(D0, 1, 1)>(vb);
    const s16x4 l2 = tr_read<v_rd_off(D0, 2, 0)>(vb), h2 = tr_read<v_rd_off(D0, 2, 1)>(vb), l3 = tr_read<v_rd_off(D0, 3, 0)>(vb), h3 = tr_read<v_rd_off(D0, 3, 1)>(vb);
    asm volatile("s_waitcnt lgkmcnt(0)" ::: "memory"); SBAR();
#define PK(L, H) (bf16x8){L[0], L[1], L[2], L[3], H[0], H[1], H[2], H[3]}
    od = __builtin_amdgcn_mfma_f32_32x32x16_bf16(pa0, PK(l0, h0), od, 0, 0, 0);
    od = __builtin_amdgcn_mfma_f32_32x32x16_bf16(pa1, PK(l1, h1), od, 0, 0, 0);
    od = __builtin_amdgcn_mfma_f32_32x32x16_bf16(pa2, PK(l2, h2), od, 0, 0, 0);
    od = __builtin_amdgcn_mfma_f32_32x32x16_bf16(pa3, PK(l3, h3), od, 0, 0, 0);
#undef PK
}
__device__ __forceinline__ void pv_d0(f32x16* o, int vb, bf16x8 pa0, bf16x8 pa1, bf16x8 pa2, bf16x8 pa3) {
    pv_one<0>(o[0], vb, pa0, pa1, pa2, pa3); pv_one<1>(o[1], vb, pa0, pa1, pa2, pa3); pv_one<2>(o[2], vb, pa0, pa1, pa2, pa3); pv_one<3>(o[3], vb, pa0, pa1, pa2, pa3);
}
__device__ __forceinline__ void qkt(f32x16& p0, f32x16& p1, const LAS unsigned char* Ks, const LAS unsigned char* Qs, int r32, int hi) {
    p0 = f32x16{}; p1 = f32x16{};
    bf16x8 b0[2], b1[2], q[2];
    { const int cb = (hi * 8) * 2; b0[0] = *(const LAS bf16x8*)(Ks + KSWZ(r32, cb)); b1[0] = *(const LAS bf16x8*)(Ks + KSWZ(32 + r32, cb)); q[0] = *(const LAS bf16x8*)(Qs + KSWZ(r32, cb)); }
#pragma unroll
    for (int d0 = 0; d0 < 8; ++d0) { const int c = d0 & 1, n = c ^ 1;
        if (d0 < 7) { const int cb = ((d0 + 1) * 16 + hi * 8) * 2;
            b0[n] = *(const LAS bf16x8*)(Ks + KSWZ(r32, cb)); b1[n] = *(const LAS bf16x8*)(Ks + KSWZ(32 + r32, cb)); q[n] = *(const LAS bf16x8*)(Qs + KSWZ(r32, cb)); }
        if (d0 < 7) asm volatile("s_waitcnt lgkmcnt(3)" ::: "memory"); else asm volatile("s_waitcnt lgkmcnt(0)" ::: "memory");
        SBAR();
        p0 = __builtin_amdgcn_mfma_f32_32x32x16_bf16(b0[c], q[c], p0, 0, 0, 0);
        p1 = __builtin_amdgcn_mfma_f32_32x32x16_bf16(b1[c], q[c], p1, 0, 0, 0);
        SBAR(); }
}
__device__ __forceinline__ void qkt_half(f32x16& p, const LAS unsigned char* Ks, const LAS unsigned char* Qs, int r32, int hi, int half) {
    p = f32x16{};
    bf16x8 b0[2], q[2];
    { const int cb = (hi * 8) * 2; b0[0] = *(const LAS bf16x8*)(Ks + KSWZ(32 * half + r32, cb)); q[0] = *(const LAS bf16x8*)(Qs + KSWZ(r32, cb)); }
#pragma unroll
    for (int d0 = 0; d0 < 8; ++d0) { const int c = d0 & 1, n = c ^ 1;
        if (d0 < 7) { const int cb = ((d0 + 1) * 16 + hi * 8) * 2; b0[n] = *(const LAS bf16x8*)(Ks + KSWZ(32 * half + r32, cb)); q[n] = *(const LAS bf16x8*)(Qs + KSWZ(r32, cb)); }
        if (d0 < 7) asm volatile("s_waitcnt lgkmcnt(2)" ::: "memory"); else asm volatile("s_waitcnt lgkmcnt(0)" ::: "memory");
        SBAR();
        p = __builtin_amdgcn_mfma_f32_32x32x16_bf16(b0[c], q[c], p, 0, 0, 0);
        SBAR(); }
}
#define PK4(P, BASE, OUT) do { unsigned a0 = pk2(P[BASE + 0], P[BASE + 1]), a1 = pk2(P[BASE + 2], P[BASE + 3]);   \
    unsigned b0 = pk2(P[BASE + 4], P[BASE + 5]), b1 = pk2(P[BASE + 6], P[BASE + 7]);                              \
    auto r0 = __builtin_amdgcn_permlane32_swap(a0, b0, false, false); auto r1 = __builtin_amdgcn_permlane32_swap(a1, b1, false, false); \
    u32x4 w = {r0[0], r1[0], r0[1], r1[1]}; OUT = __builtin_bit_cast(bf16x8, w); } while (0)
__device__ __forceinline__ float swap_max(float v) { auto rr = __builtin_amdgcn_permlane32_swap(__float_as_uint(v), __float_as_uint(v), false, false); return fmaxf(__uint_as_float(rr[0]), __uint_as_float(rr[1])); }
__device__ __forceinline__ float swap_add(float v) { auto rr = __builtin_amdgcn_permlane32_swap(__float_as_uint(v), __float_as_uint(v), false, false); return __uint_as_float(rr[0]) + __uint_as_float(rr[1]); }

struct Desc {
    const bf16_t* Q;
    const bf16_t* K; const bf16_t* V;
    const bf16_t* SZ; bf16_t* Y;
    const float* bias;
    int qpos0, nvalid, nkeys;
};
template <int TYPE>
__device__ __forceinline__ void unit(LAS unsigned char* lds, const Desc& d) {
    int tid = threadIdx.x; asm volatile("" : "+v"(tid));
    const int wid = __builtin_amdgcn_readfirstlane(tid >> 6), lane = tid & 63, r32 = lane & 31, hi = lane >> 5;
    LAS float* wsf = (LAS float*)(lds + L_WS) + wid * 64;
    LAS float* biasL = (LAS float*)(lds + L_BIAS);
    volatile LAS unsigned* flags = (volatile LAS unsigned*)(lds + L_FLAG);
    const bool wvalid = (32 * wid < d.nvalid);
    const int qpos = d.qpos0 + 32 * wid + r32;
    const int cw = (d.qpos0 + 32 * wid) >> 6;
    const bool rowinvalid = (32 * wid + r32) >= d.nvalid;
    int t_lo, t_hi;
    if (TYPE == 0) { const int c0 = d.qpos0 >> 6; t_lo = c0 - 8 > 0 ? c0 - 8 : 0; t_hi = c0 + 3; const int tk = (d.nkeys - 1) >> 6; if (t_hi > tk) t_hi = tk; }
    else { t_lo = 0; t_hi = (d.qpos0 + 255) >> 6; const int tk = (d.nkeys - 1) >> 6; if (t_hi > tk) t_hi = tk; }
    __syncthreads();
    if (TYPE == 0) { for (int i = tid; i < 257; i += 512) biasL[i] = d.bias[i] * LOG2E; }
    if (TYPE == 1) { if (tid < 16) flags[tid] = (32 * (tid & 7) < d.nvalid) ? 0u : 1u; }
    LAS unsigned char* Ql = lds + L_OST + wid * 8192;
    if (wvalid) {
#pragma unroll
        for (int d0 = 0; d0 < 8; ++d0) { const bf16x8 qv = __builtin_nontemporal_load((const bf16x8*)(d.Q + (size_t)(32 * wid + r32) * 1024 + d0 * 16 + hi * 8)); *(LAS bf16x8*)(Ql + KSWZ(r32, (d0 * 16 + hi * 8) * 2)) = qv; }
    }
    const int sr = tid >> 4, sc = (tid & 15) * 8, vst0 = v_st(sr, sc), vst1 = v_st(32 + sr, sc), kst0 = KSWZ(sr, sc * 2), kst1 = KSWZ(32 + sr, sc * 2);
    const int vbase = (int)(unsigned)(uintptr_t)(lds + L_V) + v_rd_base(lane);
    bf16x8 sv0, sv1, sk0, sk1;
#define SLOAD(T_) do { const size_t k0_ = (size_t)(T_) * 64; sv0 = *(const bf16x8*)(d.V + (k0_ + sr) * 1024 + sc); sv1 = *(const bf16x8*)(d.V + (k0_ + 32 + sr) * 1024 + sc); \
        sk0 = *(const bf16x8*)(d.K + (k0_ + sr) * 1024 + sc); sk1 = *(const bf16x8*)(d.K + (k0_ + 32 + sr) * 1024 + sc); } while (0)
    f32x16 o[4]; o[0] = f32x16{}; o[1] = f32x16{}; o[2] = f32x16{}; o[3] = f32x16{};
    float m_reg = -1e30f, l_reg = 0.f, R = 0.f; bool wdone = !wvalid;
    bf16x8 T00, T01;
    if (TYPE == 1) {
#pragma unroll
        for (int e = 0; e < 8; ++e) { const int j0 = 8 * hi + e; T00[e] = (j0 > r32) ? (short)0x3F80 : (short)0; T01[e] = (16 + j0 > r32) ? (short)0x3F80 : (short)0; }
    }
    const int step = (TYPE == 0) ? 1 : -1, nT = t_hi - t_lo + 1;
    int T = (TYPE == 0) ? t_lo : t_hi;
#define SWRITE(B_) do { LAS unsigned char* vb_ = lds + (B_) * L_BUF + L_V; LAS unsigned char* kb_ = lds + (B_) * L_BUF + L_K; \
        *(LAS bf16x8*)(vb_ + vst0) = sv0; *(LAS bf16x8*)(vb_ + vst1) = sv1; *(LAS bf16x8*)(kb_ + kst0) = sk0; *(LAS bf16x8*)(kb_ + kst1) = sk1; } while (0)
    SLOAD(T); SWRITE(0);
    if (nT > 1) SLOAD(T + step);
    __syncthreads();
    if (wid < 4) __builtin_amdgcn_s_setprio(1);
    for (int it = 0; it < nT; ++it, T += step) {
        const int cur = it & 1;
        if (TYPE == 1) { volatile LAS unsigned* fl = flags + 8 * (cur ^ 1); const unsigned f = fl[0] & fl[1] & fl[2] & fl[3] & fl[4] & fl[5] & fl[6] & fl[7]; if (f) break; }
        if (it + 1 < nT) SWRITE(cur ^ 1);
        if (it + 2 < nT) SLOAD(T + 2 * step);
        const LAS unsigned char* Kl = lds + cur * L_BUF + L_K; const int vb0 = vbase + cur * L_BUF;
        if (TYPE == 0) {
            if (wvalid && T >= cw - 8 && T <= cw) {
                f32x16 p0, p1; qkt(p0, p1, Kl, Ql, r32, hi);
                const int dc = cw - T;
                if (dc >= 3) { const float bf = biasL[256];
#pragma unroll
                    for (int r = 0; r < 16; ++r) { p0[r] += bf; p1[r] += bf; } }
                else { const int relb = qpos - 64 * T + 128;
#pragma unroll
                    for (int r = 0; r < 16; ++r) { int i0 = relb - crow(r, hi); int i1 = i0 - 32; i0 = i0 < 0 ? 0 : (i0 > 256 ? 256 : i0); i1 = i1 < 0 ? 0 : (i1 > 256 ? 256 : i1); p0[r] += biasL[i0]; p1[r] += biasL[i1]; } }
                const bool needmask = (64 * T + 63 >= d.nkeys);
                if (needmask) {
#pragma unroll
                    for (int r = 0; r < 16; ++r) { const int kp = 64 * T + crow(r, hi); if (kp >= d.nkeys) p0[r] = -1e30f; if (kp + 32 >= d.nkeys) p1[r] = -1e30f; } }
                float pmax = p0[0];
#pragma unroll
                for (int r = 1; r < 16; ++r) pmax = fmaxf(pmax, p0[r]);
#pragma unroll
                for (int r = 0; r < 16; ++r) pmax = fmaxf(pmax, p1[r]);
                pmax = swap_max(pmax);
                float alpha = 1.f; const bool grow = __any(pmax > m_reg + 8.0f);
                if (grow) { const float mx = fmaxf(m_reg, pmax); alpha = ex2(m_reg - mx); m_reg = mx; }
                const float mn = m_reg;
#pragma unroll
                for (int r = 0; r < 16; ++r) { p0[r] = ex2(p0[r] - mn); p1[r] = ex2(p1[r] - mn); }
                if (needmask) {
#pragma unroll
                    for (int r = 0; r < 16; ++r) { const int kp = 64 * T + crow(r, hi); if (kp >= d.nkeys) p0[r] = 0.f; if (kp + 32 >= d.nkeys) p1[r] = 0.f; } }
                float ps = 0.f;
#pragma unroll
                for (int r = 0; r < 16; ++r) ps += p0[r] + p1[r];
                ps = swap_add(ps);
                l_reg = l_reg * alpha + ps;
                if (grow && __any(alpha < 1.f)) { if (hi == 0) wsf[r32] = alpha; LDS_WAIT();
#pragma unroll
                    for (int dd = 0; dd < 4; ++dd)
#pragma unroll
                        for (int r = 0; r < 16; ++r) o[dd][r] *= wsf[crow(r, hi)]; }
                bf16x8 pa0, pa1, pa2, pa3; PK4(p0, 0, pa0); PK4(p0, 8, pa1); PK4(p1, 0, pa2); PK4(p1, 8, pa3);
                pv_d0(o, vb0, pa0, pa1, pa2, pa3);
            }
        } else {
            if (!wdone && T <= cw) {
                const bool diag = (T == cw);
                bf16x8 pa0, pa1, pa2, pa3; float ts1, ts0;
                {
                    f32x16 z, lf; qkt_half(z, Kl, Ql, r32, hi, 1); float ts = 0.f;
#pragma unroll
                    for (int r = 0; r < 16; ++r) { const float zz = z[r], e = ex2(-fabsf(zz)), l1p = __builtin_amdgcn_logf(1.0f + e); float lb = fminf(zz, 0.f) - l1p, lfv = -fmaxf(zz, 0.f) - l1p;
                        if (diag) { const bool c = (64 * T + 32 + crow(r, hi)) < qpos; lfv = c ? lfv : 0.f; lb = c ? lb : -1e30f; }
                        z[r] = lb; lf[r] = lfv; ts += lfv; }
                    ts1 = swap_add(ts);
                    bf16x8 la2, la3; PK4(lf, 0, la2); PK4(lf, 8, la3);
                    f32x16 L = f32x16{};
                    L = __builtin_amdgcn_mfma_f32_32x32x16_bf16(T00, la2, L, 0, 0, 0); L = __builtin_amdgcn_mfma_f32_32x32x16_bf16(T01, la3, L, 0, 0, 0);
#pragma unroll
                    for (int r = 0; r < 16; ++r) z[r] = ex2(z[r] + L[r] + R);
                    PK4(z, 0, pa2); PK4(z, 8, pa3);
                }
                {
                    f32x16 z, lf; qkt_half(z, Kl, Ql, r32, hi, 0); float ts = 0.f;
#pragma unroll
                    for (int r = 0; r < 16; ++r) { const float zz = z[r], e = ex2(-fabsf(zz)), l1p = __builtin_amdgcn_logf(1.0f + e); float lb = fminf(zz, 0.f) - l1p, lfv = -fmaxf(zz, 0.f) - l1p;
                        if (diag) { const bool c = (64 * T + crow(r, hi)) < qpos; lfv = c ? lfv : 0.f; lb = c ? lb : -1e30f; }
                        z[r] = lb; lf[r] = lfv; ts += lfv; }
                    ts0 = swap_add(ts);
                    bf16x8 la0, la1; PK4(lf, 0, la0); PK4(lf, 8, la1);
                    f32x16 L = f32x16{};
                    L = __builtin_amdgcn_mfma_f32_32x32x16_bf16(T00, la0, L, 0, 0, 0); L = __builtin_amdgcn_mfma_f32_32x32x16_bf16(T01, la1, L, 0, 0, 0);
                    const float Rr = R + ts1;
#pragma unroll
                    for (int r = 0; r < 16; ++r) z[r] = ex2(z[r] + L[r] + Rr);
                    PK4(z, 0, pa0); PK4(z, 8, pa1);
                }
                pv_d0(o, vb0, pa0, pa1, pa2, pa3);
                const float ts = ts0 + ts1;
                R += ts;
                wdone = __all((R < -160.f) || rowinvalid);
            }
            if (lane == 0) flags[8 * cur + wid] = wdone ? 1u : 0u;
        }
        __syncthreads();
    }
    __builtin_amdgcn_s_setprio(0);
    if (wvalid) {
        LAS bf16_t* stg = (LAS bf16_t*)(lds + L_OST) + wid * 4096;
        if (TYPE == 0) { if (hi == 0) wsf[32 + r32] = l_reg; LDS_WAIT(); }
#pragma unroll
        for (int r = 0; r < 16; ++r) { const int rw = crow(r, hi); const float rl = (TYPE == 0) ? __builtin_amdgcn_rcpf(wsf[32 + rw]) : 1.f;
#pragma unroll
            for (int dd = 0; dd < 4; ++dd) stg[rw * 128 + dd * 32 + r32] = f2bf(o[dd][r] * rl); }
        LDS_WAIT();
#pragma unroll 2
        for (int i = 0; i < 8; ++i) { const int rw = i * 4 + (lane >> 4), ch = lane & 15, row = 32 * wid + rw;
            if (row < d.nvalid) { const size_t off = (size_t)row * 3072 + ch * 8;
                const u32x4 ov = *(const LAS u32x4*)(stg + rw * 128 + ch * 8), gv = __builtin_nontemporal_load((const u32x4*)(d.SZ + off));
                u32x4 w; w.x = pk2(bflo(ov.x) * bflo(gv.x), bfhi(ov.x) * bfhi(gv.x)); w.y = pk2(bflo(ov.y) * bflo(gv.y), bfhi(ov.y) * bfhi(gv.y));
                w.z = pk2(bflo(ov.z) * bflo(gv.z), bfhi(ov.z) * bfhi(gv.z)); w.w = pk2(bflo(ov.w) * bflo(gv.w), bfhi(ov.w) * bfhi(gv.w));
                *(u32x4*)(d.Y + off) = w; } }
    }
#undef SLOAD
#undef SWRITE
}
}

#if defined(DBG_ONLY0)
#define ATT_DISPATCH(type, lds, d) att::unit<0>(lds, d)
#elif defined(DBG_ONLY1)
#define ATT_DISPATCH(type, lds, d) att::unit<1>(lds, d)
#elif defined(DBG_NOATT)
#define ATT_DISPATCH(type, lds, d) (void)d
#else
#define ATT_DISPATCH(type, lds, d) do { if (type) att::unit<1>(lds, d); else att::unit<0>(lds, d); } while (0)
#endif
struct Args { const float* in[28]; float* out; unsigned char* ws; int ph_lo, ph_hi; };
constexpr int I_IN = (DM / 64) * (NIN / 64), I_GLU = 16 * 16, I_BR = (MW / 64) * (DM / 64), I_OUT = 64 * 64, I_L = I_IN + I_GLU + 3 * I_BR + I_OUT;
__device__ __forceinline__ void weight_item(const float* w_in, const float* w_glu, const float* w_br0, const float* w_br1, const float* w_br2, const float* w_out, unsigned char* ws, int l, int r, LAS float* scr, int lane) {
    if (r < I_IN) { transpose_item(w_in + (size_t)l * DM * NIN, DM, NIN, (bf16_t*)(ws + WS_WIN) + (size_t)l * NIN * DM, scr, r, lane); return; } r -= I_IN;
    if (r < I_GLU) { transpose_item(w_glu + (size_t)l * MW * MW, MW, MW, (bf16_t*)(ws + WS_WGLU) + (size_t)l * MW * MW, scr, r, lane); return; } r -= I_GLU;
    if (r < 3 * I_BR) { const int br = r / I_BR; r -= br * I_BR;
        transpose_item((br == 0 ? w_br0 : br == 1 ? w_br1 : w_br2) + (size_t)l * MW * DM, MW, DM, (bf16_t*)(ws + WS_WBR) + (size_t)(l * 3 + br) * DM * MW, scr, r, lane); return; } r -= 3 * I_BR;
    transpose_item(w_out + (size_t)l * DM * DM, DM, DM, (bf16_t*)(ws + WS_WOUT) + (size_t)l * DM * DM, scr, r, lane);
}
__device__ __forceinline__ void convert_caches(const float* sbk, const float* sbv, const float* bdk, const float* bdv, const WsPtrs W, int l, int wg, int nwg, int gsz) {
    int t_ = threadIdx.x; asm volatile("" : "+v"(t_));
    const size_t gt = (size_t)wg * gsz + (t_ & (gsz - 1)), NT = (size_t)nwg * gsz;
    const size_t n_sb = 8ull * PASTL * 128, n_bd = 8ull * BANDK * 128;
    for (size_t i = gt; i < 2 * n_sb + 2 * n_bd; i += NT) {
        const float* src; bf16_t* dst; size_t j = i;
        if (j < 2 * n_sb) { const int kv = j >= n_sb; j -= kv * n_sb; const size_t lb = (size_t)l * NB + j / ((size_t)PASTL * 128), rem = j % ((size_t)PASTL * 128), t = rem >> 7, c8 = rem & 127;
            src = (kv ? sbv : sbk) + (lb * PASTL + t) * 1024 + c8 * 8; dst = (kv ? W.VCS() : W.KCS()) + (lb * KCS_ROWS + t) * 1024 + c8 * 8; }
        else { j -= 2 * n_sb; const int kv = j >= n_bd; j -= kv * n_bd; const size_t lb = (size_t)l * NB + j / ((size_t)BANDK * 128), rem = j % ((size_t)BANDK * 128), t = rem >> 7, c8 = rem & 127;
            src = (kv ? bdv : bdk) + (lb * BANDK + t) * 1024 + c8 * 8; dst = (kv ? W.VBS() : W.KBS()) + (lb * KBS_ROWS + t) * 1024 + c8 * 8; }
        const f32x4 a = __builtin_nontemporal_load((const f32x4*)src), b = __builtin_nontemporal_load((const f32x4*)(src + 4));
        st_bf16x8(dst, a, b);
    }
}
constexpr int N_PHASES = 11;

__global__ void __launch_bounds__(NWAVES * 64, 2) hse_fwd(Args args) {
    extern __shared__ __attribute__((aligned(16))) unsigned char lds_raw[];
    LAS unsigned char* lds = (LAS unsigned char*)lds_raw;
    volatile LAS unsigned* MISC = (volatile LAS unsigned*)(lds + MISC_OFF);
    const int tid = threadIdx.x, lane = tid & 63, wave = __builtin_amdgcn_readfirstlane(tid >> 6);
    const int G = gridDim.x; const int bx = blockIdx.x; const int vcu = (G % 8 == 0) ? (bx % 8) * (G / 8) + bx / 8 : bx;
    unsigned char* ws = args.ws; float* out = args.out;
    const CAS Args* const kargs = (const CAS Args*)__builtin_amdgcn_kernarg_segment_ptr();
#define KARGS() const CAS Args* KA = kargs; asm volatile("" : "+s"(KA))
#define PHASE_BEGIN() KARGS(); unsigned char* ws_o_ = ws; float* out_o_ = out; asm volatile("" : "+s"(ws_o_), "+s"(out_o_)); unsigned char* const ws = asg(ws_o_); float* const out = asg(out_o_); WsPtrs W; W.ws = ws; (void)out; (void)KA; \
    int G_o_ = G, bx_o_ = bx, vcu_o_ = vcu; asm volatile("" : "+s"(G_o_), "+s"(bx_o_), "+s"(vcu_o_)); const int G = G_o_, bx = bx_o_, vcu = vcu_o_; (void)G; (void)bx; (void)vcu
    unsigned* ctl = (unsigned*)(ws + WS_CTL);
    WsPtrs W; W.ws = ws;
    for (int u = tid; u < (LDS_BYTES - LDSCTL_OFF) / 4; u += NWAVES * 64) ((LAS unsigned*)(lds + LDSCTL_OFF))[u] = 0u;
    __syncthreads();
    XcdBarrier bar; bar.bar = ctl + CW_BAR; bar.x = 0; bar.st = nullptr;
    if (!MK_SPLIT) bar = xcd_barrier_post(ctl + CW_BAR, MISC + 8);
    const int lo = args.ph_lo, hi_ph = args.ph_hi;
#define IN(k) (lo <= (k) && (k) < hi_ph)
#define SEAM(k) do { if (!MK_SPLIT && (k) + 1 < hi_ph) xcd_barrier(bar); } while (0)
    const int gw = vcu * NWAVES + wave, NGW = G * NWAVES;

#ifndef NO_P0
    if (IN(0)) {
        PHASE_BEGIN();
        for (int lg = NGW - 1 - gw; lg < 2 * NG; lg += NGW) {
            const int l = lg / NG, g = lg - l * NG, n = lane;
            const float dt = expf(KA->in[12][lg]);
            const float are = KA->in[10][(size_t)lg * NST + n], aim = KA->in[11][(size_t)lg * NST + n];
            const float mag = expf(are * dt), abr = mag * cosf(aim * dt), abi = mag * sinf(aim * dt);
            const float den = are * are + aim * aim, nr = abr - 1.0f;
            const float kre = (nr * are + abi * aim) / den, kim = (abi * are - nr * aim) / den;
            *((f32x2*)(ws + WS_ABAR) + (size_t)lg * NST + n) = (f32x2){abr, abi};
            bf16_t* BMT = (bf16_t*)(ws + WS_BMT) + (size_t)lg * 128 * 16; bf16_t* CMT = (bf16_t*)(ws + WS_CMT) + (size_t)lg * 16 * 128;
            const float* bre = KA->in[13] + ((size_t)lg * NST + n) * 16; const float* bim = KA->in[14] + ((size_t)lg * NST + n) * 16;
#pragma unroll
            for (int p = 0; p < 16; ++p) { const float br_ = bre[p], bi_ = bim[p];
                BMT[(size_t)n * 16 + p] = f2bf(kre * br_ - kim * bi_); BMT[(size_t)(64 + n) * 16 + p] = f2bf(kre * bi_ + kim * br_);
                CMT[(size_t)p * 128 + n] = f2bf(KA->in[15][((size_t)lg * 16 + p) * NST + n]); CMT[(size_t)p * 128 + 64 + n] = f2bf(-KA->in[16][((size_t)lg * 16 + p) * NST + n]); }
        }
        LAS float* scr = (LAS float*)(lds + wave * 16640);
        for (int rep_ = 0; rep_ < ((DBG_DUP & 1) ? 2 : 1); ++rep_)
        for (int it = gw; it < I_L; it += NGW) weight_item(KA->in[9], KA->in[18], KA->in[23], KA->in[24], KA->in[25], KA->in[27], ws, 0, it, scr, lane);
        for (int m = gw; m < MR; m += NGW) {
            const float* xr = (m < MP) ? KA->in[0] + (size_t)m * DM : KA->in[1] + (size_t)(m - MP) * DM;
            xrow_to_a0(xr, KA->in[8], W.A0() + (size_t)m * DM, W.SSQ0() + m, lane);
        }
        convert_caches(KA->in[2], KA->in[3], KA->in[4], KA->in[5], W, 0, vcu, G, 512);
        for (int i = gw; i < 16 * 96 * 2; i += NGW) { const int kv = i & 1, j = i >> 1, lb = j / 96, rr = j - lb * 96;
            bf16_t* p = (rr < 48) ? (kv ? W.VCS() : W.KCS()) + ((size_t)lb * KCS_ROWS + PASTL + DSEQ + rr) * 1024 : (kv ? W.VBS() : W.KBS()) + ((size_t)lb * KBS_ROWS + BANDK + DSEQ + (rr - 48)) * 1024;
            *((u32x4*)p + lane) = (u32x4){0u, 0u, 0u, 0u}; *((u32x4*)p + 64 + lane) = (u32x4){0u, 0u, 0u, 0u}; }
        SEAM(0);
    }
#endif

    for (int l = 0; l < 2; ++l) {
        const int pb = 1 + 5 * l;
#ifndef NO_P1
        if (IN(pb)) {
            PHASE_BEGIN();
            pg8::Gemm g{DM, DM, DM};
            pg8::TileOrder<1> S; S.nM = MP / 256; S.nN = NIN / 256; S.nwg = S.nM * S.nN; S.G = G; S.c = bx;
            S.A = (const char*)W.A0(); S.B = (const char*)(ws + WS_WIN) + (size_t)l * NIN * DM * 2; S.atile = 256ull * DM * 2; S.btile = 256ull * DM * 2; S.arep = 0; S.brep = 0;
            pg8::QuarterOrder<1> SQ; SQ.pmq = MP / 256; SQ.nN = S.nN; SQ.G = G; SQ.c = bx; SQ.A = S.A; SQ.B = S.B; SQ.atile = S.atile; SQ.btile = S.btile; SQ.arep = 0; SQ.brep = 0; SQ.bhalf = 128ull * DM * 2;
            Epi1 E{l == 0 ? W.SSQ0() : W.SSQ1(), KA->in[26] + (size_t)l * 3 * DM, out, W, l};
            long long ck0 = 0, rt0 = 0; if (DBG_CLK == 1 && l == 0 && bx == 0) { ck0 = clock64(); rt0 = wall_clock64(); }
            pg8::gemm_phase<false>(lds, g, S, E);
            pg8::gemm_quarter(lds, g, SQ, E);
            if (DBG_CLK == 1 && l == 0 && bx == 0 && tid == 0) { const long long dc = clock64() - ck0, dr = wall_clock64() - rt0; ((long long*)(ws + WS_CTL + 32768))[0] = dc; ((long long*)(ws + WS_CTL + 32768))[1] = dr; }
            if (DBG_DUP & 2) { pg8::gemm_phase<false>(lds, g, S, E); pg8::gemm_quarter(lds, g, SQ, E); }
            if (DBG_DUP & 0xF00) { EpiNull EN{(float*)(ws + WS_CTL + 49152)}; S.fixed = (DBG_DUP >> 9) & 3; pg8::gemm_phase<false>(lds, g, S, EN); }
            if (DBG_CLK == 2 && l == 0 && tid == 0) { const unsigned long long t_ = (unsigned long long)wall_clock64(); atomicMax((unsigned long long*)(ws + WS_CTL + 40960), t_); atomicMax((unsigned long long*)(ws + WS_CTL + 40960) + 8, ~t_); }
            SEAM(pb);
            if (DBG_CLK == 2 && l == 0 && bx == 0 && tid == 0) { const unsigned long long mx = *((unsigned long long*)(ws + WS_CTL + 40960)), mn = ~*((unsigned long long*)(ws + WS_CTL + 40960) + 8);
                ((long long*)(ws + WS_CTL + 32768))[0] = (long long)(mx - mn) * 10; ((long long*)(ws + WS_CTL + 32768))[1] = 1; }
        }
#endif
#ifndef NO_P2A
        if (IN(pb + 1)) {
            PHASE_BEGIN();
            constexpr int NSW = 2, NHWV = NWAVES - NSW;
            if (wave < NSW) {
                LAS float* S = (LAS float*)(lds + wave * SSM_WAVE_BYTES);
                for (int st = vcu * NSW + wave; st < 1024; st += G * NSW) {
                    const int sample = st >= 512, ii = st & 511, b = ii >> 6, g = ii & 63;
                    if (!sample) ssm_unit<32>(S, ws, KA->in[17] + (size_t)l * MW, l, g, W.U(), W.YG(), b * SEQ, SEQ, nullptr, nullptr,
                                          out + O_PSR + ((size_t)(l * NB + b) * NG + g) * NST, out + O_PSI + ((size_t)(l * NB + b) * NG + g) * NST, lane);
                    else ssm_unit<16>(S, ws, KA->in[17] + (size_t)l * MW, l, g, W.U(), W.YG(), MP + b * DSEQ, DSEQ,
                                  KA->in[6] + ((size_t)(l * NB + b) * NG + g) * NST, KA->in[7] + ((size_t)(l * NB + b) * NG + g) * NST,
                                  out + O_SSR + ((size_t)(l * NB + b) * NG + g) * NST, out + O_SSI + ((size_t)(l * NB + b) * NG + g) * NST, lane);
                }
                __builtin_amdgcn_s_setprio(0);
            } else
            { const int hw = vcu * NHWV + (wave - NSW), NHW = G * NHWV;
              {
                const float* qg = KA->in[20] + (size_t)l * HD; const float* kg = KA->in[21] + (size_t)l * HD;
                int lane_o = lane; asm volatile("" : "+v"(lane_o));
                const int c0 = 16 * lane_o, dd = c0 & 127;
                float gq[16], gk[16];
#pragma unroll
                for (int j = 0; j < 16; ++j) { gq[j] = qg[dd + j] * (0.08838834764831845f * LOG2E); gk[j] = kg[dd + j]; }
                for (int row = hw; row < MR; row += NHW) {
                    { bf16_t* qp = W.QB() + (size_t)row * 1024 + c0; const u32x4 a = __builtin_nontemporal_load((const u32x4*)qp), b2 = __builtin_nontemporal_load((const u32x4*)(qp + 8));
                      float v[16] = {bflo(a.x), bfhi(a.x), bflo(a.y), bfhi(a.y), bflo(a.z), bfhi(a.z), bflo(a.w), bfhi(a.w), bflo(b2.x), bfhi(b2.x), bflo(b2.y), bfhi(b2.y), bflo(b2.z), bfhi(b2.z), bflo(b2.w), bfhi(b2.w)};
                      float s = 0.f;
#pragma unroll
                      for (int j = 0; j < 16; ++j) s += v[j] * v[j];
                      s += __shfl_xor(s, 1); s += __shfl_xor(s, 2); s += __shfl_xor(s, 4);
                      const float r = __builtin_amdgcn_rsqf(s * (1.0f / 128.0f) + 1e-6f);
#pragma unroll
                      for (int j = 0; j < 16; ++j) v[j] = v[j] * r * gq[j];
                      st_bf16x8(qp, (f32x4){v[0], v[1], v[2], v[3]}, (f32x4){v[4], v[5], v[6], v[7]}); st_bf16x8(qp + 8, (f32x4){v[8], v[9], v[10], v[11]}, (f32x4){v[12], v[13], v[14], v[15]}); }
                    { const bf16_t* kp = W.KB() + (size_t)row * 1024 + c0; const u32x4 a = __builtin_nontemporal_load((const u32x4*)kp), b2 = __builtin_nontemporal_load((const u32x4*)(kp + 8));
                      float v[16] = {bflo(a.x), bfhi(a.x), bflo(a.y), bfhi(a.y), bflo(a.z), bfhi(a.z), bflo(a.w), bfhi(a.w), bflo(b2.x), bfhi(b2.x), bflo(b2.y), bfhi(b2.y), bflo(b2.z), bfhi(b2.z), bflo(b2.w), bfhi(b2.w)};
                      float s = 0.f;
#pragma unroll
                      for (int j = 0; j < 16; ++j) s += v[j] * v[j];
                      s += __shfl_xor(s, 1); s += __shfl_xor(s, 2); s += __shfl_xor(s, 4);
                      const float r = __builtin_amdgcn_rsqf(s * (1.0f / 128.0f) + 1e-6f);
#pragma unroll
                      for (int j = 0; j < 16; ++j) v[j] = v[j] * r * gk[j];
                      bf16_t* d16; float* d32 = nullptr;
                      if (row < MP) { const int b = row >> 11, t = row & 2047; d16 = W.KB() + (size_t)row * 1024 + c0;
                          if (t >= SEQ - BANDK) d32 = out + O_PBK + ((size_t)(l * NB + b) * BANDK + (t - (SEQ - BANDK))) * 1024 + c0; }
                      else { const int sr = row - MP, b = sr >> 4, t = sr & 15; d16 = W.KBS() + ((size_t)(l * NB + b) * KBS_ROWS + BANDK + t) * 1024 + c0; d32 = out + O_SBK + ((size_t)l * MS + sr) * 1024 + c0; }
                      st_bf16x8(d16, (f32x4){v[0], v[1], v[2], v[3]}, (f32x4){v[4], v[5], v[6], v[7]}); st_bf16x8(d16 + 8, (f32x4){v[8], v[9], v[10], v[11]}, (f32x4){v[12], v[13], v[14], v[15]});
                      if (d32) { *(f32x4*)d32 = (f32x4){v[0], v[1], v[2], v[3]}; *(f32x4*)(d32 + 4) = (f32x4){v[4], v[5], v[6], v[7]}; *(f32x4*)(d32 + 8) = (f32x4){v[8], v[9], v[10], v[11]}; *(f32x4*)(d32 + 12) = (f32x4){v[12], v[13], v[14], v[15]}; } }
                }
                if (l == 0) { LAS float* scr = (LAS float*)(lds + NSW * SSM_WAVE_BYTES + (wave - NSW) * 16640);
                    for (int it = hw; it < I_IN; it += NHW) weight_item(KA->in[9], KA->in[18], KA->in[23], KA->in[24], KA->in[25], KA->in[27], ws, 1, it, scr, lane); }
                else { convert_caches(KA->in[2], KA->in[3], KA->in[4], KA->in[5], W, 1, hw, NHW, 64);
                    LAS float* scr = (LAS float*)(lds + NSW * SSM_WAVE_BYTES + (wave - NSW) * 16640);
                    for (int it = I_IN + hw; it < I_L; it += NHW) weight_item(KA->in[9], KA->in[18], KA->in[23], KA->in[24], KA->in[25], KA->in[27], ws, 1, it, scr, lane); }
              } }
            SEAM(pb + 1);
        }
#endif
#ifndef NO_P2B
        if (IN(pb + 2)) {
            PHASE_BEGIN();
            for (int rep_ = 0; rep_ < ((DBG_DUP & 8) ? 2 : 1); ++rep_) {
            const int nit = (G == 256) ? (((vcu & 7) <= 1 || (vcu & 7) >= 6) ? 5 : 4) : (1152 + G - 1 - vcu) / G;
            for (int k = 0; k < nit; ++k) {
                int item;
                if (G == 256) { const int q = vcu & 7, bq = vcu >> 3;
                    if (k < 4) { const int second = k & 1, ty = k >> 1; item = ty * 512 + (second ? ((32 + bq) << 3) + (7 - q) : (bq << 3) + q); }
                    else item = 1024 + ((q == 0 || q == 7) ? 0 : 64) + ((q == 0 || q == 1) ? 0 : 32) + bq; }
                else item = vcu + k * G;
                att::Desc d;
                if (item < 1024) {
                    const int type = item < 512 ? 1 : 0, ii = item & 511, bh = ii >> 3, qb = ii & 7, b = bh >> 3, h = bh & 7;
                    const size_t row0 = (size_t)b * SEQ + 256 * qb;
                    d.Q = (type ? W.QC() : W.QB()) + row0 * 1024 + h * HD; d.K = (type ? W.KC() : W.KB()) + (size_t)b * SEQ * 1024 + h * HD; d.V = (type ? W.VC() : W.VB()) + (size_t)b * SEQ * 1024 + h * HD;
                    d.SZ = W.SZ() + row0 * 3072 + (type ? 2048 : 1024) + h * HD; d.Y = W.Y() + row0 * 3072 + (type ? 2048 : 1024) + h * HD;
                    d.bias = KA->in[22] + ((size_t)l * NH + h) * 257; d.qpos0 = 256 * qb; d.nvalid = 256; d.nkeys = SEQ;
                    ATT_DISPATCH(type, lds, d);
                    if ((DBG_DUP & 64) && type == 1) att::unit<1>(lds, d);
                    if ((DBG_DUP & 128) && type == 0) att::unit<0>(lds, d);
                } else {
                    const int type = item < 1088 ? 0 : 1, ii = (item - 1024) & 63, b = ii >> 3, h = ii & 7;
                    const size_t row0 = (size_t)MP + b * DSEQ;
                    d.Q = (type ? W.QC() : W.QB()) + row0 * 1024 + h * HD;
                    d.K = (type ? W.KCS() + (size_t)(l * NB + b) * KCS_ROWS * 1024 : W.KBS() + (size_t)(l * NB + b) * KBS_ROWS * 1024) + h * HD;
                    d.V = (type ? W.VCS() + (size_t)(l * NB + b) * KCS_ROWS * 1024 : W.VBS() + (size_t)(l * NB + b) * KBS_ROWS * 1024) + h * HD;
                    d.SZ = W.SZ() + row0 * 3072 + (type ? 2048 : 1024) + h * HD; d.Y = W.Y() + row0 * 3072 + (type ? 2048 : 1024) + h * HD;
                    d.bias = KA->in[22] + ((size_t)l * NH + h) * 257; d.qpos0 = type ? PASTL : BANDK; d.nvalid = DSEQ; d.nkeys = (type ? PASTL : BANDK) + DSEQ;
                    ATT_DISPATCH(type, lds, d);
                }
            }
#ifndef DBG_NOGLU
            __syncthreads();
            { pg8::Gemm g{MW, MW, MW};
              pg8::TileOrder<1> S; S.nM = MP / 256; S.nN = MW / 256; S.nwg = S.nM * S.nN; S.G = G; S.c = bx;
              S.A = (const char*)W.YG(); S.B = (const char*)(ws + WS_WGLU) + (size_t)l * MW * MW * 2; S.atile = 256ull * MW * 2; S.btile = 256ull * MW * 2; S.arep = 0; S.brep = 0;
              pg8::QuarterOrder<1> SQ; SQ.pmq = MP / 256; SQ.nN = S.nN; SQ.G = G; SQ.c = (vcu + G / 2) % G; SQ.A = S.A; SQ.B = S.B; SQ.atile = S.atile; SQ.btile = S.btile; SQ.arep = 0; SQ.brep = 0; SQ.bhalf = 128ull * MW * 2;
              EpiGlu E{KA->in[19] + (size_t)l * MW, W};
              pg8::gemm_phase<false>(lds, g, S, E);
              pg8::gemm_quarter(lds, g, SQ, E); }
#endif
            }
            SEAM(pb + 2);
        }
#endif
#ifndef NO_P3
        if (IN(pb + 3)) {
            PHASE_BEGIN();
            pg8::Gemm g{3 * MW, MW, MW};
            pg8::TileOrder<3> S; S.nM = MP / 256; S.nN = DM / 256; S.nwg = S.nM * S.nN; S.G = G; S.c = bx;
            S.A = (const char*)W.Y(); S.B = (const char*)(ws + WS_WBR) + (size_t)l * 3 * DM * MW * 2; S.atile = 256ull * 3 * MW * 2; S.btile = 256ull * MW * 2; S.arep = (size_t)MW * 2; S.brep = (size_t)DM * MW * 2;
            pg8::QuarterOrder<3> SQ; SQ.pmq = MP / 256; SQ.nN = S.nN; SQ.G = G; SQ.c = bx; SQ.A = S.A; SQ.B = S.B; SQ.atile = S.atile; SQ.btile = S.btile; SQ.arep = S.arep; SQ.brep = S.brep; SQ.bhalf = 128ull * MW * 2;
            EpiBr E{W};
            pg8::gemm_phase<false>(lds, g, S, E);
            pg8::gemm_quarter(lds, g, SQ, E);
            if (DBG_DUP & 16) { pg8::gemm_phase<false>(lds, g, S, E); pg8::gemm_quarter(lds, g, SQ, E); }
            if (DBG_DUP & 2048) { EpiNull EN{(float*)(ws + WS_CTL + 49152)}; pg8::gemm_phase<false>(lds, g, S, EN); }
            if (DBG_DUP & 4096) pg8::gemm_phase<false>(lds, g, S, E);
            SEAM(pb + 3);
        }
#endif
#ifndef NO_P4
        if (IN(pb + 4)) {
            PHASE_BEGIN();
            pg8::Gemm g{DM, DM, DM};
            pg8::TileOrder<1> S; S.nM = MP / 256; S.nN = DM / 256; S.nwg = S.nM * S.nN; S.G = G; S.c = bx;
            S.A = (const char*)W.MX(); S.B = (const char*)(ws + WS_WOUT) + (size_t)l * DM * DM * 2; S.atile = 256ull * DM * 2; S.btile = 256ull * DM * 2; S.arep = 0; S.brep = 0;
            pg8::QuarterOrder<1> SQ; SQ.pmq = MP / 256; SQ.nN = S.nN; SQ.G = G; SQ.c = bx; SQ.A = S.A; SQ.B = S.B; SQ.atile = S.atile; SQ.btile = S.btile; SQ.arep = 0; SQ.brep = 0; SQ.bhalf = 128ull * DM * 2;
            EpiOut E{KA->in[0], KA->in[1], KA->in[8] + DM, out, W, l};
            pg8::gemm_phase<false>(lds, g, S, E);
            pg8::gemm_quarter(lds, g, SQ, E);
            if ((DBG_DUP & 32) && l == 1) { pg8::gemm_phase<false>(lds, g, S, E); pg8::gemm_quarter(lds, g, SQ, E); }
            SEAM(pb + 4);
        }
#endif
    }
    if (DBG_CLK && bx == 0 && tid == 0) { const long long dc = ((long long*)(ws + WS_CTL + 32768))[0], dr = ((long long*)(ws + WS_CTL + 32768))[1];
        const long long ticks = (DBG_CLK == 2) ? dc : (dc * 10000) / (dr > 0 ? dr : 1); const long long t0 = wall_clock64(); while (wall_clock64() - t0 < ticks) __builtin_amdgcn_s_sleep(8); }
#undef IN
#undef SEAM
}

extern "C" void kernel_launch(void* const* d_in, const int* in_sizes, int n_in, void* d_out, int out_size, void* d_ws, size_t ws_size, hipStream_t stream) {
    static int grid = 0;
    if (grid == 0) {
        if ((size_t)out_size != O_END) fprintf(stderr, "kernel_launch: note: out_size %d, built for %zu\n", out_size, (size_t)O_END);
        if (n_in != 28 || ws_size < WS_END) { fprintf(stderr, "kernel_launch: shape mismatch n_in %d ws %zu (want %zu)\n", n_in, ws_size, (size_t)WS_END); grid = -1; return; }
        int dev = 0, cus = 0;
        if (hipGetDevice(&dev) != hipSuccess || hipDeviceGetAttribute(&cus, hipDeviceAttributeMultiprocessorCount, dev) != hipSuccess) { grid = -1; return; }
        if (hipFuncSetAttribute((const void*)hse_fwd, hipFuncAttributeMaxDynamicSharedMemorySize, LDS_BYTES) != hipSuccess) { fprintf(stderr, "kernel_launch: hipFuncSetAttribute failed\n"); grid = -1; return; }
        int per_cu = 0;
        if (hipOccupancyMaxActiveBlocksPerMultiprocessor(&per_cu, (const void*)hse_fwd, NWAVES * 64, LDS_BYTES) != hipSuccess || per_cu < 1) fprintf(stderr, "kernel_launch: occupancy query says %d\n", per_cu);
        (void)hipGetLastError();
        grid = cus;
    }
    if (grid < 0) return;
    if (hipMemsetAsync((char*)d_ws + WS_CTL, 0, CTL_ZERO_BYTES, stream) != hipSuccess) return;
    Args a{};
    for (int i = 0; i < 28; ++i) a.in[i] = (const float*)d_in[i];
    a.out = (float*)d_out; a.ws = (unsigned char*)d_ws;
#if MK_SPLIT
    for (int p = 0; p < N_PHASES; ++p) { a.ph_lo = p; a.ph_hi = p + 1; hipLaunchKernelGGL(hse_fwd, dim3(grid), dim3(NWAVES * 64), LDS_BYTES, stream, a); }
#else
    a.ph_lo = 0; a.ph_hi = N_PHASES; hipLaunchKernelGGL(hse_fwd, dim3(grid), dim3(NWAVES * 64), LDS_BYTES, stream, a);
#endif
}
```

```cpp
#include <hip/hip_runtime.h>
#include <cstdio>
#include <cstdint>

#ifndef DBG_DUP
#define DBG_DUP 0
#endif
#ifndef DBG_CLK
#define DBG_CLK 0
#endif
#ifndef MK_SPLIT
#define MK_SPLIT 0
#endif

#define LAS __attribute__((address_space(3)))
#define GAS __attribute__((address_space(1)))
#define CAS __attribute__((address_space(4)))
typedef unsigned short bf16_t;
typedef short bf16x8 __attribute__((ext_vector_type(8)));
typedef short s16x4 __attribute__((ext_vector_type(4)));
typedef float f32x2 __attribute__((ext_vector_type(2)));
typedef float f32x4 __attribute__((ext_vector_type(4)));
typedef float f32x16 __attribute__((ext_vector_type(16)));
typedef unsigned u32x2 __attribute__((ext_vector_type(2)));
typedef unsigned u32x4 __attribute__((ext_vector_type(4)));
typedef __bf16 bf16x2_t __attribute__((ext_vector_type(2)));

constexpr int DM = 4096, SEQ = 2048, NB = 8, DSEQ = 16, MW = 1024, HD = 128, NH = 8, NG = 64, NST = 64, NIN = 22528;
constexpr int MP = NB * SEQ, MS = NB * DSEQ, MR = MP + MS, MROWS = 16640;
constexpr int KCS_ROWS = 2112, KBS_ROWS = 576, BANDK = 512, PASTL = 2048;
constexpr float LOG2E = 1.4426950408889634f, LN2 = 0.6931471805599453f;
constexpr size_t O_YP = 0, O_YS = O_YP + (size_t)MP * DM, O_PSBK = O_YS + (size_t)MS * DM, O_PSBV = O_PSBK + 2ull * MP * MW, O_PBK = O_PSBV + 2ull * MP * MW,
                 O_PBV = O_PBK + 2ull * NB * BANDK * MW, O_PSR = O_PBV + 2ull * NB * BANDK * MW, O_PSI = O_PSR + 2ull * NB * NG * NST, O_SSBK = O_PSI + 2ull * NB * NG * NST,
                 O_SSBV = O_SSBK + 2ull * MS * MW, O_SBK = O_SSBV + 2ull * MS * MW, O_SBV = O_SBK + 2ull * MS * MW, O_SSR = O_SBV + 2ull * MS * MW, O_SSI = O_SSR + 2ull * NB * NG * NST,
                 O_END = O_SSI + 2ull * NB * NG * NST;
constexpr size_t MiB = 1u << 20;
constexpr size_t R1K = (size_t)MROWS * 1024 * 2;
constexpr size_t WS_CTL = 0, CTL_ZERO_BYTES = 1 * MiB;
constexpr size_t WS_SSQ1 = 65536;
constexpr size_t WS_SSQ0 = 1 * MiB;
constexpr size_t WS_ABAR = WS_SSQ0 + 128 * 1024;
constexpr size_t WS_BMT = WS_ABAR + 64 * 1024;
constexpr size_t WS_CMT = WS_BMT + 512 * 1024;
constexpr size_t WS_WIN = 4 * MiB;
constexpr size_t WS_WGLU = WS_WIN + 2ull * NIN * DM * 2;
constexpr size_t WS_WBR = WS_WGLU + 2ull * MW * MW * 2;
constexpr size_t WS_WOUT = WS_WBR + 6ull * DM * MW * 2;
constexpr size_t WS_A0 = WS_WOUT + 2ull * DM * DM * 2;
constexpr size_t WS_U = WS_A0 + 4 * R1K;
constexpr size_t WS_SZ = WS_U + R1K;
constexpr size_t WS_QB = WS_SZ + 3 * R1K, WS_KB = WS_QB + R1K, WS_VB = WS_KB + R1K, WS_QC = WS_VB + R1K, WS_KC = WS_QC + R1K, WS_VC = WS_KC + R1K;
constexpr size_t WS_G = WS_VC + R1K;
constexpr size_t WS_YG = WS_G + 12 * R1K;
constexpr size_t WS_Y = WS_YG + R1K;
constexpr size_t WS_MX = WS_Y + 3 * R1K;
constexpr size_t WS_Y0 = WS_MX + 4 * R1K;
constexpr size_t WS_KCS = WS_Y0 + (size_t)MROWS * DM * 4;
constexpr size_t WS_VCS = WS_KCS + 16ull * KCS_ROWS * 1024 * 2;
constexpr size_t WS_KBS = WS_VCS + 16ull * KCS_ROWS * 1024 * 2;
constexpr size_t WS_VBS = WS_KBS + 16ull * KBS_ROWS * 1024 * 2;
constexpr size_t WS_END = WS_VBS + 16ull * KBS_ROWS * 1024 * 2;
static_assert(WS_END < 2900ull * MiB && WS_CMT + 512 * 1024 <= WS_WIN && (WS_WGLU % 256) == 0 && (R1K % 256) == 0, "d_ws map");
constexpr int CW_BAR = 4096;
constexpr int SCR_BYTES = 147456;
constexpr int LDSCTL_OFF = SCR_BYTES, MISC_OFF = LDSCTL_OFF + 320;
constexpr int LDS_BYTES = 155648;
constexpr int NWAVES = 8;

__device__ __forceinline__ unsigned pk2(float lo, float hi) { f32x2 v = {lo, hi}; bf16x2_t b = __builtin_convertvector(v, bf16x2_t); return __builtin_bit_cast(unsigned, b); }
__device__ __forceinline__ float bflo(unsigned w) { return __uint_as_float(w << 16); }
__device__ __forceinline__ float bfhi(unsigned w) { return __uint_as_float(w & 0xffff0000u); }
__device__ __forceinline__ float bf2f(bf16_t h) { return __uint_as_float((unsigned)h << 16); }
__device__ __forceinline__ bf16_t f2bf(float f) { return (bf16_t)(pk2(f, 0.f) & 0xffffu); }
__device__ __forceinline__ float ex2(float x) { return __builtin_amdgcn_exp2f(x); }
__device__ __forceinline__ float sigmoidf_(float x) { return __builtin_amdgcn_rcpf(1.0f + ex2(-x * LOG2E)); }
#define LDS_WAIT() asm volatile("s_waitcnt lgkmcnt(0)" ::: "memory")
#define VM_WAIT() asm volatile("s_waitcnt vmcnt(0)" ::: "memory")

namespace pg8 {
constexpr int BM = 256, BK = 64, HALF = 128, HTB = HALF * BK * 2  , STAGE_BYTES = 8 * HTB, NXCD = 8, WGM = 8;
__host__ __device__ __forceinline__ int lds_byte(int r, int c) { const int st = (r >> 4) * 2 + (c >> 5), rr = r & 15, cc = c & 31, ob = rr * 64 + cc * 2; return st * 1024 + (ob ^ (((ob >> 9) & 1) << 5)); }
__host__ __device__ __forceinline__ void stage_rc(int b, int& R, int& C) { const int st = b / 1024, sb = b % 1024, swz = sb ^ (((sb >> 9) & 1) << 5); R = (st >> 1) * 16 + swz / 64; C = (st & 1) * 32 + (swz % 64) / 2; }
__host__ __device__ __forceinline__ int perm32(int rho) { const int n = rho >> 4, i = rho & 15; return 8 * (i >> 2) + 4 * n + (i & 3); }

struct Unit { const char* a; const char* b; int pm, pn, aux, q, cs; };
struct Gemm { int lda, ldb, K; };

template <int REP> struct TileOrder {
    int nM, nN, nwg, G, c; const char* A; const char* B; size_t atile, btile, arep, brep; int fixed = 0;
    __device__ __forceinline__ bool next(int i, Unit& u) const {
        const int ti = i / REP, r = i - ti * REP;
        const long L = (long)ti * G + c; if (L >= nwg) return false;
        int wgid = (int)L; { const int q = nwg / NXCD, rr = nwg % NXCD, xcd = wgid % NXCD, off = wgid / NXCD; wgid = (xcd < rr ? xcd * (q + 1) : rr * (q + 1) + (xcd - rr) * q) + off; }
        const int nig = WGM * nN, gid = wgid / nig, fm = gid * WGM, gsz = (nM - fm) < WGM ? (nM - fm) : WGM;
        u.pm = fm + ((wgid % nig) % gsz); u.pn = (wgid % nig) / gsz; u.aux = r; u.q = 0; u.cs = 0;
        u.a = A + (size_t)((fixed & 1) ? 0 : u.pm) * atile + (size_t)r * arep; u.b = B + (size_t)((fixed & 2) ? 0 : u.pn) * btile + (size_t)r * brep; return true;
    }
};

template <int REP> struct QuarterOrder {
    int pmq, nN, G, c; const char* A; const char* B; size_t atile, btile, arep, brep, bhalf;
    __device__ __forceinline__ bool next(int i, Unit& u) const {
        const int ti = i / REP, r = i - ti * REP;
        const int L = ti * G + c; if (L >= 2 * nN) return false;
        u.pm = pmq; u.pn = L >> 1; u.aux = r; u.q = 1; u.cs = (L & 1) * HALF;
        u.a = A + (size_t)pmq * atile + (size_t)r * arep; u.b = B + (size_t)u.pn * btile + (size_t)(L & 1) * bhalf + (size_t)r * brep; return true;
    }
};

template <bool Q, class Epi, class Sched>
__device__ __forceinline__ void gemm_phase(LAS unsigned char* lds, const Gemm g, const Sched& S, const Epi& E) {
    int tid = threadIdx.x; asm volatile("" : "+v"(tid));
    const int wid = __builtin_amdgcn_readfirstlane(tid >> 6), lane = tid & 63, wr = wid >> 2, wc = wid & 3, fr = lane & 15, fq = lane >> 4;
    const int K = g.K, nt = K / BK;
    unsigned voffA[2], voffB[2];
#pragma unroll
    for (int i = 0; i < 2; ++i) { int R, C; stage_rc(tid * 16 + i * 8192, R, C); const int Rb = Epi::PERM ? ((R & ~31) + perm32(R & 31)) : R;
        voffA[i] = (unsigned)(R * g.lda + C) * 2u; voffB[i] = (unsigned)(Rb * g.ldb + C) * 2u; }
    const size_t kstep = (size_t)(BK * 2);
    const size_t hstepA = Q ? 0 : (size_t)HALF * g.lda * 2, hstepB = Q ? 0 : (size_t)HALF * g.ldb * 2;
    const unsigned ldsw = (unsigned)wid * 1024u;
    const int aoff = lds_byte(wr * 64 + fr, fq * 8), boff = lds_byte(wc * 32 + fr, fq * 8);
#define PG8_SA(b, h) (((b) * 2 + (h)) * HTB)
#define PG8_SB(b, h) ((4 + (b) * 2 + (h)) * HTB)
#define PG8_STAGE(bufoff, gbase, voff) do { _Pragma("unroll") for (int _i = 0; _i < 2; ++_i) \
        __builtin_amdgcn_global_load_lds((const unsigned*)((const char*)(gbase) + (voff)[_i]), (LAS unsigned*)(lds + (bufoff) + ldsw + _i * 8192), 16, 0, 0); } while (0)
#define PG8_LDA(dst, b, h) do { _Pragma("unroll") for (int m = 0; m < 4; ++m) _Pragma("unroll") for (int k = 0; k < 2; ++k) dst[m][k] = *(const LAS bf16x8*)(lds + PG8_SA(b, h) + aoff + m * 2048 + k * 1024); } while (0)
#define PG8_LDB(dst, b, h) do { _Pragma("unroll") for (int n = 0; n < 2; ++n) _Pragma("unroll") for (int k = 0; k < 2; ++k) dst[n][k] = *(const LAS bf16x8*)(lds + PG8_SB(b, h) + boff + n * 2048 + k * 1024); } while (0)
#define PG8_MMA(ai, bj, At, Bt) do { __builtin_amdgcn_s_setprio(1); _Pragma("unroll") for (int m = 0; m < 4; ++m) _Pragma("unroll") for (int n = 0; n < 2; ++n) _Pragma("unroll") for (int k = 0; k < 2; ++k) \
        acc[ai][bj][m][n] = __builtin_amdgcn_mfma_f32_16x16x32_bf16(Bt[n][k], At[m][k], acc[ai][bj][m][n], 0, 0, 0); __builtin_amdgcn_s_setprio(0); } while (0)
#define PG8_WAIT_V(n) asm volatile("s_waitcnt vmcnt(" #n ")" ::: "memory")
#define PG8_WAIT_L(n) asm volatile("s_waitcnt lgkmcnt(" #n ")" ::: "memory")
#define PG8_BAR __builtin_amdgcn_s_barrier()
#define PG8_SCHED __builtin_amdgcn_sched_barrier(0)
    Unit cur, nxt; int ui = 0;
    if (!S.next(0, cur)) return;
    f32x4 acc[2][2][4][2];
#pragma unroll
    for (int a = 0; a < 2; ++a)
#pragma unroll
        for (int b = 0; b < 2; ++b)
#pragma unroll
            for (int m = 0; m < 4; ++m)
#pragma unroll
                for (int n = 0; n < 2; ++n) acc[a][b][m][n] = (f32x4){0.f, 0.f, 0.f, 0.f};
    bf16x8 At[4][2], B0[2][2], B1[2][2];
    const char* cA = cur.a; const char* cB = cur.b;
    PG8_STAGE(PG8_SB(0, 0), cB, voffB); PG8_STAGE(PG8_SB(0, 1), cB + hstepB, voffB); PG8_STAGE(PG8_SA(0, 0), cA, voffA); PG8_STAGE(PG8_SA(0, 1), cA + hstepA, voffA);
    if (wr == 1) PG8_BAR;
    PG8_WAIT_V(2); PG8_BAR;
    PG8_STAGE(PG8_SB(1, 0), cB + kstep, voffB); PG8_STAGE(PG8_SA(1, 0), cA + kstep, voffA); PG8_STAGE(PG8_SB(1, 1), cB + hstepB + kstep, voffB);
    PG8_WAIT_V(6); PG8_BAR;
    for (;;) {
        const bool has_next = S.next(ui + 1, nxt);
        const char* nA = has_next ? nxt.a : cA; const char* nB = has_next ? nxt.b : cB;
        for (int t = 0; t < nt; t += 2) {
            const bool last = (t == nt - 2);
            const char* a1 = cA + (size_t)(t + 1) * kstep;
            const char* a2 = last ? nA : cA + (size_t)(t + 2) * kstep; const char* b2 = last ? nB : cB + (size_t)(t + 2) * kstep;
            const char* a3 = a2 + kstep; const char* b3 = b2 + kstep;
            PG8_LDB(B0, 0, 0); if (!Q) PG8_LDB(B1, 0, 1); PG8_SCHED; PG8_LDA(At, 0, 0); PG8_STAGE(PG8_SA(1, 1), a1 + hstepA, voffA);
            PG8_WAIT_V(8); PG8_WAIT_L(0); PG8_BAR; PG8_MMA(0, 0, At, B0); if (!Q) PG8_MMA(0, 1, At, B1); PG8_BAR; PG8_SCHED;
            if (!Q) PG8_LDA(At, 0, 1); PG8_STAGE(PG8_SB(0, 0), b2, voffB); PG8_STAGE(PG8_SB(0, 1), b2 + hstepB, voffB); PG8_STAGE(PG8_SA(0, 0), a2, voffA);
            PG8_WAIT_V(8); PG8_WAIT_L(0); PG8_BAR; if (!Q) { PG8_MMA(1, 0, At, B0); PG8_MMA(1, 1, At, B1); } PG8_BAR; PG8_SCHED;
            PG8_LDB(B0, 1, 0); if (!Q) PG8_LDB(B1, 1, 1); PG8_SCHED; PG8_LDA(At, 1, 0); PG8_STAGE(PG8_SA(0, 1), a2 + hstepA, voffA);
            PG8_WAIT_V(8); PG8_WAIT_L(0); PG8_BAR; PG8_MMA(0, 0, At, B0); if (!Q) PG8_MMA(0, 1, At, B1); PG8_BAR; PG8_SCHED;
            if (!Q) PG8_LDA(At, 1, 1); PG8_STAGE(PG8_SB(1, 0), b3, voffB); PG8_STAGE(PG8_SB(1, 1), b3 + hstepB, voffB); PG8_STAGE(PG8_SA(1, 0), a3, voffA);
            PG8_WAIT_V(8); PG8_WAIT_L(0); PG8_BAR; if (!Q) { PG8_MMA(1, 0, At, B0); PG8_MMA(1, 1, At, B1); } PG8_BAR; PG8_SCHED;
        }
        if (wr == 0) PG8_BAR;
        E.template run<Q>(acc, cur, wr, wc, fr, fq);
        if (!has_next) break;
        if (!E.keep(cur)) {
#pragma unroll
        for (int a = 0; a < 2; ++a)
#pragma unroll
            for (int b = 0; b < 2; ++b)
#pragma unroll
                for (int m = 0; m < 4; ++m)
#pragma unroll
                    for (int n = 0; n < 2; ++n) acc[a][b][m][n] = (f32x4){0.f, 0.f, 0.f, 0.f};
        }
        cur = nxt; cA = nA; cB = nB; ++ui;
        if (wr == 1) PG8_BAR;
    }
    PG8_WAIT_V(0);
    PG8_BAR;
#undef PG8_SA
#undef PG8_SB
#undef PG8_STAGE
#undef PG8_LDA
#undef PG8_LDB
#undef PG8_MMA
#undef PG8_WAIT_V
#undef PG8_WAIT_L
#undef PG8_BAR
#undef PG8_SCHED
}

template <class Epi, class Sched>
__device__ __forceinline__ void gemm_quarter(LAS unsigned char* lds, const Gemm g, const Sched& S, const Epi& E) {
    int tid = threadIdx.x; asm volatile("" : "+v"(tid));
    const int wid = __builtin_amdgcn_readfirstlane(tid >> 6), lane = tid & 63, wr = wid >> 2, wc = wid & 3, fr = lane & 15, fq = lane >> 4;
    const int nt = g.K / BK;
    unsigned voffA[2], voffB[2];
#pragma unroll
    for (int i = 0; i < 2; ++i) { int R, C; stage_rc(tid * 16 + i * 8192, R, C); const int Rb = Epi::PERM ? ((R & ~31) + perm32(R & 31)) : R;
        voffA[i] = (unsigned)(R * g.lda + C) * 2u; voffB[i] = (unsigned)(Rb * g.ldb + C) * 2u; }
    const unsigned ldsw = (unsigned)wid * 1024u;
    const int aoff = lds_byte(wr * 64 + fr, fq * 8), boff = lds_byte(wc * 32 + fr, fq * 8);
#define GQ_STAGE(slot, ga, gb) do { _Pragma("unroll") for (int _i = 0; _i < 2; ++_i) { \
        __builtin_amdgcn_global_load_lds((const unsigned*)((const char*)(ga) + voffA[_i]), (LAS unsigned*)(lds + (slot) * 32768 + ldsw + _i * 8192), 16, 0, 0); \
        __builtin_amdgcn_global_load_lds((const unsigned*)((const char*)(gb) + voffB[_i]), (LAS unsigned*)(lds + (slot) * 32768 + 16384 + ldsw + _i * 8192), 16, 0, 0); } } while (0)
    f32x4 acc[2][2][4][2];
    Unit cur; bool kept = false;
    for (int ui = 0; S.next(ui, cur); ++ui) {
        if (!kept) {
#pragma unroll
            for (int m = 0; m < 4; ++m)
#pragma unroll
                for (int n = 0; n < 2; ++n) acc[0][0][m][n] = (f32x4){0.f, 0.f, 0.f, 0.f};
        }
        const char* cA = cur.a; const char* cB = cur.b;
#pragma unroll
        for (int s4 = 0; s4 < 4; ++s4) GQ_STAGE(s4, cA + (size_t)s4 * (BK * 2), cB + (size_t)s4 * (BK * 2));
        for (int t = 0; t < nt; ++t) {
            const int slot = t & 3;
            asm volatile("s_waitcnt vmcnt(12)" ::: "memory");
            __builtin_amdgcn_s_barrier();
            bf16x8 At[4][2], B0[2][2];
#pragma unroll
            for (int n = 0; n < 2; ++n)
#pragma unroll
                for (int k = 0; k < 2; ++k) B0[n][k] = *(const LAS bf16x8*)(lds + slot * 32768 + 16384 + boff + n * 2048 + k * 1024);
#pragma unroll
            for (int m = 0; m < 4; ++m)
#pragma unroll
                for (int k = 0; k < 2; ++k) At[m][k] = *(const LAS bf16x8*)(lds + slot * 32768 + aoff + m * 2048 + k * 1024);
            asm volatile("s_waitcnt lgkmcnt(0)" ::: "memory");
            __builtin_amdgcn_s_barrier();
            const int tn = (t + 4 < nt) ? t + 4 : 0;
            GQ_STAGE(slot, cA + (size_t)tn * (BK * 2), cB + (size_t)tn * (BK * 2));
#pragma unroll
            for (int m = 0; m < 4; ++m)
#pragma unroll
                for (int n = 0; n < 2; ++n)
#pragma unroll
                    for (int k = 0; k < 2; ++k) acc[0][0][m][n] = __builtin_amdgcn_mfma_f32_16x16x32_bf16(B0[n][k], At[m][k], acc[0][0][m][n], 0, 0, 0);
        }
        asm volatile("s_waitcnt vmcnt(0)" ::: "memory");
        __builtin_amdgcn_s_barrier();
        E.template run<true>(acc, cur, wr, wc, fr, fq);
        kept = E.keep(cur);
    }
#undef GQ_STAGE
}
}

template <class T> __device__ __forceinline__ T* asg(T* p) { return (T*)(__attribute__((address_space(1))) T*)(unsigned long long)p; }
struct WsPtrs {
    unsigned char* ws;
#define WSP(name, T, off) __device__ __forceinline__ T* name() const { return (T*)(ws + (off)); }
    WSP(U, bf16_t, WS_U) WSP(SZ, bf16_t, WS_SZ) WSP(QB, bf16_t, WS_QB) WSP(KB, bf16_t, WS_KB) WSP(VB, bf16_t, WS_VB) WSP(QC, bf16_t, WS_QC) WSP(KC, bf16_t, WS_KC) WSP(VC, bf16_t, WS_VC)
    WSP(G, bf16_t, WS_G) WSP(YG, bf16_t, WS_YG) WSP(Y, bf16_t, WS_Y) WSP(MX, bf16_t, WS_MX) WSP(A0, bf16_t, WS_A0) WSP(KCS, bf16_t, WS_KCS) WSP(VCS, bf16_t, WS_VCS) WSP(KBS, bf16_t, WS_KBS) WSP(VBS, bf16_t, WS_VBS)
    WSP(Y0, float, WS_Y0) WSP(SSQ0, float, WS_SSQ0) WSP(SSQ1, float, WS_SSQ1)
#undef WSP
};
#ifndef G_NATIVE
#define G_NATIVE 1
#endif
#if G_NATIVE
__device__ __forceinline__ size_t g_slot(int pm, int gt, int wv, int ai, int m, int bjx, int lane) { return ((((((size_t)pm * 48 + gt) * 8 + wv) * 2 + ai) * 4 + m) * 2 + bjx) * 64 + lane; }
#else
__device__ __forceinline__ size_t g_slot(int pm, int gt, int wv, int ai, int m, int bjx, int lane) { const int row = pm * 256 + ai * 128 + (wv >> 2) * 64 + m * 16 + (lane & 15); return (size_t)row * 1536 + gt * 32 + bjx * 16 + (wv & 3) * 4 + (lane >> 4); }
#endif
typedef unsigned short u16x2 __attribute__((ext_vector_type(2)));
__device__ __forceinline__ unsigned pkmin_u16(unsigned a, unsigned b) { return __builtin_bit_cast(unsigned, __builtin_elementwise_min(__builtin_bit_cast(u16x2, a), __builtin_bit_cast(u16x2, b))); }
__device__ __forceinline__ void st_bf16x8_cap(bf16_t* p, f32x4 v0, f32x4 v1) {
    u32x4 w; w.x = pkmin_u16(pk2(v0[0], v0[1]), 0x71497149u); w.y = pkmin_u16(pk2(v0[2], v0[3]), 0x71497149u); w.z = pkmin_u16(pk2(v1[0], v1[1]), 0x71497149u); w.w = pkmin_u16(pk2(v1[2], v1[3]), 0x71497149u); __builtin_nontemporal_store(w, (u32x4*)p);
}
__device__ __forceinline__ void st_bf16x8(bf16_t* p, f32x4 v0, f32x4 v1) {
    u32x4 w; w.x = pk2(v0[0], v0[1]); w.y = pk2(v0[2], v0[3]); w.z = pk2(v1[0], v1[1]); w.w = pk2(v1[2], v1[3]); *(u32x4*)p = w;
}
struct Epi1 {
    static constexpr bool PERM = true;
    __device__ __forceinline__ bool keep(const pg8::Unit&) const { return false; }
    const float* ssq; const float* gate_b; float* out; WsPtrs W; int layer;
    template <bool Q> __device__ __forceinline__ void run(f32x4 (&acc)[2][2][4][2], const pg8::Unit& u, int wr, int wc, int fr, int fq) const {
        constexpr int NAI = Q ? 1 : 2, NBJ = Q ? 1 : 2;
        const int sec = u.pn >> 2;
        const int colt = (u.pn & 3) * 256 + u.cs + wc * 32 + 8 * fq;
        int mode = 0, ld = 1024, coff = 0, special = 0; float scale = 1.f; bf16_t* base;
        if (sec >= 10) { mode = 2; base = W.G(); ld = 12288; coff = (sec - 10) * 1024; }
        else if (sec == 1 || sec == 5 || sec == 9) { mode = 1; base = W.SZ(); ld = 3072; coff = (sec == 1) ? 0 : (sec == 5 ? 1024 : 2048); }
        else { base = (sec == 0) ? W.U() : (sec == 2) ? W.QB() : (sec == 3) ? W.KB() : (sec == 4) ? W.VB() : (sec == 6) ? W.QC() : (sec == 7) ? W.KC() : W.VC();
               if (sec == 6) scale = 0.08838834764831845f * LOG2E; special = (sec == 4 || sec == 7 || sec == 8) ? sec : 0; }
        f32x4 bv[NBJ][2];
#pragma unroll
        for (int bj = 0; bj < NBJ; ++bj)
#pragma unroll
            for (int n = 0; n < 2; ++n) bv[bj][n] = (mode == 2) ? *(const f32x4*)(gate_b + coff + colt + bj * 128 + 4 * n) * (-LOG2E) : (f32x4){0.f, 0.f, 0.f, 0.f};
        const int l = layer, row0 = u.pm * 256 + wr * 64 + fr;
        float rs[NAI][4];
#pragma unroll
        for (int ai = 0; ai < NAI; ++ai)
#pragma unroll
            for (int m = 0; m < 4; ++m) rs[ai][m] = ssq[row0 + ai * 128 + m * 16];
#pragma unroll
        for (int ai = 0; ai < NAI; ++ai)
#pragma unroll
            for (int m = 0; m < 4; ++m) rs[ai][m] = __builtin_amdgcn_rsqf(rs[ai][m] * (1.0f / 4096.0f) + 1e-6f) * scale;
        if (mode == 2) scale = -LOG2E;
#pragma unroll
        for (int ai = 0; ai < NAI; ++ai)
#pragma unroll
            for (int m = 0; m < 4; ++m) {
                const int row = row0 + ai * 128 + m * 16;
                bf16_t* d16 = base + (size_t)row * ld + coff + colt; float* d32 = nullptr;
                if (special) {
                    if (!Q) { const int b = row >> 11, t = row & 2047;
                        if (special == 7) d32 = out + O_PSBK + ((size_t)l * MP + row) * 1024 + colt;
                        else if (special == 8) d32 = out + O_PSBV + ((size_t)l * MP + row) * 1024 + colt;
                        else if (t >= SEQ - BANDK) d32 = out + O_PBV + ((size_t)(l * NB + b) * BANDK + (t - (SEQ - BANDK))) * 1024 + colt;
                    } else { const int sr = row - MP, b = sr >> 4, t = sr & 15;
                        if (special == 7) { d16 = W.KCS() + ((size_t)(l * NB + b) * KCS_ROWS + PASTL + t) * 1024 + colt; d32 = out + O_SSBK + ((size_t)l * MS + sr) * 1024 + colt; }
                        else if (special == 8) { d16 = W.VCS() + ((size_t)(l * NB + b) * KCS_ROWS + PASTL + t) * 1024 + colt; d32 = out + O_SSBV + ((size_t)l * MS + sr) * 1024 + colt; }
                        else { d16 = W.VBS() + ((size_t)(l * NB + b) * KBS_ROWS + BANDK + t) * 1024 + colt; d32 = out + O_SBV + ((size_t)l * MS + sr) * 1024 + colt; }
                    }
                }
#pragma unroll
                for (int bj = 0; bj < NBJ; ++bj) {
                    if (mode == 2) {
                        const float nrs = rs[ai][m] * scale;
                        f32x4 v0 = acc[ai][bj][m][0] * nrs + bv[bj][0], v1 = acc[ai][bj][m][1] * nrs + bv[bj][1];
#pragma unroll
                        for (int j = 0; j < 4; ++j) { v0[j] = ex2(v0[j]); v1[j] = ex2(v1[j]); }
                        v0 = v0 + 1.0f; v1 = v1 + 1.0f;
                        st_bf16x8_cap(W.G() + 8 * g_slot(u.pm, u.pn - 40, wr * 4 + wc, ai, m, bj + (u.cs >> 7), fq * 16 + fr), v0, v1);
                    } else {
                    f32x4 v0 = acc[ai][bj][m][0] * rs[ai][m], v1 = acc[ai][bj][m][1] * rs[ai][m];
                    if (mode == 1) {
#pragma unroll
                        for (int j = 0; j < 4; ++j) { v0[j] = v0[j] * sigmoidf_(v0[j]); v1[j] = v1[j] * sigmoidf_(v1[j]); } }
                    st_bf16x8(d16 + bj * 128, v0, v1);
                    if (d32) { __builtin_nontemporal_store(v0, (f32x4*)(d32 + bj * 128)); __builtin_nontemporal_store(v1, (f32x4*)(d32 + bj * 128 + 4)); }
                    }
                }
            }
    }
};
struct EpiNull {
    static constexpr bool PERM = true;
    __device__ __forceinline__ bool keep(const pg8::Unit&) const { return false; }
    float* sink;
    template <bool Q> __device__ __forceinline__ void run(f32x4 (&acc)[2][2][4][2], const pg8::Unit& u, int wr, int wc, int fr, int fq) const {
        float s = 0.f;
#pragma unroll
        for (int ai = 0; ai < 2; ++ai)
#pragma unroll
            for (int bj = 0; bj < 2; ++bj)
#pragma unroll
                for (int m = 0; m < 4; ++m)
#pragma unroll
                    for (int n = 0; n < 2; ++n) s += (acc[ai][bj][m][n][0] + acc[ai][bj][m][n][1]) + (acc[ai][bj][m][n][2] + acc[ai][bj][m][n][3]);
        if (s == 1.2345e30f) sink[u.pm + u.pn + wr + wc + fr + fq] = s;
    }
};
struct EpiGlu {
    static constexpr bool PERM = true;
    __device__ __forceinline__ bool keep(const pg8::Unit&) const { return false; }
    const float* bglu; WsPtrs W;
    template <bool Q> __device__ __forceinline__ void run(f32x4 (&acc)[2][2][4][2], const pg8::Unit& u, int wr, int wc, int fr, int fq) const {
        constexpr int NAI = Q ? 1 : 2, NBJ = Q ? 1 : 2;
        const int colt = u.pn * 256 + u.cs + wc * 32 + 8 * fq, row0 = u.pm * 256 + wr * 64 + fr;
        f32x4 bv[NBJ][2];
#pragma unroll
        for (int bj = 0; bj < NBJ; ++bj)
#pragma unroll
            for (int n = 0; n < 2; ++n) bv[bj][n] = *(const f32x4*)(bglu + colt + bj * 128 + 4 * n);
#pragma unroll
        for (int aim = 0; aim < 2 * NAI; ++aim) { const int ai = aim >> 1, mb = (aim & 1) * 2;
            u32x4 yg[4][NBJ], sz[4][NBJ];
#pragma unroll
            for (int m = mb; m < mb + 2; ++m)
#pragma unroll
                for (int bj = 0; bj < NBJ; ++bj) { const int row = row0 + ai * 128 + m * 16, col = colt + bj * 128;
                    yg[m][bj] = __builtin_nontemporal_load((const u32x4*)(W.YG() + (size_t)row * 1024 + col)); sz[m][bj] = __builtin_nontemporal_load((const u32x4*)(W.SZ() + (size_t)row * 3072 + col)); }
#pragma unroll
            for (int m = mb; m < mb + 2; ++m)
#pragma unroll
                for (int bj = 0; bj < NBJ; ++bj) { const int row = row0 + ai * 128 + m * 16, col = colt + bj * 128;
                    const u32x4 y = yg[m][bj], z = sz[m][bj];
                    f32x4 v0 = acc[ai][bj][m][0] + bv[bj][0], v1 = acc[ai][bj][m][1] + bv[bj][1];
                    v0[0] = bflo(y.x) * sigmoidf_(v0[0]) * bflo(z.x); v0[1] = bfhi(y.x) * sigmoidf_(v0[1]) * bfhi(z.x);
                    v0[2] = bflo(y.y) * sigmoidf_(v0[2]) * bflo(z.y); v0[3] = bfhi(y.y) * sigmoidf_(v0[3]) * bfhi(z.y);
                    v1[0] = bflo(y.z) * sigmoidf_(v1[0]) * bflo(z.z); v1[1] = bfhi(y.z) * sigmoidf_(v1[1]) * bfhi(z.z);
                    v1[2] = bflo(y.w) * sigmoidf_(v1[2]) * bflo(z.w); v1[3] = bfhi(y.w) * sigmoidf_(v1[3]) * bfhi(z.w);
                    st_bf16x8(W.Y() + (size_t)row * 3072 + col, v0, v1); }
        }
    }
};
struct EpiBr {
    static constexpr bool PERM = true;
    WsPtrs W;
    __device__ __forceinline__ bool keep(const pg8::Unit& u) const { return u.aux < 2; }
    template <bool Q> __device__ __forceinline__ void run(f32x4 (&acc)[2][2][4][2], const pg8::Unit& u, int wr, int wc, int fr, int fq) const {
        constexpr int NAI = Q ? 1 : 2, NBJ = Q ? 1 : 2;
        const int colt = u.pn * 256 + u.cs + wc * 32 + 8 * fq, br = u.aux, row0 = u.pm * 256 + wr * 64 + fr;
        if (br < 2) {
#pragma unroll
            for (int ai = 0; ai < NAI; ++ai) { constexpr int mb = 0;
                u32x4 gn[4][NBJ], gd[4][NBJ];
#pragma unroll
                for (int m = mb; m < mb + 4; ++m)
#pragma unroll
                    for (int bj = 0; bj < NBJ; ++bj) { const int bjx = bj + (u.cs >> 7), wv = wr * 4 + wc, ln = fq * 16 + fr;
                        gn[m][bj] = __builtin_nontemporal_load((const u32x4*)(W.G() + 8 * g_slot(u.pm, br * 16 + u.pn, wv, ai, m, bjx, ln))); gd[m][bj] = __builtin_nontemporal_load((const u32x4*)(W.G() + 8 * g_slot(u.pm, (br + 1) * 16 + u.pn, wv, ai, m, bjx, ln))); }
#pragma unroll
                for (int m = mb; m < mb + 4; ++m)
#pragma unroll
                    for (int bj = 0; bj < NBJ; ++bj) { const u32x4 a = gn[m][bj], d = gd[m][bj]; f32x4& v0 = acc[ai][bj][m][0]; f32x4& v1 = acc[ai][bj][m][1];
#define RAT(de, nu) ((nu) * __builtin_amdgcn_rcpf(de))
                        v0[0] *= RAT(bflo(a.x), bflo(d.x)); v0[1] *= RAT(bfhi(a.x), bfhi(d.x)); v0[2] *= RAT(bflo(a.y), bflo(d.y)); v0[3] *= RAT(bfhi(a.y), bfhi(d.y));
                        v1[0] *= RAT(bflo(a.z), bflo(d.z)); v1[1] *= RAT(bfhi(a.z), bfhi(d.z)); v1[2] *= RAT(bflo(a.w), bflo(d.w)); v1[3] *= RAT(bfhi(a.w), bfhi(d.w));
#undef RAT
                    }
            }
        } else {
#pragma unroll
            for (int ai = 0; ai < NAI; ++ai) {
                u32x4 g2[4][NBJ];
#pragma unroll
                for (int m = 0; m < 4; ++m)
#pragma unroll
                    for (int bj = 0; bj < NBJ; ++bj) g2[m][bj] = __builtin_nontemporal_load((const u32x4*)(W.G() + 8 * g_slot(u.pm, 32 + u.pn, wr * 4 + wc, ai, m, bj + (u.cs >> 7), fq * 16 + fr)));
#pragma unroll
                for (int m = 0; m < 4; ++m)
#pragma unroll
                    for (int bj = 0; bj < NBJ; ++bj) { const u32x4 g = g2[m][bj]; const f32x4 v0 = acc[ai][bj][m][0], v1 = acc[ai][bj][m][1];
                        f32x4 o0, o1;
                        o0[0] = v0[0] * __builtin_amdgcn_rcpf(bflo(g.x)); o0[1] = v0[1] * __builtin_amdgcn_rcpf(bfhi(g.x)); o0[2] = v0[2] * __builtin_amdgcn_rcpf(bflo(g.y)); o0[3] = v0[3] * __builtin_amdgcn_rcpf(bfhi(g.y));
                        o1[0] = v1[0] * __builtin_amdgcn_rcpf(bflo(g.z)); o1[1] = v1[1] * __builtin_amdgcn_rcpf(bfhi(g.z)); o1[2] = v1[2] * __builtin_amdgcn_rcpf(bflo(g.w)); o1[3] = v1[3] * __builtin_amdgcn_rcpf(bfhi(g.w));
                        st_bf16x8(W.MX() + (size_t)(row0 + ai * 128 + m * 16) * 4096 + colt + bj * 128, o0, o1); }
            }
        }
    }
};
struct EpiOut {
    static constexpr bool PERM = false;
    __device__ __forceinline__ bool keep(const pg8::Unit&) const { return false; }
    const float* xp; const float* xs; const float* ng1; float* out; WsPtrs W; int layer;
    template <bool Q> __device__ __forceinline__ void run(f32x4 (&acc)[2][2][4][2], const pg8::Unit& u, int wr, int wc, int fr, int fq) const {
        constexpr int NAI = Q ? 1 : 2, NBJ = Q ? 1 : 2;
        const int colt = u.pn * 256 + u.cs + wc * 32 + 4 * fq, row0 = u.pm * 256 + wr * 64 + fr;
        f32x4 gg[NBJ][2];
#pragma unroll
        for (int bj = 0; bj < NBJ; ++bj)
#pragma unroll
            for (int n = 0; n < 2; ++n) gg[bj][n] = (layer == 0) ? *(const f32x4*)(ng1 + colt + bj * 128 + n * 16) : (f32x4){0.f, 0.f, 0.f, 0.f};
#pragma unroll
        for (int aim = 0; aim < 2 * NAI; ++aim) { const int ai = aim >> 1, mb = (aim & 1) * 2;
            f32x4 rv[4][NBJ][2];
#pragma unroll
            for (int m = mb; m < mb + 2; ++m) { const int row = row0 + ai * 128 + m * 16;
                const float* res = (layer == 0) ? (Q ? xs + (size_t)(row - MP) * DM : xp + (size_t)row * DM) : W.Y0() + (size_t)row * DM;
#pragma unroll
                for (int bj = 0; bj < NBJ; ++bj)
#pragma unroll
                    for (int n = 0; n < 2; ++n) rv[m][bj][n] = __builtin_nontemporal_load((const f32x4*)(res + colt + bj * 128 + n * 16)); }
#pragma unroll
            for (int m = mb; m < mb + 2; ++m) { const int row = row0 + ai * 128 + m * 16;
                float* dst = (layer == 0) ? W.Y0() + (size_t)row * DM : (Q ? out + O_YS + (size_t)(row - MP) * DM : out + O_YP + (size_t)row * DM);
                float ss = 0.f;
#pragma unroll
                for (int bj = 0; bj < NBJ; ++bj)
#pragma unroll
                    for (int n = 0; n < 2; ++n) { const int col = colt + bj * 128 + n * 16;
                        const f32x4 y = acc[ai][bj][m][n] + rv[m][bj][n];
                        __builtin_nontemporal_store(y, (f32x4*)(dst + col));
                        if (layer == 0) { const f32x4 g4 = gg[bj][n]; ss += (y[0] * y[0] + y[1] * y[1]) + (y[2] * y[2] + y[3] * y[3]);
                            u32x2 w; w.x = pk2(y[0] * g4[0], y[1] * g4[1]); w.y = pk2(y[2] * g4[2], y[3] * g4[3]); *(u32x2*)(W.A0() + (size_t)row * DM + col) = w; } }
                if (layer == 0) { ss += __shfl_xor(ss, 16); ss += __shfl_xor(ss, 32); if (fq == 0) atomicAdd(W.SSQ1() + row, ss); }
            }
        }
    }
};

#define XB_TMO      128
#define XB_XCNT(j)  (256  + 64 * (j))
#define XB_XSUB(j)  (1280 + 64 * (j))
#define XB_XGEN(j)  (2304 + 64 * (j))
#define XB_TOP      3328
#define XB_TOPGEN   3392
#define XCD_BAR_WORDS 3456
#define XB_SPIN_CAP (1u << 22)
__device__ __forceinline__ unsigned xb_ld(unsigned* p)              { return __hip_atomic_load(p, __ATOMIC_RELAXED, __HIP_MEMORY_SCOPE_AGENT); }
__device__ __forceinline__ unsigned xb_add(unsigned* p, unsigned v) { return __hip_atomic_fetch_add(p, v, __ATOMIC_RELAXED, __HIP_MEMORY_SCOPE_AGENT); }
__device__ __forceinline__ unsigned xb_xcc_id() { return (unsigned)__builtin_amdgcn_s_getreg((3 << 11) | 20) & 0xFu; }
#define XB_SPIN(cond, bar) do { unsigned _sp = 0; while (cond) { __builtin_amdgcn_s_sleep(1); \
    if ((++_sp & 255u) == 0u) { if (xb_ld(&(bar)[XB_TMO])) break; if (_sp > XB_SPIN_CAP) { atomicAdd(&(bar)[XB_TMO], 1u); break; } } } } while (0)
struct XcdBarrier { unsigned* bar; unsigned x; volatile LAS unsigned* st; };
__device__ __forceinline__ XcdBarrier xcd_barrier_post(unsigned* bar, volatile LAS unsigned* st) {
    XcdBarrier b; b.bar = bar; b.x = xb_xcc_id(); b.st = st;
    if (threadIdx.x == 0) (void)xb_add(&bar[XB_XCNT(b.x)], 1u);
    return b;
}
__device__ __forceinline__ void xcd_barrier_complete(unsigned* bar, unsigned x, unsigned& nloc, unsigned& nx) {
    const unsigned G = gridDim.x * gridDim.y * gridDim.z;
    unsigned sum, cnt, mine, sp = 0u;
    for (;;) {
        sum = 0u; cnt = 0u; mine = 0u;
#pragma unroll
        for (unsigned j = 0; j < 16; ++j) { const unsigned c = xb_ld(&bar[XB_XCNT(j)]); sum += c; cnt += (c > 0u) ? 1u : 0u; mine = (j == x) ? c : mine; }
        if (sum == G) break;
        __builtin_amdgcn_s_sleep(1);
        if ((++sp & 255u) == 0u) { if (xb_ld(&bar[XB_TMO])) break; if (sp > XB_SPIN_CAP) { atomicAdd(&bar[XB_TMO], 1u); break; } }
    }
    nloc = mine > 0u ? mine : 1u; nx = cnt > 0u ? cnt : 1u;
}
__device__ __forceinline__ void xcd_barrier(const XcdBarrier& b) {
    asm volatile("s_waitcnt vmcnt(0)" ::: "memory");
    __syncthreads();
    if (threadIdx.x == 0) {
        unsigned* bar = b.bar;
        __builtin_amdgcn_s_waitcnt(0);
        unsigned nloc = b.st[0], nx = b.st[1];
        if (nloc == 0u) { xcd_barrier_complete(bar, b.x, nloc, nx); b.st[0] = nloc; b.st[1] = nx; }
        const unsigned old = xb_add(&bar[XB_XSUB(b.x)], 1u);
        const unsigned gen = old / nloc;
        if (old + 1u == (gen + 1u) * nloc) {
            __builtin_amdgcn_fence(__ATOMIC_RELEASE, "agent");
            asm volatile("s_waitcnt vmcnt(0)" ::: "memory");
            const unsigned og = xb_add(&bar[XB_TOP], 1u);
            const unsigned tg = og / nx;
            if (og + 1u == (tg + 1u) * nx) xb_add(&bar[XB_TOPGEN], 1u);
            else XB_SPIN(xb_ld(&bar[XB_TOPGEN]) == tg, bar);
            __builtin_amdgcn_fence(__ATOMIC_ACQUIRE, "agent");
            xb_add(&bar[XB_XGEN(b.x)], 1u);
            asm volatile("s_waitcnt vmcnt(0)" ::: "memory");
        } else {
            XB_SPIN(xb_ld(&bar[XB_XGEN(b.x)]) == gen, bar);
            __builtin_amdgcn_fence(__ATOMIC_ACQUIRE, "agent");
            asm volatile("s_waitcnt vmcnt(0)" ::: "memory");
        }
    }
    __syncthreads();
}

__device__ __forceinline__ void transpose_item(const float* W, int K, int N, bf16_t* WT, LAS float* scr, int item, int lane_) {
    int lane = lane_; asm volatile("" : "+v"(lane));
    const int sup = item >> 3, sub = item & 7, nsup = N / 128, kb4 = sup / nsup, nb2 = sup - kb4 * nsup, kb = 4 * kb4 + (sub >> 1), nb = 2 * nb2 + (sub & 1), k0 = 64 * kb, n0 = 64 * nb;
    const int kq = lane >> 4, nq = lane & 15;
#pragma unroll 4
    for (int i = 0; i < 16; ++i) { const int kk = 4 * i + kq; const f32x4 v = __builtin_nontemporal_load((const f32x4*)(W + (size_t)(k0 + kk) * N + n0 + 4 * nq));
        LAS float* s = scr + kk * 65 + 4 * nq; s[0] = v[0]; s[1] = v[1]; s[2] = v[2]; s[3] = v[3]; }
    LDS_WAIT();
    const int c = lane & 7, nl = lane >> 3;
#pragma unroll
    for (int j = 0; j < 8; ++j) { const int n = 8 * j + nl; const LAS float* s = scr + (8 * c) * 65 + n;
        u32x4 o; o.x = pk2(s[0 * 65], s[1 * 65]); o.y = pk2(s[2 * 65], s[3 * 65]); o.z = pk2(s[4 * 65], s[5 * 65]); o.w = pk2(s[6 * 65], s[7 * 65]);
        *(u32x4*)(WT + (size_t)(n0 + n) * K + k0 + 8 * c) = o; }
    LDS_WAIT();
}
__device__ __forceinline__ float wave_sum(float v) {
#pragma unroll
    for (int o = 1; o < 64; o <<= 1) v += __shfl_xor(v, o);
    return v;
}
__device__ __forceinline__ void xrow_to_a0(const float* xrow, const float* g, bf16_t* orow, float* ssq, int lane) {
    float s = 0.f;
#pragma unroll 4
    for (int j = 0; j < 16; ++j) { const f32x4 v = __builtin_nontemporal_load((const f32x4*)xrow + lane + 64 * j), gg = *((const f32x4*)g + lane + 64 * j);
        s += (v[0] * v[0] + v[1] * v[1]) + (v[2] * v[2] + v[3] * v[3]);
        u32x2 w; w.x = pk2(v[0] * gg[0], v[1] * gg[1]); w.y = pk2(v[2] * gg[2], v[3] * gg[3]); *((u32x2*)orow + lane + 64 * j) = w; }
    s = wave_sum(s);
    if (lane == 0) *ssq = s;
}

constexpr int SSM_PITCH = 132, SSM_TP = 36, SSM_WAVE_BYTES = 128 * SSM_TP * 4 + 1024;
static_assert(128 * SSM_TP >= 32 * SSM_PITCH, "h image fits the Bu^T region");
template <int NT> __device__ __forceinline__ void ssm_unit(LAS float* S, const unsigned char* ws, const float* dskip_l, int l, int g, const bf16_t* U, bf16_t* YG, int row0, int ntok,
                                         const float* h0re, const float* h0im, float* ore, float* oim, int lane_) {
    int lane = lane_; asm volatile("" : "+v"(lane));
    const int r32 = lane & 31, hi = lane >> 5, p16 = lane & 15, q4 = lane >> 4;
    LAS bf16_t* Us = (LAS bf16_t*)(S + 128 * SSM_TP);
    const f32x2 ab = *((const f32x2*)(ws + WS_ABAR) + (size_t)(l * NG + g) * NST + lane);
    const float ar = ab[0], ai = ab[1];
    bf16x8 bmf[4], cmf[4];
    const bf16_t* BMT = (const bf16_t*)(ws + WS_BMT) + (size_t)(l * NG + g) * 128 * 16;
    const bf16_t* CMT = (const bf16_t*)(ws + WS_CMT) + (size_t)(l * NG + g) * 16 * 128;
#pragma unroll
    for (int nb = 0; nb < 4; ++nb) bmf[nb] = *(const bf16x8*)(BMT + (size_t)(32 * nb + r32) * 16 + 8 * hi);
#pragma unroll
    for (int kb = 0; kb < 4; ++kb) cmf[kb] = *(const bf16x8*)(CMT + (size_t)p16 * 128 + 32 * kb + 8 * q4);
    const float dsk = dskip_l[16 * g + p16];
    float hr = h0re ? h0re[lane] : 0.f, hm = h0im ? h0im[lane] : 0.f;
    const bf16_t* up = U + (size_t)(row0 + r32) * 1024 + 16 * g + 8 * hi;
    bf16x8 uf = __builtin_nontemporal_load((const bf16x8*)up);
    for (int t0 = 0; t0 < ntok; t0 += 32) {
        const bf16x8 ucur = uf;
        if (t0 + 32 < ntok) uf = __builtin_nontemporal_load((const bf16x8*)(up + (size_t)(t0 + 32) * 1024));
        *(LAS bf16x8*)(Us + r32 * 16 + 8 * hi) = ucur;
#pragma unroll
        for (int nb = 0; nb < 4; ++nb) {
            f32x16 acc = {};
            acc = __builtin_amdgcn_mfma_f32_32x32x16_bf16(ucur, bmf[nb], acc, 0, 0, 0);
#pragma unroll
            for (int q = 0; q < 4; ++q) *(LAS f32x4*)(S + (32 * nb + r32) * SSM_TP + 8 * q + 4 * hi) = (f32x4){acc[4 * q], acc[4 * q + 1], acc[4 * q + 2], acc[4 * q + 3]};
        }
        LDS_WAIT();
        f32x4 br[NT / 4], bi[NT / 4];
#pragma unroll
        for (int t4 = 0; t4 < NT / 4; ++t4) { br[t4] = *(const LAS f32x4*)(S + lane * SSM_TP + 4 * t4); bi[t4] = *(const LAS f32x4*)(S + (64 + lane) * SSM_TP + 4 * t4); }
        LDS_WAIT();
#pragma unroll
        for (int t = 0; t < NT; ++t) {
            const float nr = ar * hr - ai * hm + br[t >> 2][t & 3], ni = ar * hm + ai * hr + bi[t >> 2][t & 3];
            hr = nr; hm = ni;
            S[t * SSM_PITCH + lane] = hr; S[t * SSM_PITCH + 64 + lane] = hm;
        }
        LDS_WAIT();
#pragma unroll
        for (int th = 0; th < NT / 16; ++th) {
            f32x4 ya = {0.f, 0.f, 0.f, 0.f};
#pragma unroll
            for (int kb = 0; kb < 4; ++kb) {
                const LAS float* sp = S + (16 * th + p16) * SSM_PITCH + 32 * kb + 8 * q4;
                const f32x4 a0 = *(const LAS f32x4*)sp, a1 = *(const LAS f32x4*)(sp + 4);
                u32x4 w; w.x = pk2(a0[0], a0[1]); w.y = pk2(a0[2], a0[3]); w.z = pk2(a1[0], a1[1]); w.w = pk2(a1[2], a1[3]);
                ya = __builtin_amdgcn_mfma_f32_16x16x32_bf16(__builtin_bit_cast(bf16x8, w), cmf[kb], ya, 0, 0, 0);
            }
#pragma unroll
            for (int j = 0; j < 4; ++j) {
                const int tl = 16 * th + 4 * q4 + j, tt = t0 + tl;
                const float y = ya[j] + dsk * bf2f(Us[tl * 16 + p16]);
                const float ge = y * __builtin_amdgcn_rcpf(1.0f + ex2(-2.3022081985f * y * (1.0f + 0.044715f * y * y)));
                YG[(size_t)(row0 + tt) * 1024 + 16 * g + p16] = f2bf(ge);
            }
        }
        LDS_WAIT();
    }
    ore[lane] = hr; oim[lane] = hm;
}

namespace att {
constexpr int L_V = 0, L_K = 16384, L_BUF = 32768, L_WS = 65536, L_BIAS = 67584, L_FLAG = 68864, L_OST = 73728;
#define KSWZ(row, colB) ((row) * 256 + ((colB) ^ (((row) & 7) << 4)))
#define SBAR() __builtin_amdgcn_sched_barrier(0)
__device__ __forceinline__ int crow(int r, int hi) { return (r & 3) + 8 * (r >> 2) + 4 * hi; }
__device__ __forceinline__ int v_st(int k, int c) { const int kk = (k & ~0xC) | ((k & 4) << 1) | ((k & 8) >> 1); return ((kk >> 3) * 4 + (c >> 5)) * 512 + ((kk & 7) * 32 + (c & 31)) * 2; }
__device__ __forceinline__ int v_rd_base(int lane) { return ((lane & 3) << 3) | (((lane >> 2) & 3) << 6) | (((lane >> 4) & 1) << 5) | (((lane >> 5) & 1) << 8); }
constexpr int v_rd_off(int d0, int ks, int half) { return d0 * 512 + ks * 4096 + half * 2048; }
template <int OFF> __device__ __forceinline__ s16x4 tr_read(int vb) {
    s16x4 r; asm volatile("ds_read_b64_tr_b16 %0, %1 offset:%2" : "=&v"(r) : "v"(vb), "i"(OFF) : "memory"); return r;
}
template <int D0> __device__ __forceinline__ void pv_one(f32x16& od, int vb, bf16x8 pa0, bf16x8 pa1, bf16x8 pa2, bf16x8 pa3) {
    const s16x4 l0 = tr_read<v_rd_off(D0, 0, 0)>(vb), h0 = tr_read<v_rd_off(D0, 0, 1)>(vb), l1 = tr_read<v_rd_off(D0, 1, 0)>(vb), h1 = tr_read<v_rd_off(D0, 1, 1)>(vb);
    const s16x4 l2 = tr_read<v_rd_off(D0, 2, 0)>(vb), h2 = tr_read<v_rd_off(D0, 2, 1)>(vb), l3 = tr_read<v_rd_off(D0, 3, 0)>(vb), h3 = tr_read<v_rd_off(D0, 3, 1)>(vb);
    asm volatile("s_waitcnt lgkmcnt(0)" ::: "memory"); SBAR();
#define PK(L, H) (bf16x8){L[0], L[1], L[2], L[3], H[0], H[1], H[2], H[3]}
    od = __builtin_amdgcn_mfma_f32_32x32x16_bf16(pa0, PK(l0, h0), od, 0, 0, 0);
    od = __builtin_amdgcn_mfma_f32_32x32x16_bf16(pa1, PK(l1, h1), od, 0, 0, 0);
    od = __builtin_amdgcn_mfma_f32_32x32x16_bf16(pa2, PK(l2, h2), od, 0, 0, 0);
    od = __builtin_amdgcn_mfma_f32_32x32x16_bf16(pa3, PK(l3, h3), od, 0, 0, 0);
#undef PK
}
__device__ __forceinline__ void pv_d0(f32x16* o, int vb, bf16x8 pa0, bf16x8 pa1, bf16x8 pa2, bf16x8 pa3) {
    pv_one<0>(o[0], vb, pa0, pa1, pa2, pa3); pv_one<1>(o[1], vb, pa0, pa1, pa2, pa3); pv_one<2>(o[2], vb, pa0, pa1, pa2, pa3); pv_one<3>(o[3], vb, pa0, pa1, pa2, pa3);
}
__device__ __forceinline__ void qkt(f32x16& p0, f32x16& p1, const LAS unsigned char* Ks, const LAS unsigned char* Qs, int r32, int hi) {
    p0 = f32x16{}; p1 = f32x16{};
    bf16x8 b0[2], b1[2], q[2];
    { const int cb = (hi * 8) * 2; b0[0] = *(const LAS bf16x8*)(Ks + KSWZ(r32, cb)); b1[0] = *(const LAS bf16x8*)(Ks + KSWZ(32 + r32, cb)); q[0] = *(const LAS bf16x8*)(Qs + KSWZ(r32, cb)); }
#pragma unroll
    for (int d0 = 0; d0 < 8; ++d0) { const int c = d0 & 1, n = c ^ 1;
        if (d0 < 7) { const int cb = ((d0 + 1) * 16 + hi * 8) * 2;
            b0[n] = *(const LAS bf16x8*)(Ks + KSWZ(r32, cb)); b1[n] = *(const LAS bf16x8*)(Ks + KSWZ(32 + r32, cb)); q[n] = *(const LAS bf16x8*)(Qs + KSWZ(r32, cb)); }
        if (d0 < 7) asm volatile("s_waitcnt lgkmcnt(3)" ::: "memory"); else asm volatile("s_waitcnt lgkmcnt(0)" ::: "memory");
        SBAR();
        p0 = __builtin_amdgcn_mfma_f32_32x32x16_bf16(b0[c], q[c], p0, 0, 0, 0);
        p1 = __builtin_amdgcn_mfma_f32_32x32x16_bf16(b1[c], q[c], p1, 0, 0, 0);
        SBAR(); }
}
__device__ __forceinline__ void qkt_half(f32x16& p, const LAS unsigned char* Ks, const LAS unsigned char* Qs, int r32, int hi, int half) {
    p = f32x16{};
    bf16x8 b0[2], q[2];
    { const int cb = (hi * 8) * 2; b0[0] = *(const LAS bf16x8*)(Ks + KSWZ(32 * half + r32, cb)); q[0] = *(const LAS bf16x8*)(Qs + KSWZ(r32, cb)); }
#pragma unroll
    for (int d0 = 0; d0 < 8; ++d0) { const int c = d0 & 1, n = c ^ 1;
        if (d0 < 7) { const int cb = ((d0 + 1) * 16 + hi * 8) * 2; b0[n] = *(const LAS bf16x8*)(Ks + KSWZ(32 * half + r32, cb)); q[n] = *(const LAS bf16x8*)(Qs + KSWZ(r32, cb)); }
        if (d0 < 7) asm volatile("s_waitcnt lgkmcnt(2)" ::: "memory"); else asm volatile("s_waitcnt lgkmcnt(0)" ::: "memory");
        SBAR();
        p = __builtin_amdgcn_mfma_f32_32x32x16_bf16(b0[c], q[c], p, 0, 0, 0);
        SBAR(); }
}
#define PK4(P, BASE, OUT) do { unsigned a0 = pk2(P[BASE + 0], P[BASE + 1]), a1 = pk2(P[BASE + 2], P[BASE + 3]);   \
    unsigned b0 = pk2(P[BASE + 4], P[BASE + 5]), b1 = pk2(P[BASE + 6], P[BASE + 7]);                              \
    auto r0 = __builtin_amdgcn_permlane32_swap(a0, b0, false, false); auto r1 = __builtin_amdgcn_permlane32_swap(a1, b1, false, false); \
    u32x4 w = {r0[0], r1[0], r0[1], r1[1]}; OUT = __builtin_bit_cast(bf16x8, w); } while (0)
__device__ __forceinline__ float swap_max(float v) { auto rr = __builtin_amdgcn_permlane32_swap(__float_as_uint(v), __float_as_uint(v), false, false); return fmaxf(__uint_as_float(rr[0]), __uint_as_float(rr[1])); }
__device__ __forceinline__ float swap_add(float v) { auto rr = __builtin_amdgcn_permlane32_swap(__float_as_uint(v), __float_as_uint(v), false, false); return __uint_as_float(rr[0]) + __uint_as_float(rr[1]); }

struct Desc {
    const bf16_t* Q;
    const bf16_t* K; const bf16_t* V;
    const bf16_t* SZ; bf16_t* Y;
    const float* bias;
    int qpos0, nvalid, nkeys;
};
template <int TYPE>
__device__ __forceinline__ void unit(LAS unsigned char* lds, const Desc& d) {
    int tid = threadIdx.x; asm volatile("" : "+v"(tid));
    const int wid = __builtin_amdgcn_readfirstlane(tid >> 6), lane = tid & 63, r32 = lane & 31, hi = lane >> 5;
    LAS float* wsf = (LAS float*)(lds + L_WS) + wid * 64;
    LAS float* biasL = (LAS float*)(lds + L_BIAS);
    volatile LAS unsigned* flags = (volatile LAS unsigned*)(lds + L_FLAG);
    const bool wvalid = (32 * wid < d.nvalid);
    const int qpos = d.qpos0 + 32 * wid + r32;
    const int cw = (d.qpos0 + 32 * wid) >> 6;
    const bool rowinvalid = (32 * wid + r32) >= d.nvalid;
    int t_lo, t_hi;
    if (TYPE == 0) { const int c0 = d.qpos0 >> 6; t_lo = c0 - 8 > 0 ? c0 - 8 : 0; t_hi = c0 + 3; const int tk = (d.nkeys - 1) >> 6; if (t_hi > tk) t_hi = tk; }
    else { t_lo = 0; t_hi = (d.qpos0 + 255) >> 6; const int tk = (d.nkeys - 1) >> 6; if (t_hi > tk) t_hi = tk; }
    __syncthreads();
    if (TYPE == 0) { for (int i = tid; i < 257; i += 512) biasL[i] = d.bias[i] * LOG2E; }
    if (TYPE == 1) { if (tid < 16) flags[tid] = (32 * (tid & 7) < d.nvalid) ? 0u : 1u; }
    LAS unsigned char* Ql = lds + L_OST + wid * 8192;
    if (wvalid) {
#pragma unroll
        for (int d0 = 0; d0 < 8; ++d0) { const bf16x8 qv = __builtin_nontemporal_load((const bf16x8*)(d.Q + (size_t)(32 * wid + r32) * 1024 + d0 * 16 + hi * 8)); *(LAS bf16x8*)(Ql + KSWZ(r32, (d0 * 16 + hi * 8) * 2)) = qv; }
    }
    const int sr = tid >> 4, sc = (tid & 15) * 8, vst0 = v_st(sr, sc), vst1 = v_st(32 + sr, sc), kst0 = KSWZ(sr, sc * 2), kst1 = KSWZ(32 + sr, sc * 2);
    const int vbase = (int)(unsigned)(uintptr_t)(lds + L_V) + v_rd_base(lane);
    bf16x8 sv0, sv1, sk0, sk1;
#define SLOAD(T_) do { const size_t k0_ = (size_t)(T_) * 64; sv0 = *(const bf16x8*)(d.V + (k0_ + sr) * 1024 + sc); sv1 = *(const bf16x8*)(d.V + (k0_ + 32 + sr) * 1024 + sc); \
        sk0 = *(const bf16x8*)(d.K + (k0_ + sr) * 1024 + sc); sk1 = *(const bf16x8*)(d.K + (k0_ + 32 + sr) * 1024 + sc); } while (0)
    f32x16 o[4]; o[0] = f32x16{}; o[1] = f32x16{}; o[2] = f32x16{}; o[3] = f32x16{};
    float m_reg = -1e30f, l_reg = 0.f, R = 0.f; bool wdone = !wvalid;
    bf16x8 T00, T01;
    if (TYPE == 1) {
#pragma unroll
        for (int e = 0; e < 8; ++e) { const int j0 = 8 * hi + e; T00[e] = (j0 > r32) ? (short)0x3F80 : (short)0; T01[e] = (16 + j0 > r32) ? (short)0x3F80 : (short)0; }
    }
    const int step = (TYPE == 0) ? 1 : -1, nT = t_hi - t_lo + 1;
    int T = (TYPE == 0) ? t_lo : t_hi;
#define SWRITE(B_) do { LAS unsigned char* vb_ = lds + (B_) * L_BUF + L_V; LAS unsigned char* kb_ = lds + (B_) * L_BUF + L_K; \
        *(LAS bf16x8*)(vb_ + vst0) = sv0; *(LAS bf16x8*)(vb_ + vst1) = sv1; *(LAS bf16x8*)(kb_ + kst0) = sk0; *(LAS bf16x8*)(kb_ + kst1) = sk1; } while (0)
    SLOAD(T); SWRITE(0);
    if (nT > 1) SLOAD(T + step);
    __syncthreads();
    if (wid < 4) __builtin_amdgcn_s_setprio(1);
    for (int it = 0; it < nT; ++it, T += step) {
        const int cur = it & 1;
        if (TYPE == 1) { volatile LAS unsigned* fl = flags + 8 * (cur ^ 1); const unsigned f = fl[0] & fl[1] & fl[2] & fl[3] & fl[4] & fl[5] & fl[6] & fl[7]; if (f) break; }
        if (it + 1 < nT) SWRITE(cur ^ 1);
        if (it + 2 < nT) SLOAD(T + 2 * step);
        const LAS unsigned char* Kl = lds + cur * L_BUF + L_K; const int vb0 = vbase + cur * L_BUF;
        if (TYPE == 0) {
            if (wvalid && T >= cw - 8 && T <= cw) {
                f32x16 p0, p1; qkt(p0, p1, Kl, Ql, r32, hi);
                const int dc = cw - T;
                if (dc >= 3) { const float bf = biasL[256];
#pragma unroll
                    for (int r = 0; r < 16; ++r) { p0[r] += bf; p1[r] += bf; } }
                else { const int relb = qpos - 64 * T + 128;
#pragma unroll
                    for (int r = 0; r < 16; ++r) { int i0 = relb - crow(r, hi); int i1 = i0 - 32; i0 = i0 < 0 ? 0 : (i0 > 256 ? 256 : i0); i1 = i1 < 0 ? 0 : (i1 > 256 ? 256 : i1); p0[r] += biasL[i0]; p1[r] += biasL[i1]; } }
                const bool needmask = (64 * T + 63 >= d.nkeys);
                if (needmask) {
#pragma unroll
                    for (int r = 0; r < 16; ++r) { const int kp = 64 * T + crow(r, hi); if (kp >= d.nkeys) p0[r] = -1e30f; if (kp + 32 >= d.nkeys) p1[r] = -1e30f; } }
                float pmax = p0[0];
#pragma unroll
                for (int r = 1; r < 16; ++r) pmax = fmaxf(pmax, p0[r]);
#pragma unroll
                for (int r = 0; r < 16; ++r) pmax = fmaxf(pmax, p1[r]);
                pmax = swap_max(pmax);
                float alpha = 1.f; const bool grow = __any(pmax > m_reg + 8.0f);
                if (grow) { const float mx = fmaxf(m_reg, pmax); alpha = ex2(m_reg - mx); m_reg = mx; }
                const float mn = m_reg;
#pragma unroll
                for (int r = 0; r < 16; ++r) { p0[r] = ex2(p0[r] - mn); p1[r] = ex2(p1[r] - mn); }
                if (needmask) {
#pragma unroll
                    for (int r = 0; r < 16; ++r) { const int kp = 64 * T + crow(r, hi); if (kp >= d.nkeys) p0[r] = 0.f; if (kp + 32 >= d.nkeys) p1[r] = 0.f; } }
                float ps = 0.f;
#pragma unroll
                for (int r = 0; r < 16; ++r) ps += p0[r] + p1[r];
                ps = swap_add(ps);
                l_reg = l_reg * alpha + ps;
                if (grow && __any(alpha < 1.f)) { if (hi == 0) wsf[r32] = alpha; LDS_WAIT();
#pragma unroll
                    for (int dd = 0; dd < 4; ++dd)
#pragma unroll
                        for (int r = 0; r < 16; ++r) o[dd][r] *= wsf[crow(r, hi)]; }
                bf16x8 pa0, pa1, pa2, pa3; PK4(p0, 0, pa0); PK4(p0, 8, pa1); PK4(p1, 0, pa2); PK4(p1, 8, pa3);
                pv_d0(o, vb0, pa0, pa1, pa2, pa3);
            }
        } else {
            if (!wdone && T <= cw) {
                const bool diag = (T == cw);
                bf16x8 pa0, pa1, pa2, pa3; float ts1, ts0;
                {
                    f32x16 z, lf; qkt_half(z, Kl, Ql, r32, hi, 1); float ts = 0.f;
#pragma unroll
                    for (int r = 0; r < 16; ++r) { const float zz = z[r], e = ex2(-fabsf(zz)), l1p = __builtin_amdgcn_logf(1.0f + e); float lb = fminf(zz, 0.f) - l1p, lfv = -fmaxf(zz, 0.f) - l1p;
                        if (diag) { const bool c = (64 * T + 32 + crow(r, hi)) < qpos; lfv = c ? lfv : 0.f; lb = c ? lb : -1e30f; }
                        z[r] = lb; lf[r] = lfv; ts += lfv; }
                    ts1 = swap_add(ts);
                    bf16x8 la2, la3; PK4(lf, 0, la2); PK4(lf, 8, la3);
                    f32x16 L = f32x16{};
                    L = __builtin_amdgcn_mfma_f32_32x32x16_bf16(T00, la2, L, 0, 0, 0); L = __builtin_amdgcn_mfma_f32_32x32x16_bf16(T01, la3, L, 0, 0, 0);
#pragma unroll
                    for (int r = 0; r < 16; ++r) z[r] = ex2(z[r] + L[r] + R);
                    PK4(z, 0, pa2); PK4(z, 8, pa3);
                }
                {
                    f32x16 z, lf; qkt_half(z, Kl, Ql, r32, hi, 0); float ts = 0.f;
#pragma unroll
                    for (int r = 0; r < 16; ++r) { const float zz = z[r], e = ex2(-fabsf(zz)), l1p = __builtin_amdgcn_logf(1.0f + e); float lb = fminf(zz, 0.f) - l1p, lfv = -fmaxf(zz, 0.f) - l1p;
                        if (diag) { const bool c = (64 * T + crow(r, hi)) < qpos; lfv = c ? lfv : 0.f; lb = c ? lb : -1e30f; }
                        z[r] = lb; lf[r] = lfv; ts += lfv; }
                    ts0 = swap_add(ts);
                    bf16x8 la0, la1; PK4(lf, 0, la0); PK4(lf, 8, la1);
                    f32x16 L = f32x16{};
                    L = __builtin_amdgcn_mfma_f32_32x32x16_bf16(T00, la0, L, 0, 0, 0); L = __builtin_amdgcn_mfma_f32_32x32x16_bf16(T01, la1, L, 0, 0, 0);
                    const float Rr = R + ts1;
#pragma unroll
                    for (int r = 0; r < 16; ++r) z[r] = ex2(z[r] + L[r] + Rr);
                    PK4(z, 0, pa0); PK4(z, 8, pa1);
                }
                pv_d0(o, vb0, pa0, pa1, pa2, pa3);
                const float ts = ts0 + ts1;
                R += ts;
                wdone = __all((R < -160.f) || rowinvalid);
            }
            if (lane == 0) flags[8 * cur + wid] = wdone ? 1u : 0u;
        }
        __syncthreads();
    }
    __builtin_amdgcn_s_setprio(0);
    if (wvalid) {
        LAS bf16_t* stg = (LAS bf16_t*)(lds + L_OST) + wid * 4096;
        if (TYPE == 0) { if (hi == 0) wsf[32 + r32] = l_reg; LDS_WAIT(); }
#pragma unroll
        for (int r = 0; r < 16; ++r) { const int rw = crow(r, hi); const float rl = (TYPE == 0) ? __builtin_amdgcn_rcpf(wsf[32 + rw]) : 1.f;
#pragma unroll
            for (int dd = 0; dd < 4; ++dd) stg[rw * 128 + dd * 32 + r32] = f2bf(o[dd][r] * rl); }
        LDS_WAIT();
#pragma unroll 2
        for (int i = 0; i < 8; ++i) { const int rw = i * 4 + (lane >> 4), ch = lane & 15, row = 32 * wid + rw;
            if (row < d.nvalid) { const size_t off = (size_t)row * 3072 + ch * 8;
                const u32x4 ov = *(const LAS u32x4*)(stg + rw * 128 + ch * 8), gv = __builtin_nontemporal_load((const u32x4*)(d.SZ + off));
                u32x4 w; w.x = pk2(bflo(ov.x) * bflo(gv.x), bfhi(ov.x) * bfhi(gv.x)); w.y = pk2(bflo(ov.y) * bflo(gv.y), bfhi(ov.y) * bfhi(gv.y));
                w.z = pk2(bflo(ov.z) * bflo(gv.z), bfhi(ov.z) * bfhi(gv.z)); w.w = pk2(bflo(ov.w) * bflo(gv.w), bfhi(ov.w) * bfhi(gv.w));
                *(u32x4*)(d.Y + off) = w; } }
    }
#undef SLOAD
#undef SWRITE
}
}

#if defined(DBG_ONLY0)
#define ATT_DISPATCH(type, lds, d) att::unit<0>(lds, d)
#elif defined(DBG_ONLY1)
#define ATT_DISPATCH(type, lds, d) att::unit<1>(lds, d)
#elif defined(DBG_NOATT)
#define ATT_DISPATCH(type, lds, d) (void)d
#else
#define ATT_DISPATCH(type, lds, d) do { if (type) att::unit<1>(lds, d); else att::unit<0>(lds, d); } while (0)
#endif
struct Args { const float* in[28]; float* out; unsigned char* ws; int ph_lo, ph_hi; };
constexpr int I_IN = (DM / 64) * (NIN / 64), I_GLU = 16 * 16, I_BR = (MW / 64) * (DM / 64), I_OUT = 64 * 64, I_L = I_IN + I_GLU + 3 * I_BR + I_OUT;
__device__ __forceinline__ void weight_item(const float* w_in, const float* w_glu, const float* w_br0, const float* w_br1, const float* w_br2, const float* w_out, unsigned char* ws, int l, int r, LAS float* scr, int lane) {
    if (r < I_IN) { transpose_item(w_in + (size_t)l * DM * NIN, DM, NIN, (bf16_t*)(ws + WS_WIN) + (size_t)l * NIN * DM, scr, r, lane); return; } r -= I_IN;
    if (r < I_GLU) { transpose_item(w_glu + (size_t)l * MW * MW, MW, MW, (bf16_t*)(ws + WS_WGLU) + (size_t)l * MW * MW, scr, r, lane); return; } r -= I_GLU;
    if (r < 3 * I_BR) { const int br = r / I_BR; r -= br * I_BR;
        transpose_item((br == 0 ? w_br0 : br == 1 ? w_br1 : w_br2) + (size_t)l * MW * DM, MW, DM, (bf16_t*)(ws + WS_WBR) + (size_t)(l * 3 + br) * DM * MW, scr, r, lane); return; } r -= 3 * I_BR;
    transpose_item(w_out + (size_t)l * DM * DM, DM, DM, (bf16_t*)(ws + WS_WOUT) + (size_t)l * DM * DM, scr, r, lane);
}
__device__ __forceinline__ void convert_caches(const float* sbk, const float* sbv, const float* bdk, const float* bdv, const WsPtrs W, int l, int wg, int nwg, int gsz) {
    int t_ = threadIdx.x; asm volatile("" : "+v"(t_));
    const size_t gt = (size_t)wg * gsz + (t_ & (gsz - 1)), NT = (size_t)nwg * gsz;
    const size_t n_sb = 8ull * PASTL * 128, n_bd = 8ull * BANDK * 128;
    for (size_t i = gt; i < 2 * n_sb + 2 * n_bd; i += NT) {
        const float* src; bf16_t* dst; size_t j = i;
        if (j < 2 * n_sb) { const int kv = j >= n_sb; j -= kv * n_sb; const size_t lb = (size_t)l * NB + j / ((size_t)PASTL * 128), rem = j % ((size_t)PASTL * 128), t = rem >> 7, c8 = rem & 127;
            src = (kv ? sbv : sbk) + (lb * PASTL + t) * 1024 + c8 * 8; dst = (kv ? W.VCS() : W.KCS()) + (lb * KCS_ROWS + t) * 1024 + c8 * 8; }
        else { j -= 2 * n_sb; const int kv = j >= n_bd; j -= kv * n_bd; const size_t lb = (size_t)l * NB + j / ((size_t)BANDK * 128), rem = j % ((size_t)BANDK * 128), t = rem >> 7, c8 = rem & 127;
            src = (kv ? bdv : bdk) + (lb * BANDK + t) * 1024 + c8 * 8; dst = (kv ? W.VBS() : W.KBS()) + (lb * KBS_ROWS + t) * 1024 + c8 * 8; }
        const f32x4 a = __builtin_nontemporal_load((const f32x4*)src), b = __builtin_nontemporal_load((const f32x4*)(src + 4));
        st_bf16x8(dst, a, b);
    }
}
constexpr int N_PHASES = 11;

__global__ void __launch_bounds__(NWAVES * 64, 2) hse_fwd(Args args) {
    extern __shared__ __attribute__((aligned(16))) unsigned char lds_raw[];
    LAS unsigned char* lds = (LAS unsigned char*)lds_raw;
    volatile LAS unsigned* MISC = (volatile LAS unsigned*)(lds + MISC_OFF);
    const int tid = threadIdx.x, lane = tid & 63, wave = __builtin_amdgcn_readfirstlane(tid >> 6);
    const int G = gridDim.x; const int bx = blockIdx.x; const int vcu = (G % 8 == 0) ? (bx % 8) * (G / 8) + bx / 8 : bx;
    unsigned char* ws = args.ws; float* out = args.out;
    const CAS Args* const kargs = (const CAS Args*)__builtin_amdgcn_kernarg_segment_ptr();
#define KARGS() const CAS Args* KA = kargs; asm volatile("" : "+s"(KA))
#define PHASE_BEGIN() KARGS(); unsigned char* ws_o_ = ws; float* out_o_ = out; asm volatile("" : "+s"(ws_o_), "+s"(out_o_)); unsigned char* const ws = asg(ws_o_); float* const out = asg(out_o_); WsPtrs W; W.ws = ws; (void)out; (void)KA; \
    int G_o_ = G, bx_o_ = bx, vcu_o_ = vcu; asm volatile("" : "+s"(G_o_), "+s"(bx_o_), "+s"(vcu_o_)); const int G = G_o_, bx = bx_o_, vcu = vcu_o_; (void)G; (void)bx; (void)vcu
    unsigned* ctl = (unsigned*)(ws + WS_CTL);
    WsPtrs W; W.ws = ws;
    for (int u = tid; u < (LDS_BYTES - LDSCTL_OFF) / 4; u += NWAVES * 64) ((LAS unsigned*)(lds + LDSCTL_OFF))[u] = 0u;
    __syncthreads();
    XcdBarrier bar; bar.bar = ctl + CW_BAR; bar.x = 0; bar.st = nullptr;
    if (!MK_SPLIT) bar = xcd_barrier_post(ctl + CW_BAR, MISC + 8);
    const int lo = args.ph_lo, hi_ph = args.ph_hi;
#define IN(k) (lo <= (k) && (k) < hi_ph)
#define SEAM(k) do { if (!MK_SPLIT && (k) + 1 < hi_ph) xcd_barrier(bar); } while (0)
    const int gw = vcu * NWAVES + wave, NGW = G * NWAVES;

#ifndef NO_P0
    if (IN(0)) {
        PHASE_BEGIN();
        for (int lg = NGW - 1 - gw; lg < 2 * NG; lg += NGW) {
            const int l = lg / NG, g = lg - l * NG, n = lane;
            const float dt = expf(KA->in[12][lg]);
            const float are = KA->in[10][(size_t)lg * NST + n], aim = KA->in[11][(size_t)lg * NST + n];
            const float mag = expf(are * dt), abr = mag * cosf(aim * dt), abi = mag * sinf(aim * dt);
            const float den = are * are + aim * aim, nr = abr - 1.0f;
            const float kre = (nr * are + abi * aim) / den, kim = (abi * are - nr * aim) / den;
            *((f32x2*)(ws + WS_ABAR) + (size_t)lg * NST + n) = (f32x2){abr, abi};
            bf16_t* BMT = (bf16_t*)(ws + WS_BMT) + (size_t)lg * 128 * 16; bf16_t* CMT = (bf16_t*)(ws + WS_CMT) + (size_t)lg * 16 * 128;
            const float* bre = KA->in[13] + ((size_t)lg * NST + n) * 16; const float* bim = KA->in[14] + ((size_t)lg * NST + n) * 16;
#pragma unroll
            for (int p = 0; p < 16; ++p) { const float br_ = bre[p], bi_ = bim[p];
                BMT[(size_t)n * 16 + p] = f2bf(kre * br_ - kim * bi_); BMT[(size_t)(64 + n) * 16 + p] = f2bf(kre * bi_ + kim * br_);
                CMT[(size_t)p * 128 + n] = f2bf(KA->in[15][((size_t)lg * 16 + p) * NST + n]); CMT[(size_t)p * 128 + 64 + n] = f2bf(-KA->in[16][((size_t)lg * 16 + p) * NST + n]); }
        }
        LAS float* scr = (LAS float*)(lds + wave * 16640);
        for (int rep_ = 0; rep_ < ((DBG_DUP & 1) ? 2 : 1); ++rep_)
        for (int it = gw; it < I_L; it += NGW) weight_item(KA->in[9], KA->in[18], KA->in[23], KA->in[24], KA->in[25], KA->in[27], ws, 0, it, scr, lane);
        for (int m = gw; m < MR; m += NGW) {
            const float* xr = (m < MP) ? KA->in[0] + (size_t)m * DM : KA->in[1] + (size_t)(m - MP) * DM;
            xrow_to_a0(xr, KA->in[8], W.A0() + (size_t)m * DM, W.SSQ0() + m, lane);
        }
        convert_caches(KA->in[2], KA->in[3], KA->in[4], KA->in[5], W, 0, vcu, G, 512);
        for (int i = gw; i < 16 * 96 * 2; i += NGW) { const int kv = i & 1, j = i >> 1, lb = j / 96, rr = j - lb * 96;
            bf16_t* p = (rr < 48) ? (kv ? W.VCS() : W.KCS()) + ((size_t)lb * KCS_ROWS + PASTL + DSEQ + rr) * 1024 : (kv ? W.VBS() : W.KBS()) + ((size_t)lb * KBS_ROWS + BANDK + DSEQ + (rr - 48)) * 1024;
            *((u32x4*)p + lane) = (u32x4){0u, 0u, 0u, 0u}; *((u32x4*)p + 64 + lane) = (u32x4){0u, 0u, 0u, 0u}; }
        SEAM(0);
    }
#endif

    for (int l = 0; l < 2; ++l) {
        const int pb = 1 + 5 * l;
#ifndef NO_P1
        if (IN(pb)) {
            PHASE_BEGIN();
            pg8::Gemm g{DM, DM, DM};
            pg8::TileOrder<1> S; S.nM = MP / 256; S.nN = NIN / 256; S.nwg = S.nM * S.nN; S.G = G; S.c = bx;
            S.A = (const char*)W.A0(); S.B = (const char*)(ws + WS_WIN) + (size_t)l * NIN * DM * 2; S.atile = 256ull * DM * 2; S.btile = 256ull * DM * 2; S.arep = 0; S.brep = 0;
            pg8::QuarterOrder<1> SQ; SQ.pmq = MP / 256; SQ.nN = S.nN; SQ.G = G; SQ.c = bx; SQ.A = S.A; SQ.B = S.B; SQ.atile = S.atile; SQ.btile = S.btile; SQ.arep = 0; SQ.brep = 0; SQ.bhalf = 128ull * DM * 2;
            Epi1 E{l == 0 ? W.SSQ0() : W.SSQ1(), KA->in[26] + (size_t)l * 3 * DM, out, W, l};
            long long ck0 = 0, rt0 = 0; if (DBG_CLK == 1 && l == 0 && bx == 0) { ck0 = clock64(); rt0 = wall_clock64(); }
            pg8::gemm_phase<false>(lds, g, S, E);
            pg8::gemm_quarter(lds, g, SQ, E);
            if (DBG_CLK == 1 && l == 0 && bx == 0 && tid == 0) { const long long dc = clock64() - ck0, dr = wall_clock64() - rt0; ((long long*)(ws + WS_CTL + 32768))[0] = dc; ((long long*)(ws + WS_CTL + 32768))[1] = dr; }
            if (DBG_DUP & 2) { pg8::gemm_phase<false>(lds, g, S, E); pg8::gemm_quarter(lds, g, SQ, E); }
            if (DBG_DUP & 0xF00) { EpiNull EN{(float*)(ws + WS_CTL + 49152)}; S.fixed = (DBG_DUP >> 9) & 3; pg8::gemm_phase<false>(lds, g, S, EN); }
            if (DBG_CLK == 2 && l == 0 && tid == 0) { const unsigned long long t_ = (unsigned long long)wall_clock64(); atomicMax((unsigned long long*)(ws + WS_CTL + 40960), t_); atomicMax((unsigned long long*)(ws + WS_CTL + 40960) + 8, ~t_); }
            SEAM(pb);
            if (DBG_CLK == 2 && l == 0 && bx == 0 && tid == 0) { const unsigned long long mx = *((unsigned long long*)(ws + WS_CTL + 40960)), mn = ~*((unsigned long long*)(ws + WS_CTL + 40960) + 8);
                ((long long*)(ws + WS_CTL + 32768))[0] = (long long)(mx - mn) * 10; ((long long*)(ws + WS_CTL + 32768))[1] = 1; }
        }
#endif
#ifndef NO_P2A
        if (IN(pb + 1)) {
            PHASE_BEGIN();
            constexpr int NSW = 2, NHWV = NWAVES - NSW;
            if (wave < NSW) {
                LAS float* S = (LAS float*)(lds + wave * SSM_WAVE_BYTES);
                __builtin_amdgcn_s_setprio(2);
                for (int st = vcu * NSW + wave; st < 1024; st += G * NSW) {
                    const int sample = st >= 512, ii = st & 511, b = ii >> 6, g = ii & 63;
                    if (!sample) ssm_unit<32>(S, ws, KA->in[17] + (size_t)l * MW, l, g, W.U(), W.YG(), b * SEQ, SEQ, nullptr, nullptr,
                                          out + O_PSR + ((size_t)(l * NB + b) * NG + g) * NST, out + O_PSI + ((size_t)(l * NB + b) * NG + g) * NST, lane);
                    else ssm_unit<16>(S, ws, KA->in[17] + (size_t)l * MW, l, g, W.U(), W.YG(), MP + b * DSEQ, DSEQ,
                                  KA->in[6] + ((size_t)(l * NB + b) * NG + g) * NST, KA->in[7] + ((size_t)(l * NB + b) * NG + g) * NST,
                                  out + O_SSR + ((size_t)(l * NB + b) * NG + g) * NST, out + O_SSI + ((size_t)(l * NB + b) * NG + g) * NST, lane);
                }
                __builtin_amdgcn_s_setprio(0);
            } else
            { const int hw = vcu * NHWV + (wave - NSW), NHW = G * NHWV;
              {
                const float* qg = KA->in[20] + (size_t)l * HD; const float* kg = KA->in[21] + (size_t)l * HD;
                int lane_o = lane; asm volatile("" : "+v"(lane_o));
                const int c0 = 16 * lane_o, dd = c0 & 127;
                float gq[16], gk[16];
#pragma unroll
                for (int j = 0; j < 16; ++j) { gq[j] = qg[dd + j] * (0.08838834764831845f * LOG2E); gk[j] = kg[dd + j]; }
                for (int row = hw; row < MR; row += NHW) {
                    { bf16_t* qp = W.QB() + (size_t)row * 1024 + c0; const u32x4 a = __builtin_nontemporal_load((const u32x4*)qp), b2 = __builtin_nontemporal_load((const u32x4*)(qp + 8));
                      float v[16] = {bflo(a.x), bfhi(a.x), bflo(a.y), bfhi(a.y), bflo(a.z), bfhi(a.z), bflo(a.w), bfhi(a.w), bflo(b2.x), bfhi(b2.x), bflo(b2.y), bfhi(b2.y), bflo(b2.z), bfhi(b2.z), bflo(b2.w), bfhi(b2.w)};
                      float s = 0.f;
#pragma unroll
                      for (int j = 0; j < 16; ++j) s += v[j] * v[j];
                      s += __shfl_xor(s, 1); s += __shfl_xor(s, 2); s += __shfl_xor(s, 4);
                      const float r = __builtin_amdgcn_rsqf(s * (1.0f / 128.0f) + 1e-6f);
#pragma unroll
                      for (int j = 0; j < 16; ++j) v[j] = v[j] * r * gq[j];
                      st_bf16x8(qp, (f32x4){v[0], v[1], v[2], v[3]}, (f32x4){v[4], v[5], v[6], v[7]}); st_bf16x8(qp + 8, (f32x4){v[8], v[9], v[10], v[11]}, (f32x4){v[12], v[13], v[14], v[15]}); }
                    { const bf16_t* kp = W.KB() + (size_t)row * 1024 + c0; const u32x4 a = __builtin_nontemporal_load((const u32x4*)kp), b2 = __builtin_nontemporal_load((const u32x4*)(kp + 8));
                      float v[16] = {bflo(a.x), bfhi(a.x), bflo(a.y), bfhi(a.y), bflo(a.z), bfhi(a.z), bflo(a.w), bfhi(a.w), bflo(b2.x), bfhi(b2.x), bflo(b2.y), bfhi(b2.y), bflo(b2.z), bfhi(b2.z), bflo(b2.w), bfhi(b2.w)};
                      float s = 0.f;
#pragma unroll
                      for (int j = 0; j < 16; ++j) s += v[j] * v[j];
                      s += __shfl_xor(s, 1); s += __shfl_xor(s, 2); s += __shfl_xor(s, 4);
                      const float r = __builtin_amdgcn_rsqf(s * (1.0f / 128.0f) + 1e-6f);
#pragma unroll
                      for (int j = 0; j < 16; ++j) v[j] = v[j] * r * gk[j];
                      bf16_t* d16; float* d32 = nullptr;
                      if (row < MP) { const int b = row >> 11, t = row & 2047; d16 = W.KB() + (size_t)row * 1024 + c0;
                          if (t >= SEQ - BANDK) d32 = out + O_PBK + ((size_t)(l * NB + b) * BANDK + (t - (SEQ - BANDK))) * 1024 + c0; }
                      else { const int sr = row - MP, b = sr >> 4, t = sr & 15; d16 = W.KBS() + ((size_t)(l * NB + b) * KBS_ROWS + BANDK + t) * 1024 + c0; d32 = out + O_SBK + ((size_t)l * MS + sr) * 1024 + c0; }
                      st_bf16x8(d16, (f32x4){v[0], v[1], v[2], v[3]}, (f32x4){v[4], v[5], v[6], v[7]}); st_bf16x8(d16 + 8, (f32x4){v[8], v[9], v[10], v[11]}, (f32x4){v[12], v[13], v[14], v[15]});
                      if (d32) { *(f32x4*)d32 = (f32x4){v[0], v[1], v[2], v[3]}; *(f32x4*)(d32 + 4) = (f32x4){v[4], v[5], v[6], v[7]}; *(f32x4*)(d32 + 8) = (f32x4){v[8], v[9], v[10], v[11]}; *(f32x4*)(d32 + 12) = (f32x4){v[12], v[13], v[14], v[15]}; } }
                }
                if (l == 0) { LAS float* scr = (LAS float*)(lds + NSW * SSM_WAVE_BYTES + (wave - NSW) * 16640);
                    for (int it = hw; it < I_IN; it += NHW) weight_item(KA->in[9], KA->in[18], KA->in[23], KA->in[24], KA->in[25], KA->in[27], ws, 1, it, scr, lane); }
                else { convert_caches(KA->in[2], KA->in[3], KA->in[4], KA->in[5], W, 1, hw, NHW, 64);
                    LAS float* scr = (LAS float*)(lds + NSW * SSM_WAVE_BYTES + (wave - NSW) * 16640);
                    for (int it = I_IN + hw; it < I_L; it += NHW) weight_item(KA->in[9], KA->in[18], KA->in[23], KA->in[24], KA->in[25], KA->in[27], ws, 1, it, scr, lane); }
              } }
            SEAM(pb + 1);
        }
#endif
#ifndef NO_P2B
        if (IN(pb + 2)) {
            PHASE_BEGIN();
            for (int rep_ = 0; rep_ < ((DBG_DUP & 8) ? 2 : 1); ++rep_) {
            const int nit = (G == 256) ? (((vcu & 7) <= 1 || (vcu & 7) >= 6) ? 5 : 4) : (1152 + G - 1 - vcu) / G;
            for (int k = 0; k < nit; ++k) {
                int item;
                if (G == 256) { const int q = vcu & 7, bq = vcu >> 3;
                    if (k < 4) { const int second = k & 1, ty = k >> 1; item = ty * 512 + (second ? ((32 + bq) << 3) + (7 - q) : (bq << 3) + q); }
                    else item = 1024 + ((q == 0 || q == 7) ? 0 : 64) + ((q == 0 || q == 1) ? 0 : 32) + bq; }
                else item = vcu + k * G;
                att::Desc d;
                if (item < 1024) {
                    const int type = item < 512 ? 1 : 0, ii = item & 511, bh = ii >> 3, qb = ii & 7, b = bh >> 3, h = bh & 7;
                    const size_t row0 = (size_t)b * SEQ + 256 * qb;
                    d.Q = (type ? W.QC() : W.QB()) + row0 * 1024 + h * HD; d.K = (type ? W.KC() : W.KB()) + (size_t)b * SEQ * 1024 + h * HD; d.V = (type ? W.VC() : W.VB()) + (size_t)b * SEQ * 1024 + h * HD;
                    d.SZ = W.SZ() + row0 * 3072 + (type ? 2048 : 1024) + h * HD; d.Y = W.Y() + row0 * 3072 + (type ? 2048 : 1024) + h * HD;
                    d.bias = KA->in[22] + ((size_t)l * NH + h) * 257; d.qpos0 = 256 * qb; d.nvalid = 256; d.nkeys = SEQ;
                    ATT_DISPATCH(type, lds, d);
                    if ((DBG_DUP & 64) && type == 1) att::unit<1>(lds, d);
                    if ((DBG_DUP & 128) && type == 0) att::unit<0>(lds, d);
                } else {
                    const int type = item < 1088 ? 0 : 1, ii = (item - 1024) & 63, b = ii >> 3, h = ii & 7;
                    const size_t row0 = (size_t)MP + b * DSEQ;
                    d.Q = (type ? W.QC() : W.QB()) + row0 * 1024 + h * HD;
                    d.K = (type ? W.KCS() + (size_t)(l * NB + b) * KCS_ROWS * 1024 : W.KBS() + (size_t)(l * NB + b) * KBS_ROWS * 1024) + h * HD;
                    d.V = (type ? W.VCS() + (size_t)(l * NB + b) * KCS_ROWS * 1024 : W.VBS() + (size_t)(l * NB + b) * KBS_ROWS * 1024) + h * HD;
                    d.SZ = W.SZ() + row0 * 3072 + (type ? 2048 : 1024) + h * HD; d.Y = W.Y() + row0 * 3072 + (type ? 2048 : 1024) + h * HD;
                    d.bias = KA->in[22] + ((size_t)l * NH + h) * 257; d.qpos0 = type ? PASTL : BANDK; d.nvalid = DSEQ; d.nkeys = (type ? PASTL : BANDK) + DSEQ;
                    ATT_DISPATCH(type, lds, d);
                }
            }
#ifndef DBG_NOGLU
            __syncthreads();
            { pg8::Gemm g{MW, MW, MW};
              pg8::TileOrder<1> S; S.nM = MP / 256; S.nN = MW / 256; S.nwg = S.nM * S.nN; S.G = G; S.c = bx;
              S.A = (const char*)W.YG(); S.B = (const char*)(ws + WS_WGLU) + (size_t)l * MW * MW * 2; S.atile = 256ull * MW * 2; S.btile = 256ull * MW * 2; S.arep = 0; S.brep = 0;
              pg8::QuarterOrder<1> SQ; SQ.pmq = MP / 256; SQ.nN = S.nN; SQ.G = G; SQ.c = (vcu + G / 2) % G; SQ.A = S.A; SQ.B = S.B; SQ.atile = S.atile; SQ.btile = S.btile; SQ.arep = 0; SQ.brep = 0; SQ.bhalf = 128ull * MW * 2;
              EpiGlu E{KA->in[19] + (size_t)l * MW, W};
              pg8::gemm_phase<false>(lds, g, S, E);
              pg8::gemm_quarter(lds, g, SQ, E); }
#endif
            }
            SEAM(pb + 2);
        }
#endif
#ifndef NO_P3
        if (IN(pb + 3)) {
            PHASE_BEGIN();
            pg8::Gemm g{3 * MW, MW, MW};
            pg8::TileOrder<3> S; S.nM = MP / 256; S.nN = DM / 256; S.nwg = S.nM * S.nN; S.G = G; S.c = bx;
            S.A = (const char*)W.Y(); S.B = (const char*)(ws + WS_WBR) + (size_t)l * 3 * DM * MW * 2; S.atile = 256ull * 3 * MW * 2; S.btile = 256ull * MW * 2; S.arep = (size_t)MW * 2; S.brep = (size_t)DM * MW * 2;
            pg8::QuarterOrder<3> SQ; SQ.pmq = MP / 256; SQ.nN = S.nN; SQ.G = G; SQ.c = bx; SQ.A = S.A; SQ.B = S.B; SQ.atile = S.atile; SQ.btile = S.btile; SQ.arep = S.arep; SQ.brep = S.brep; SQ.bhalf = 128ull * MW * 2;
            EpiBr E{W};
            pg8::gemm_phase<false>(lds, g, S, E);
            pg8::gemm_quarter(lds, g, SQ, E);
            if (DBG_DUP & 16) { pg8::gemm_phase<false>(lds, g, S, E); pg8::gemm_quarter(lds, g, SQ, E); }
            if (DBG_DUP & 2048) { EpiNull EN{(float*)(ws + WS_CTL + 49152)}; pg8::gemm_phase<false>(lds, g, S, EN); }
            if (DBG_DUP & 4096) pg8::gemm_phase<false>(lds, g, S, E);
            SEAM(pb + 3);
        }
#endif
#ifndef NO_P4
        if (IN(pb + 4)) {
            PHASE_BEGIN();
            pg8::Gemm g{DM, DM, DM};
            pg8::TileOrder<1> S; S.nM = MP / 256; S.nN = DM / 256; S.nwg = S.nM * S.nN; S.G = G; S.c = bx;
            S.A = (const char*)W.MX(); S.B = (const char*)(ws + WS_WOUT) + (size_t)l * DM * DM * 2; S.atile = 256ull * DM * 2; S.btile = 256ull * DM * 2; S.arep = 0; S.brep = 0;
            pg8::QuarterOrder<1> SQ; SQ.pmq = MP / 256; SQ.nN = S.nN; SQ.G = G; SQ.c = bx; SQ.A = S.A; SQ.B = S.B; SQ.atile = S.atile; SQ.btile = S.btile; SQ.arep = 0; SQ.brep = 0; SQ.bhalf = 128ull * DM * 2;
            EpiOut E{KA->in[0], KA->in[1], KA->in[8] + DM, out, W, l};
            pg8::gemm_phase<false>(lds, g, S, E);
            pg8::gemm_quarter(lds, g, SQ, E);
            if ((DBG_DUP & 32) && l == 1) { pg8::gemm_phase<false>(lds, g, S, E); pg8::gemm_quarter(lds, g, SQ, E); }
            SEAM(pb + 4);
        }
#endif
    }
    if (DBG_CLK && bx == 0 && tid == 0) { const long long dc = ((long long*)(ws + WS_CTL + 32768))[0], dr = ((long long*)(ws + WS_CTL + 32768))[1];
        const long long ticks = (DBG_CLK == 2) ? dc : (dc * 10000) / (dr > 0 ? dr : 1); const long long t0 = wall_clock64(); while (wall_clock64() - t0 < ticks) __builtin_amdgcn_s_sleep(8); }
#undef IN
#undef SEAM
}

extern "C" void kernel_launch(void* const* d_in, const int* in_sizes, int n_in, void* d_out, int out_size, void* d_ws, size_t ws_size, hipStream_t stream) {
    static int grid = 0;
    if (grid == 0) {
        if ((size_t)out_size != O_END) fprintf(stderr, "kernel_launch: note: out_size %d, built for %zu\n", out_size, (size_t)O_END);
        if (n_in != 28 || ws_size < WS_END) { fprintf(stderr, "kernel_launch: shape mismatch n_in %d ws %zu (want %zu)\n", n_in, ws_size, (size_t)WS_END); grid = -1; return; }
        int dev = 0, cus = 0;
        if (hipGetDevice(&dev) != hipSuccess || hipDeviceGetAttribute(&cus, hipDeviceAttributeMultiprocessorCount, dev) != hipSuccess) { grid = -1; return; }
        if (hipFuncSetAttribute((const void*)hse_fwd, hipFuncAttributeMaxDynamicSharedMemorySize, LDS_BYTES) != hipSuccess) { fprintf(stderr, "kernel_launch: hipFuncSetAttribute failed\n"); grid = -1; return; }
        int per_cu = 0;
        if (hipOccupancyMaxActiveBlocksPerMultiprocessor(&per_cu, (const void*)hse_fwd, NWAVES * 64, LDS_BYTES) != hipSuccess || per_cu < 1) fprintf(stderr, "kernel_launch: occupancy query says %d\n", per_cu);
        (void)hipGetLastError();
        grid = cus;
    }
    if (grid < 0) return;
    if (hipMemsetAsync((char*)d_ws + WS_CTL, 0, CTL_ZERO_BYTES, stream) != hipSuccess) return;
    Args a{};
    for (int i = 0; i < 28; ++i) a.in[i] = (const float*)d_in[i];
    a.out = (float*)d_out; a.ws = (unsigned char*)d_ws;
#if MK_SPLIT
    for (int p = 0; p < N_PHASES; ++p) { a.ph_lo = p; a.ph_hi = p + 1; hipLaunchKernelGGL(hse_fwd, dim3(grid), dim3(NWAVES * 64), LDS_BYTES, stream, a); }
#else
    a.ph_lo = 0; a.ph_hi = N_PHASES; hipLaunchKernelGGL(hse_fwd, dim3(grid), dim3(NWAVES * 64), LDS_BYTES, stream, a);
#endif
}
```

```cpp
#include <hip/hip_runtime.h>
#include <cstdio>
#include <cstdint>

#ifndef DBG_DUP
#define DBG_DUP 0
#endif
#ifndef DBG_CLK
#define DBG_CLK 0
#endif
#ifndef MK_SPLIT
#define MK_SPLIT 0
#endif

#define LAS __attribute__((address_space(3)))
#define GAS __attribute__((address_space(1)))
#define CAS __attribute__((address_space(4)))
typedef unsigned short bf16_t;
typedef short bf16x8 __attribute__((ext_vector_type(8)));
typedef short s16x4 __attribute__((ext_vector_type(4)));
typedef float f32x2 __attribute__((ext_vector_type(2)));
typedef float f32x4 __attribute__((ext_vector_type(4)));
typedef float f32x16 __attribute__((ext_vector_type(16)));
typedef unsigned u32x2 __attribute__((ext_vector_type(2)));
typedef unsigned u32x4 __attribute__((ext_vector_type(4)));
typedef __bf16 bf16x2_t __attribute__((ext_vector_type(2)));

constexpr int DM = 4096, SEQ = 2048, NB = 8, DSEQ = 16, MW = 1024, HD = 128, NH = 8, NG = 64, NST = 64, NIN = 22528;
constexpr int MP = NB * SEQ, MS = NB * DSEQ, MR = MP + MS, MROWS = 16640;
constexpr int KCS_ROWS = 2112, KBS_ROWS = 576, BANDK = 512, PASTL = 2048;
constexpr float LOG2E = 1.4426950408889634f, LN2 = 0.6931471805599453f;
constexpr size_t O_YP = 0, O_YS = O_YP + (size_t)MP * DM, O_PSBK = O_YS + (size_t)MS * DM, O_PSBV = O_PSBK + 2ull * MP * MW, O_PBK = O_PSBV + 2ull * MP * MW,
                 O_PBV = O_PBK + 2ull * NB * BANDK * MW, O_PSR = O_PBV + 2ull * NB * BANDK * MW, O_PSI = O_PSR + 2ull * NB * NG * NST, O_SSBK = O_PSI + 2ull * NB * NG * NST,
                 O_SSBV = O_SSBK + 2ull * MS * MW, O_SBK = O_SSBV + 2ull * MS * MW, O_SBV = O_SBK + 2ull * MS * MW, O_SSR = O_SBV + 2ull * MS * MW, O_SSI = O_SSR + 2ull * NB * NG * NST,
                 O_END = O_SSI + 2ull * NB * NG * NST;
constexpr size_t MiB = 1u << 20;
constexpr size_t R1K = (size_t)MROWS * 1024 * 2;
constexpr size_t WS_CTL = 0, CTL_ZERO_BYTES = 1 * MiB;
constexpr size_t WS_SSQ1 = 65536;
constexpr size_t WS_SSQ0 = 1 * MiB;
constexpr size_t WS_ABAR = WS_SSQ0 + 128 * 1024;
constexpr size_t WS_BMT = WS_ABAR + 64 * 1024;
constexpr size_t WS_CMT = WS_BMT + 512 * 1024;
constexpr size_t WS_WIN = 4 * MiB;
constexpr size_t WS_WGLU = WS_WIN + 2ull * NIN * DM * 2;
constexpr size_t WS_WBR = WS_WGLU + 2ull * MW * MW * 2;
constexpr size_t WS_WOUT = WS_WBR + 6ull * DM * MW * 2;
constexpr size_t WS_A0 = WS_WOUT + 2ull * DM * DM * 2;
constexpr size_t WS_U = WS_A0 + 4 * R1K;
constexpr size_t WS_SZ = WS_U + R1K;
constexpr size_t WS_QB = WS_SZ + 3 * R1K, WS_KB = WS_QB + R1K, WS_VB = WS_KB + R1K, WS_QC = WS_VB + R1K, WS_KC = WS_QC + R1K, WS_VC = WS_KC + R1K;
constexpr size_t WS_G = WS_VC + R1K;
constexpr size_t WS_YG = WS_G + 12 * R1K;
constexpr size_t WS_Y = WS_YG + R1K;
constexpr size_t WS_MX = WS_Y + 3 * R1K;
constexpr size_t WS_Y0 = WS_MX + 4 * R1K;
constexpr size_t WS_KCS = WS_Y0 + (size_t)MROWS * DM * 4;
constexpr size_t WS_VCS = WS_KCS + 16ull * KCS_ROWS * 1024 * 2;
constexpr size_t WS_KBS = WS_VCS + 16ull * KCS_ROWS * 1024 * 2;
constexpr size_t WS_VBS = WS_KBS + 16ull * KBS_ROWS * 1024 * 2;
constexpr size_t WS_END = WS_VBS + 16ull * KBS_ROWS * 1024 * 2;
static_assert(WS_END < 2900ull * MiB && WS_CMT + 512 * 1024 <= WS_WIN && (WS_WGLU % 256) == 0 && (R1K % 256) == 0, "d_ws map");
constexpr int CW_BAR = 4096;
constexpr int SCR_BYTES = 147456;
constexpr int LDSCTL_OFF = SCR_BYTES, MISC_OFF = LDSCTL_OFF + 320;
constexpr int LDS_BYTES = 155648;
constexpr int NWAVES = 8;

__device__ __forceinline__ unsigned pk2(float lo, float hi) { f32x2 v = {lo, hi}; bf16x2_t b = __builtin_convertvector(v, bf16x2_t); return __builtin_bit_cast(unsigned, b); }
__device__ __forceinline__ float bflo(unsigned w) { return __uint_as_float(w << 16); }
__device__ __forceinline__ float bfhi(unsigned w) { return __uint_as_float(w & 0xffff0000u); }
__device__ __forceinline__ float bf2f(bf16_t h) { return __uint_as_float((unsigned)h << 16); }
__device__ __forceinline__ bf16_t f2bf(float f) { return (bf16_t)(pk2(f, 0.f) & 0xffffu); }
__device__ __forceinline__ float ex2(float x) { return __builtin_amdgcn_exp2f(x); }
__device__ __forceinline__ float sigmoidf_(float x) { return __builtin_amdgcn_rcpf(1.0f + ex2(-x * LOG2E)); }
#define LDS_WAIT() asm volatile("s_waitcnt lgkmcnt(0)" ::: "memory")
#define VM_WAIT() asm volatile("s_waitcnt vmcnt(0)" ::: "memory")

namespace pg8 {
constexpr int BM = 256, BK = 64, HALF = 128, HTB = HALF * BK * 2  , STAGE_BYTES = 8 * HTB, NXCD = 8, WGM = 8;
__host__ __device__ __forceinline__ int lds_byte(int r, int c) { const int st = (r >> 4) * 2 + (c >> 5), rr = r & 15, cc = c & 31, ob = rr * 64 + cc * 2; return st * 1024 + (ob ^ (((ob >> 9) & 1) << 5)); }
__host__ __device__ __forceinline__ void stage_rc(int b, int& R, int& C) { const int st = b / 1024, sb = b % 1024, swz = sb ^ (((sb >> 9) & 1) << 5); R = (st >> 1) * 16 + swz / 64; C = (st & 1) * 32 + (swz % 64) / 2; }
__host__ __device__ __forceinline__ int perm32(int rho) { const int n = rho >> 4, i = rho & 15; return 8 * (i >> 2) + 4 * n + (i & 3); }

struct Unit { const char* a; const char* b; int pm, pn, aux, q, cs; };
struct Gemm { int lda, ldb, K; };

template <int REP> struct TileOrder {
    int nM, nN, nwg, G, c; const char* A; const char* B; size_t atile, btile, arep, brep; int fixed = 0;
    __device__ __forceinline__ bool next(int i, Unit& u) const {
        const int ti = i / REP, r = i - ti * REP;
        const long L = (long)ti * G + c; if (L >= nwg) return false;
        int wgid = (int)L; { const int q = nwg / NXCD, rr = nwg % NXCD, xcd = wgid % NXCD, off = wgid / NXCD; wgid = (xcd < rr ? xcd * (q + 1) : rr * (q + 1) + (xcd - rr) * q) + off; }
        const int nig = WGM * nN, gid = wgid / nig, fm = gid * WGM, gsz = (nM - fm) < WGM ? (nM - fm) : WGM;
        u.pm = fm + ((wgid % nig) % gsz); u.pn = (wgid % nig) / gsz; u.aux = r; u.q = 0; u.cs = 0;
        u.a = A + (size_t)((fixed & 1) ? 0 : u.pm) * atile + (size_t)r * arep; u.b = B + (size_t)((fixed & 2) ? 0 : u.pn) * btile + (size_t)r * brep; return true;
    }
};

template <int REP> struct QuarterOrder {
    int pmq, nN, G, c; const char* A; const char* B; size_t atile, btile, arep, brep, bhalf;
    __device__ __forceinline__ bool next(int i, Unit& u) const {
        const int ti = i / REP, r = i - ti * REP;
        const int L = ti * G + c; if (L >= 2 * nN) return false;
        u.pm = pmq; u.pn = L >> 1; u.aux = r; u.q = 1; u.cs = (L & 1) * HALF;
        u.a = A + (size_t)pmq * atile + (size_t)r * arep; u.b = B + (size_t)u.pn * btile + (size_t)(L & 1) * bhalf + (size_t)r * brep; return true;
    }
};

template <bool Q, class Epi, class Sched>
__device__ __forceinline__ void gemm_phase(LAS unsigned char* lds, const Gemm g, const Sched& S, const Epi& E) {
    int tid = threadIdx.x; asm volatile("" : "+v"(tid));
    const int wid = __builtin_amdgcn_readfirstlane(tid >> 6), lane = tid & 63, wr = wid >> 2, wc = wid & 3, fr = lane & 15, fq = lane >> 4;
    const int K = g.K, nt = K / BK;
    unsigned voffA[2], voffB[2];
#pragma unroll
    for (int i = 0; i < 2; ++i) { int R, C; stage_rc(tid * 16 + i * 8192, R, C); const int Rb = Epi::PERM ? ((R & ~31) + perm32(R & 31)) : R;
        voffA[i] = (unsigned)(R * g.lda + C) * 2u; voffB[i] = (unsigned)(Rb * g.ldb + C) * 2u; }
    const size_t kstep = (size_t)(BK * 2);
    const size_t hstepA = Q ? 0 : (size_t)HALF * g.lda * 2, hstepB = Q ? 0 : (size_t)HALF * g.ldb * 2;
    const unsigned ldsw = (unsigned)wid * 1024u;
    const int aoff = lds_byte(wr * 64 + fr, fq * 8), boff = lds_byte(wc * 32 + fr, fq * 8);
#define PG8_SA(b, h) (((b) * 2 + (h)) * HTB)
#define PG8_SB(b, h) ((4 + (b) * 2 + (h)) * HTB)
#define PG8_STAGE(bufoff, gbase, voff) do { _Pragma("unroll") for (int _i = 0; _i < 2; ++_i) \
        __builtin_amdgcn_global_load_lds((const unsigned*)((const char*)(gbase) + (voff)[_i]), (LAS unsigned*)(lds + (bufoff) + ldsw + _i * 8192), 16, 0, 0); } while (0)
#define PG8_LDA(dst, b, h) do { _Pragma("unroll") for (int m = 0; m < 4; ++m) _Pragma("unroll") for (int k = 0; k < 2; ++k) dst[m][k] = *(const LAS bf16x8*)(lds + PG8_SA(b, h) + aoff + m * 2048 + k * 1024); } while (0)
#define PG8_LDB(dst, b, h) do { _Pragma("unroll") for (int n = 0; n < 2; ++n) _Pragma("unroll") for (int k = 0; k < 2; ++k) dst[n][k] = *(const LAS bf16x8*)(lds + PG8_SB(b, h) + boff + n * 2048 + k * 1024); } while (0)
#define PG8_MMA(ai, bj, At, Bt) do { __builtin_amdgcn_s_setprio(1); _Pragma("unroll") for (int m = 0; m < 4; ++m) _Pragma("unroll") for (int n = 0; n < 2; ++n) _Pragma("unroll") for (int k = 0; k < 2; ++k) \
        acc[ai][bj][m][n] = __builtin_amdgcn_mfma_f32_16x16x32_bf16(Bt[n][k], At[m][k], acc[ai][bj][m][n], 0, 0, 0); __builtin_amdgcn_s_setprio(0); } while (0)
#define PG8_WAIT_V(n) asm volatile("s_waitcnt vmcnt(" #n ")" ::: "memory")
#define PG8_WAIT_L(n) asm volatile("s_waitcnt lgkmcnt(" #n ")" ::: "memory")
#define PG8_BAR __builtin_amdgcn_s_barrier()
#define PG8_SCHED __builtin_amdgcn_sched_barrier(0)
    Unit cur, nxt; int ui = 0;
    if (!S.next(0, cur)) return;
    f32x4 acc[2][2][4][2];
#pragma unroll
    for (int a = 0; a < 2; ++a)
#pragma unroll
        for (int b = 0; b < 2; ++b)
#pragma unroll
            for (int m = 0; m < 4; ++m)
#pragma unroll
                for (int n = 0; n < 2; ++n) acc[a][b][m][n] = (f32x4){0.f, 0.f, 0.f, 0.f};
    bf16x8 At[4][2], B0[2][2], B1[2][2];
    const char* cA = cur.a; const char* cB = cur.b;
    PG8_STAGE(PG8_SB(0, 0), cB, voffB); PG8_STAGE(PG8_SB(0, 1), cB + hstepB, voffB); PG8_STAGE(PG8_SA(0, 0), cA, voffA); PG8_STAGE(PG8_SA(0, 1), cA + hstepA, voffA);
    if (wr == 1) PG8_BAR;
    PG8_WAIT_V(2); PG8_BAR;
    PG8_STAGE(PG8_SB(1, 0), cB + kstep, voffB); PG8_STAGE(PG8_SA(1, 0), cA + kstep, voffA); PG8_STAGE(PG8_SB(1, 1), cB + hstepB + kstep, voffB);
    PG8_WAIT_V(6); PG8_BAR;
    for (;;) {
        const bool has_next = S.next(ui + 1, nxt);
        const char* nA = has_next ? nxt.a : cA; const char* nB = has_next ? nxt.b : cB;
        for (int t = 0; t < nt; t += 2) {
            const bool last = (t == nt - 2);
            const char* a1 = cA + (size_t)(t + 1) * kstep;
            const char* a2 = last ? nA : cA + (size_t)(t + 2) * kstep; const char* b2 = last ? nB : cB + (size_t)(t + 2) * kstep;
            const char* a3 = a2 + kstep; const char* b3 = b2 + kstep;
            PG8_LDB(B0, 0, 0); if (!Q) PG8_LDB(B1, 0, 1); PG8_SCHED; PG8_LDA(At, 0, 0); PG8_STAGE(PG8_SA(1, 1), a1 + hstepA, voffA);
            PG8_WAIT_V(8); PG8_WAIT_L(0); PG8_BAR; PG8_MMA(0, 0, At, B0); if (!Q) PG8_MMA(0, 1, At, B1); PG8_BAR; PG8_SCHED;
            if (!Q) PG8_LDA(At, 0, 1); PG8_STAGE(PG8_SB(0, 0), b2, voffB); PG8_STAGE(PG8_SB(0, 1), b2 + hstepB, voffB); PG8_STAGE(PG8_SA(0, 0), a2, voffA);
            PG8_WAIT_V(8); PG8_WAIT_L(0); PG8_BAR; if (!Q) { PG8_MMA(1, 0, At, B0); PG8_MMA(1, 1, At, B1); } PG8_BAR; PG8_SCHED;
            PG8_LDB(B0, 1, 0); if (!Q) PG8_LDB(B1, 1, 1); PG8_SCHED; PG8_LDA(At, 1, 0); PG8_STAGE(PG8_SA(0, 1), a2 + hstepA, voffA);
            PG8_WAIT_V(8); PG8_WAIT_L(0); PG8_BAR; PG8_MMA(0, 0, At, B0); if (!Q) PG8_MMA(0, 1, At, B1); PG8_BAR; PG8_SCHED;
            if (!Q) PG8_LDA(At, 1, 1); PG8_STAGE(PG8_SB(1, 0), b3, voffB); PG8_STAGE(PG8_SB(1, 1), b3 + hstepB, voffB); PG8_STAGE(PG8_SA(1, 0), a3, voffA);
            PG8_WAIT_V(8); PG8_WAIT_L(0); PG8_BAR; if (!Q) { PG8_MMA(1, 0, At, B0); PG8_MMA(1, 1, At, B1); } PG8_BAR; PG8_SCHED;
        }
        if (wr == 0) PG8_BAR;
        E.template run<Q>(acc, cur, wr, wc, fr, fq);
        if (!has_next) break;
        if (!E.keep(cur)) {
#pragma unroll
        for (int a = 0; a < 2; ++a)
#pragma unroll
            for (int b = 0; b < 2; ++b)
#pragma unroll
                for (int m = 0; m < 4; ++m)
#pragma unroll
                    for (int n = 0; n < 2; ++n) acc[a][b][m][n] = (f32x4){0.f, 0.f, 0.f, 0.f};
        }
        cur = nxt; cA = nA; cB = nB; ++ui;
        if (wr == 1) PG8_BAR;
    }
    PG8_WAIT_V(0);
    PG8_BAR;
#undef PG8_SA
#undef PG8_SB
#undef PG8_STAGE
#undef PG8_LDA
#undef PG8_LDB
#undef PG8_MMA
#undef PG8_WAIT_V
#undef PG8_WAIT_L
#undef PG8_BAR
#undef PG8_SCHED
}

template <class Epi, class Sched>
__device__ __forceinline__ void gemm_quarter(LAS unsigned char* lds, const Gemm g, const Sched& S, const Epi& E) {
    int tid = threadIdx.x; asm volatile("" : "+v"(tid));
    const int wid = __builtin_amdgcn_readfirstlane(tid >> 6), lane = tid & 63, wr = wid >> 2, wc = wid & 3, fr = lane & 15, fq = lane >> 4;
    const int nt = g.K / BK;
    unsigned voffA[2], voffB[2];
#pragma unroll
    for (int i = 0; i < 2; ++i) { int R, C; stage_rc(tid * 16 + i * 8192, R, C); const int Rb = Epi::PERM ? ((R & ~31) + perm32(R & 31)) : R;
        voffA[i] = (unsigned)(R * g.lda + C) * 2u; voffB[i] = (unsigned)(Rb * g.ldb + C) * 2u; }
    const unsigned ldsw = (unsigned)wid * 1024u;
    const int aoff = lds_byte(wr * 64 + fr, fq * 8), boff = lds_byte(wc * 32 + fr, fq * 8);
#define GQ_STAGE(slot, ga, gb) do { _Pragma("unroll") for (int _i = 0; _i < 2; ++_i) { \
        __builtin_amdgcn_global_load_lds((const unsigned*)((const char*)(ga) + voffA[_i]), (LAS unsigned*)(lds + (slot) * 32768 + ldsw + _i * 8192), 16, 0, 0); \
        __builtin_amdgcn_global_load_lds((const unsigned*)((const char*)(gb) + voffB[_i]), (LAS unsigned*)(lds + (slot) * 32768 + 16384 + ldsw + _i * 8192), 16, 0, 0); } } while (0)
    f32x4 acc[2][2][4][2];
    Unit cur; bool kept = false;
    for (int ui = 0; S.next(ui, cur); ++ui) {
        if (!kept) {
#pragma unroll
            for (int m = 0; m < 4; ++m)
#pragma unroll
                for (int n = 0; n < 2; ++n) acc[0][0][m][n] = (f32x4){0.f, 0.f, 0.f, 0.f};
        }
        const char* cA = cur.a; const char* cB = cur.b;
#pragma unroll
        for (int s4 = 0; s4 < 4; ++s4) GQ_STAGE(s4, cA + (size_t)s4 * (BK * 2), cB + (size_t)s4 * (BK * 2));
        for (int t = 0; t < nt; ++t) {
            const int slot = t & 3;
            asm volatile("s_waitcnt vmcnt(12)" ::: "memory");
            __builtin_amdgcn_s_barrier();
            bf16x8 At[4][2], B0[2][2];
#pragma unroll
            for (int n = 0; n < 2; ++n)
#pragma unroll
                for (int k = 0; k < 2; ++k) B0[n][k] = *(const LAS bf16x8*)(lds + slot * 32768 + 16384 + boff + n * 2048 + k * 1024);
#pragma unroll
            for (int m = 0; m < 4; ++m)
#pragma unroll
                for (int k = 0; k < 2; ++k) At[m][k] = *(const LAS bf16x8*)(lds + slot * 32768 + aoff + m * 2048 + k * 1024);
            asm volatile("s_waitcnt lgkmcnt(0)" ::: "memory");
            __builtin_amdgcn_s_barrier();
            const int tn = (t + 4 < nt) ? t + 4 : 0;
            GQ_STAGE(slot, cA + (size_t)tn * (BK * 2), cB + (size_t)tn * (BK * 2));
#pragma unroll
            for (int m = 0; m < 4; ++m)
#pragma unroll
                for (int n = 0; n < 2; ++n)
#pragma unroll
                    for (int k = 0; k < 2; ++k) acc[0][0][m][n] = __builtin_amdgcn_mfma_f32_16x16x32_bf16(B0[n][k], At[m][k], acc[0][0][m][n], 0, 0, 0);
        }
        asm volatile("s_waitcnt vmcnt(0)" ::: "memory");
        __builtin_amdgcn_s_barrier();
        E.template run<true>(acc, cur, wr, wc, fr, fq);
        kept = E.keep(cur);
    }
#undef GQ_STAGE
}
}

template <class T> __device__ __forceinline__ T* asg(T* p) { return (T*)(__attribute__((address_space(1))) T*)(unsigned long long)p; }
struct WsPtrs {
    unsigned char* ws;
#define WSP(name, T, off) __device__ __forceinline__ T* name() const { return (T*)(ws + (off)); }
    WSP(U, bf16_t, WS_U) WSP(SZ, bf16_t, WS_SZ) WSP(QB, bf16_t, WS_QB) WSP(KB, bf16_t, WS_KB) WSP(VB, bf16_t, WS_VB) WSP(QC, bf16_t, WS_QC) WSP(KC, bf16_t, WS_KC) WSP(VC, bf16_t, WS_VC)
    WSP(G, bf16_t, WS_G) WSP(YG, bf16_t, WS_YG) WSP(Y, bf16_t, WS_Y) WSP(MX, bf16_t, WS_MX) WSP(A0, bf16_t, WS_A0) WSP(KCS, bf16_t, WS_KCS) WSP(VCS, bf16_t, WS_VCS) WSP(KBS, bf16_t, WS_KBS) WSP(VBS, bf16_t, WS_VBS)
    WSP(Y0, float, WS_Y0) WSP(SSQ0, float, WS_SSQ0) WSP(SSQ1, float, WS_SSQ1)
#undef WSP
};
#ifndef G_NATIVE
#define G_NATIVE 1
#endif
#if G_NATIVE
__device__ __forceinline__ size_t g_slot(int pm, int gt, int wv, int ai, int m, int bjx, int lane) { return ((((((size_t)pm * 48 + gt) * 8 + wv) * 2 + ai) * 4 + m) * 2 + bjx) * 64 + lane; }
#else
__device__ __forceinline__ size_t g_slot(int pm, int gt, int wv, int ai, int m, int bjx, int lane) { const int row = pm * 256 + ai * 128 + (wv >> 2) * 64 + m * 16 + (lane & 15); return (size_t)row * 1536 + gt * 32 + bjx * 16 + (wv & 3) * 4 + (lane >> 4); }
#endif
typedef unsigned short u16x2 __attribute__((ext_vector_type(2)));
__device__ __forceinline__ unsigned pkmin_u16(unsigned a, unsigned b) { return __builtin_bit_cast(unsigned, __builtin_elementwise_min(__builtin_bit_cast(u16x2, a), __builtin_bit_cast(u16x2, b))); }
__device__ __forceinline__ void st_bf16x8_cap(bf16_t* p, f32x4 v0, f32x4 v1) {
    u32x4 w; w.x = pkmin_u16(pk2(v0[0], v0[1]), 0x71497149u); w.y = pkmin_u16(pk2(v0[2], v0[3]), 0x71497149u); w.z = pkmin_u16(pk2(v1[0], v1[1]), 0x71497149u); w.w = pkmin_u16(pk2(v1[2], v1[3]), 0x71497149u); __builtin_nontemporal_store(w, (u32x4*)p);
}
__device__ __forceinline__ void st_bf16x8_nt(bf16_t* p, f32x4 v0, f32x4 v1) {
    u32x4 w; w.x = pk2(v0[0], v0[1]); w.y = pk2(v0[2], v0[3]); w.z = pk2(v1[0], v1[1]); w.w = pk2(v1[2], v1[3]); __builtin_nontemporal_store(w, (u32x4*)p);
}
__device__ __forceinline__ void st_bf16x8(bf16_t* p, f32x4 v0, f32x4 v1) {
    u32x4 w; w.x = pk2(v0[0], v0[1]); w.y = pk2(v0[2], v0[3]); w.z = pk2(v1[0], v1[1]); w.w = pk2(v1[2], v1[3]); *(u32x4*)p = w;
}
struct Epi1 {
    static constexpr bool PERM = true;
    __device__ __forceinline__ bool keep(const pg8::Unit&) const { return false; }
    const float* ssq; const float* gate_b; float* out; WsPtrs W; int layer;
    template <bool Q> __device__ __forceinline__ void run(f32x4 (&acc)[2][2][4][2], const pg8::Unit& u, int wr, int wc, int fr, int fq) const {
        constexpr int NAI = Q ? 1 : 2, NBJ = Q ? 1 : 2;
        const int sec = u.pn >> 2;
        const int colt = (u.pn & 3) * 256 + u.cs + wc * 32 + 8 * fq;
        int mode = 0, ld = 1024, coff = 0, special = 0; float scale = 1.f; bf16_t* base;
        if (sec >= 10) { mode = 2; base = W.G(); ld = 12288; coff = (sec - 10) * 1024; }
        else if (sec == 1 || sec == 5 || sec == 9) { mode = 1; base = W.SZ(); ld = 3072; coff = (sec == 1) ? 0 : (sec == 5 ? 1024 : 2048); }
        else { base = (sec == 0) ? W.U() : (sec == 2) ? W.QB() : (sec == 3) ? W.KB() : (sec == 4) ? W.VB() : (sec == 6) ? W.QC() : (sec == 7) ? W.KC() : W.VC();
               if (sec == 6) scale = 0.08838834764831845f * LOG2E; special = (sec == 4 || sec == 7 || sec == 8) ? sec : 0; }
        f32x4 bv[NBJ][2];
#pragma unroll
        for (int bj = 0; bj < NBJ; ++bj)
#pragma unroll
            for (int n = 0; n < 2; ++n) bv[bj][n] = (mode == 2) ? *(const f32x4*)(gate_b + coff + colt + bj * 128 + 4 * n) * (-LOG2E) : (f32x4){0.f, 0.f, 0.f, 0.f};
        const int l = layer, row0 = u.pm * 256 + wr * 64 + fr;
        float rs[NAI][4];
#pragma unroll
        for (int ai = 0; ai < NAI; ++ai)
#pragma unroll
            for (int m = 0; m < 4; ++m) rs[ai][m] = ssq[row0 + ai * 128 + m * 16];
#pragma unroll
        for (int ai = 0; ai < NAI; ++ai)
#pragma unroll
            for (int m = 0; m < 4; ++m) rs[ai][m] = __builtin_amdgcn_rsqf(rs[ai][m] * (1.0f / 4096.0f) + 1e-6f) * scale;
        if (mode == 2) scale = -LOG2E;
#pragma unroll
        for (int ai = 0; ai < NAI; ++ai)
#pragma unroll
            for (int m = 0; m < 4; ++m) {
                const int row = row0 + ai * 128 + m * 16;
                bf16_t* d16 = base + (size_t)row * ld + coff + colt; float* d32 = nullptr;
                if (special) {
                    if (!Q) { const int b = row >> 11, t = row & 2047;
                        if (special == 7) d32 = out + O_PSBK + ((size_t)l * MP + row) * 1024 + colt;
                        else if (special == 8) d32 = out + O_PSBV + ((size_t)l * MP + row) * 1024 + colt;
                        else if (t >= SEQ - BANDK) d32 = out + O_PBV + ((size_t)(l * NB + b) * BANDK + (t - (SEQ - BANDK))) * 1024 + colt;
                    } else { const int sr = row - MP, b = sr >> 4, t = sr & 15;
                        if (special == 7) { d16 = W.KCS() + ((size_t)(l * NB + b) * KCS_ROWS + PASTL + t) * 1024 + colt; d32 = out + O_SSBK + ((size_t)l * MS + sr) * 1024 + colt; }
                        else if (special == 8) { d16 = W.VCS() + ((size_t)(l * NB + b) * KCS_ROWS + PASTL + t) * 1024 + colt; d32 = out + O_SSBV + ((size_t)l * MS + sr) * 1024 + colt; }
                        else { d16 = W.VBS() + ((size_t)(l * NB + b) * KBS_ROWS + BANDK + t) * 1024 + colt; d32 = out + O_SBV + ((size_t)l * MS + sr) * 1024 + colt; }
                    }
                }
#pragma unroll
                for (int bj = 0; bj < NBJ; ++bj) {
                    if (mode == 2) {
                        const float nrs = rs[ai][m] * scale;
                        f32x4 v0 = acc[ai][bj][m][0] * nrs + bv[bj][0], v1 = acc[ai][bj][m][1] * nrs + bv[bj][1];
#pragma unroll
                        for (int j = 0; j < 4; ++j) { v0[j] = ex2(v0[j]); v1[j] = ex2(v1[j]); }
                        v0 = v0 + 1.0f; v1 = v1 + 1.0f;
                        st_bf16x8_cap(W.G() + 8 * g_slot(u.pm, u.pn - 40, wr * 4 + wc, ai, m, bj + (u.cs >> 7), fq * 16 + fr), v0, v1);
                    } else {
                    f32x4 v0 = acc[ai][bj][m][0] * rs[ai][m], v1 = acc[ai][bj][m][1] * rs[ai][m];
                    if (mode == 1) {
#pragma unroll
                        for (int j = 0; j < 4; ++j) { v0[j] = v0[j] * sigmoidf_(v0[j]); v1[j] = v1[j] * sigmoidf_(v1[j]); } }
                    if (mode == 1) st_bf16x8_nt(d16 + bj * 128, v0, v1); else st_bf16x8(d16 + bj * 128, v0, v1);
                    if (d32) { __builtin_nontemporal_store(v0, (f32x4*)(d32 + bj * 128)); __builtin_nontemporal_store(v1, (f32x4*)(d32 + bj * 128 + 4)); }
                    }
                }
            }
    }
};
struct EpiNull {
    static constexpr bool PERM = true;
    __device__ __forceinline__ bool keep(const pg8::Unit&) const { return false; }
    float* sink;
    template <bool Q> __device__ __forceinline__ void run(f32x4 (&acc)[2][2][4][2], const pg8::Unit& u, int wr, int wc, int fr, int fq) const {
        float s = 0.f;
#pragma unroll
        for (int ai = 0; ai < 2; ++ai)
#pragma unroll
            for (int bj = 0; bj < 2; ++bj)
#pragma unroll
                for (int m = 0; m < 4; ++m)
#pragma unroll
                    for (int n = 0; n < 2; ++n) s += (acc[ai][bj][m][n][0] + acc[ai][bj][m][n][1]) + (acc[ai][bj][m][n][2] + acc[ai][bj][m][n][3]);
        if (s == 1.2345e30f) sink[u.pm + u.pn + wr + wc + fr + fq] = s;
    }
};
struct EpiGlu {
    static constexpr bool PERM = true;
    __device__ __forceinline__ bool keep(const pg8::Unit&) const { return false; }
    const float* bglu; WsPtrs W;
    template <bool Q> __device__ __forceinline__ void run(f32x4 (&acc)[2][2][4][2], const pg8::Unit& u, int wr, int wc, int fr, int fq) const {
        constexpr int NAI = Q ? 1 : 2, NBJ = Q ? 1 : 2;
        const int colt = u.pn * 256 + u.cs + wc * 32 + 8 * fq, row0 = u.pm * 256 + wr * 64 + fr;
        f32x4 bv[NBJ][2];
#pragma unroll
        for (int bj = 0; bj < NBJ; ++bj)
#pragma unroll
            for (int n = 0; n < 2; ++n) bv[bj][n] = *(const f32x4*)(bglu + colt + bj * 128 + 4 * n);
#pragma unroll
        for (int aim = 0; aim < 2 * NAI; ++aim) { const int ai = aim >> 1, mb = (aim & 1) * 2;
            u32x4 yg[4][NBJ], sz[4][NBJ];
#pragma unroll
            for (int m = mb; m < mb + 2; ++m)
#pragma unroll
                for (int bj = 0; bj < NBJ; ++bj) { const int row = row0 + ai * 128 + m * 16, col = colt + bj * 128;
                    yg[m][bj] = __builtin_nontemporal_load((const u32x4*)(W.YG() + (size_t)row * 1024 + col)); sz[m][bj] = __builtin_nontemporal_load((const u32x4*)(W.SZ() + (size_t)row * 3072 + col)); }
#pragma unroll
            for (int m = mb; m < mb + 2; ++m)
#pragma unroll
                for (int bj = 0; bj < NBJ; ++bj) { const int row = row0 + ai * 128 + m * 16, col = colt + bj * 128;
                    const u32x4 y = yg[m][bj], z = sz[m][bj];
                    f32x4 v0 = acc[ai][bj][m][0] + bv[bj][0], v1 = acc[ai][bj][m][1] + bv[bj][1];
                    v0[0] = bflo(y.x) * sigmoidf_(v0[0]) * bflo(z.x); v0[1] = bfhi(y.x) * sigmoidf_(v0[1]) * bfhi(z.x);
                    v0[2] = bflo(y.y) * sigmoidf_(v0[2]) * bflo(z.y); v0[3] = bfhi(y.y) * sigmoidf_(v0[3]) * bfhi(z.y);
                    v1[0] = bflo(y.z) * sigmoidf_(v1[0]) * bflo(z.z); v1[1] = bfhi(y.z) * sigmoidf_(v1[1]) * bfhi(z.z);
                    v1[2] = bflo(y.w) * sigmoidf_(v1[2]) * bflo(z.w); v1[3] = bfhi(y.w) * sigmoidf_(v1[3]) * bfhi(z.w);
                    st_bf16x8(W.Y() + (size_t)row * 3072 + col, v0, v1); }
        }
    }
};
struct EpiBr {
    static constexpr bool PERM = true;
    WsPtrs W;
    __device__ __forceinline__ bool keep(const pg8::Unit& u) const { return u.aux < 2; }
    template <bool Q> __device__ __forceinline__ void run(f32x4 (&acc)[2][2][4][2], const pg8::Unit& u, int wr, int wc, int fr, int fq) const {
        constexpr int NAI = Q ? 1 : 2, NBJ = Q ? 1 : 2;
        const int colt = u.pn * 256 + u.cs + wc * 32 + 8 * fq, br = u.aux, row0 = u.pm * 256 + wr * 64 + fr;
        if (br < 2) {
#pragma unroll
            for (int ai = 0; ai < NAI; ++ai) { constexpr int mb = 0;
                u32x4 gn[4][NBJ], gd[4][NBJ];
#pragma unroll
                for (int m = mb; m < mb + 4; ++m)
#pragma unroll
                    for (int bj = 0; bj < NBJ; ++bj) { const int bjx = bj + (u.cs >> 7), wv = wr * 4 + wc, ln = fq * 16 + fr;
                        gn[m][bj] = __builtin_nontemporal_load((const u32x4*)(W.G() + 8 * g_slot(u.pm, br * 16 + u.pn, wv, ai, m, bjx, ln))); gd[m][bj] = __builtin_nontemporal_load((const u32x4*)(W.G() + 8 * g_slot(u.pm, (br + 1) * 16 + u.pn, wv, ai, m, bjx, ln))); }
#pragma unroll
                for (int m = mb; m < mb + 4; ++m)
#pragma unroll
                    for (int bj = 0; bj < NBJ; ++bj) { const u32x4 a = gn[m][bj], d = gd[m][bj]; f32x4& v0 = acc[ai][bj][m][0]; f32x4& v1 = acc[ai][bj][m][1];
#define RAT(de, nu) ((nu) * __builtin_amdgcn_rcpf(de))
                        v0[0] *= RAT(bflo(a.x), bflo(d.x)); v0[1] *= RAT(bfhi(a.x), bfhi(d.x)); v0[2] *= RAT(bflo(a.y), bflo(d.y)); v0[3] *= RAT(bfhi(a.y), bfhi(d.y));
                        v1[0] *= RAT(bflo(a.z), bflo(d.z)); v1[1] *= RAT(bfhi(a.z), bfhi(d.z)); v1[2] *= RAT(bflo(a.w), bflo(d.w)); v1[3] *= RAT(bfhi(a.w), bfhi(d.w));
#undef RAT
                    }
            }
        } else {
#pragma unroll
            for (int ai = 0; ai < NAI; ++ai) {
                u32x4 g2[4][NBJ];
#pragma unroll
                for (int m = 0; m < 4; ++m)
#pragma unroll
                    for (int bj = 0; bj < NBJ; ++bj) g2[m][bj] = __builtin_nontemporal_load((const u32x4*)(W.G() + 8 * g_slot(u.pm, 32 + u.pn, wr * 4 + wc, ai, m, bj + (u.cs >> 7), fq * 16 + fr)));
#pragma unroll
                for (int m = 0; m < 4; ++m)
#pragma unroll
                    for (int bj = 0; bj < NBJ; ++bj) { const u32x4 g = g2[m][bj]; const f32x4 v0 = acc[ai][bj][m][0], v1 = acc[ai][bj][m][1];
                        f32x4 o0, o1;
                        o0[0] = v0[0] * __builtin_amdgcn_rcpf(bflo(g.x)); o0[1] = v0[1] * __builtin_amdgcn_rcpf(bfhi(g.x)); o0[2] = v0[2] * __builtin_amdgcn_rcpf(bflo(g.y)); o0[3] = v0[3] * __builtin_amdgcn_rcpf(bfhi(g.y));
                        o1[0] = v1[0] * __builtin_amdgcn_rcpf(bflo(g.z)); o1[1] = v1[1] * __builtin_amdgcn_rcpf(bfhi(g.z)); o1[2] = v1[2] * __builtin_amdgcn_rcpf(bflo(g.w)); o1[3] = v1[3] * __builtin_amdgcn_rcpf(bfhi(g.w));
                        st_bf16x8(W.MX() + (size_t)(row0 + ai * 128 + m * 16) * 4096 + colt + bj * 128, o0, o1); }
            }
        }
    }
};
struct EpiOut {
    static constexpr bool PERM = false;
    __device__ __forceinline__ bool keep(const pg8::Unit&) const { return false; }
    const float* xp; const float* xs; const float* ng1; float* out; WsPtrs W; int layer;
    template <bool Q> __device__ __forceinline__ void run(f32x4 (&acc)[2][2][4][2], const pg8::Unit& u, int wr, int wc, int fr, int fq) const {
        constexpr int NAI = Q ? 1 : 2, NBJ = Q ? 1 : 2;
        const int colt = u.pn * 256 + u.cs + wc * 32 + 4 * fq, row0 = u.pm * 256 + wr * 64 + fr;
        f32x4 gg[NBJ][2];
#pragma unroll
        for (int bj = 0; bj < NBJ; ++bj)
#pragma unroll
            for (int n = 0; n < 2; ++n) gg[bj][n] = (layer == 0) ? *(const f32x4*)(ng1 + colt + bj * 128 + n * 16) : (f32x4){0.f, 0.f, 0.f, 0.f};
#pragma unroll
        for (int aim = 0; aim < 2 * NAI; ++aim) { const int ai = aim >> 1, mb = (aim & 1) * 2;
            f32x4 rv[4][NBJ][2];
#pragma unroll
            for (int m = mb; m < mb + 2; ++m) { const int row = row0 + ai * 128 + m * 16;
                const float* res = (layer == 0) ? (Q ? xs + (size_t)(row - MP) * DM : xp + (size_t)row * DM) : W.Y0() + (size_t)row * DM;
#pragma unroll
                for (int bj = 0; bj < NBJ; ++bj)
#pragma unroll
                    for (int n = 0; n < 2; ++n) rv[m][bj][n] = __builtin_nontemporal_load((const f32x4*)(res + colt + bj * 128 + n * 16)); }
#pragma unroll
            for (int m = mb; m < mb + 2; ++m) { const int row = row0 + ai * 128 + m * 16;
                float* dst = (layer == 0) ? W.Y0() + (size_t)row * DM : (Q ? out + O_YS + (size_t)(row - MP) * DM : out + O_YP + (size_t)row * DM);
                float ss = 0.f;
#pragma unroll
                for (int bj = 0; bj < NBJ; ++bj)
#pragma unroll
                    for (int n = 0; n < 2; ++n) { const int col = colt + bj * 128 + n * 16;
                        const f32x4 y = acc[ai][bj][m][n] + rv[m][bj][n];
                        __builtin_nontemporal_store(y, (f32x4*)(dst + col));
                        if (layer == 0) { const f32x4 g4 = gg[bj][n]; ss += (y[0] * y[0] + y[1] * y[1]) + (y[2] * y[2] + y[3] * y[3]);
                            u32x2 w; w.x = pk2(y[0] * g4[0], y[1] * g4[1]); w.y = pk2(y[2] * g4[2], y[3] * g4[3]); *(u32x2*)(W.A0() + (size_t)row * DM + col) = w; } }
                if (layer == 0) { ss += __shfl_xor(ss, 16); ss += __shfl_xor(ss, 32); if (fq == 0) atomicAdd(W.SSQ1() + row, ss); }
            }
        }
    }
};

#define XB_TMO      128
#define XB_XCNT(j)  (256  + 64 * (j))
#define XB_XSUB(j)  (1280 + 64 * (j))
#define XB_XGEN(j)  (2304 + 64 * (j))
#define XB_TOP      3328
#define XB_TOPGEN   3392
#define XCD_BAR_WORDS 3456
#define XB_SPIN_CAP (1u << 22)
__device__ __forceinline__ unsigned xb_ld(unsigned* p)              { return __hip_atomic_load(p, __ATOMIC_RELAXED, __HIP_MEMORY_SCOPE_AGENT); }
__device__ __forceinline__ unsigned xb_add(unsigned* p, unsigned v) { return __hip_atomic_fetch_add(p, v, __ATOMIC_RELAXED, __HIP_MEMORY_SCOPE_AGENT); }
__device__ __forceinline__ unsigned xb_xcc_id() { return (unsigned)__builtin_amdgcn_s_getreg((3 << 11) | 20) & 0xFu; }
#define XB_SPIN(cond, bar) do { unsigned _sp = 0; while (cond) { __builtin_amdgcn_s_sleep(1); \
    if ((++_sp & 255u) == 0u) { if (xb_ld(&(bar)[XB_TMO])) break; if (_sp > XB_SPIN_CAP) { atomicAdd(&(bar)[XB_TMO], 1u); break; } } } } while (0)
struct XcdBarrier { unsigned* bar; unsigned x; volatile LAS unsigned* st; };
__device__ __forceinline__ XcdBarrier xcd_barrier_post(unsigned* bar, volatile LAS unsigned* st) {
    XcdBarrier b; b.bar = bar; b.x = xb_xcc_id(); b.st = st;
    if (threadIdx.x == 0) (void)xb_add(&bar[XB_XCNT(b.x)], 1u);
    return b;
}
__device__ __forceinline__ void xcd_barrier_complete(unsigned* bar, unsigned x, unsigned& nloc, unsigned& nx) {
    const unsigned G = gridDim.x * gridDim.y * gridDim.z;
    unsigned sum, cnt, mine, sp = 0u;
    for (;;) {
        sum = 0u; cnt = 0u; mine = 0u;
#pragma unroll
        for (unsigned j = 0; j < 16; ++j) { const unsigned c = xb_ld(&bar[XB_XCNT(j)]); sum += c; cnt += (c > 0u) ? 1u : 0u; mine = (j == x) ? c : mine; }
        if (sum == G) break;
        __builtin_amdgcn_s_sleep(1);
        if ((++sp & 255u) == 0u) { if (xb_ld(&bar[XB_TMO])) break; if (sp > XB_SPIN_CAP) { atomicAdd(&bar[XB_TMO], 1u); break; } }
    }
    nloc = mine > 0u ? mine : 1u; nx = cnt > 0u ? cnt : 1u;
}
__device__ __forceinline__ void xcd_barrier(const XcdBarrier& b) {
    asm volatile("s_waitcnt vmcnt(0)" ::: "memory");
    __syncthreads();
    if (threadIdx.x == 0) {
        unsigned* bar = b.bar;
        __builtin_amdgcn_s_waitcnt(0);
        unsigned nloc = b.st[0], nx = b.st[1];
        if (nloc == 0u) { xcd_barrier_complete(bar, b.x, nloc, nx); b.st[0] = nloc; b.st[1] = nx; }
        const unsigned old = xb_add(&bar[XB_XSUB(b.x)], 1u);
        const unsigned gen = old / nloc;
        if (old + 1u == (gen + 1u) * nloc) {
            __builtin_amdgcn_fence(__ATOMIC_RELEASE, "agent");
            asm volatile("s_waitcnt vmcnt(0)" ::: "memory");
            const unsigned og = xb_add(&bar[XB_TOP], 1u);
            const unsigned tg = og / nx;
            if (og + 1u == (tg + 1u) * nx) xb_add(&bar[XB_TOPGEN], 1u);
            else XB_SPIN(xb_ld(&bar[XB_TOPGEN]) == tg, bar);
            __builtin_amdgcn_fence(__ATOMIC_ACQUIRE, "agent");
            xb_add(&bar[XB_XGEN(b.x)], 1u);
            asm volatile("s_waitcnt vmcnt(0)" ::: "memory");
        } else {
            XB_SPIN(xb_ld(&bar[XB_XGEN(b.x)]) == gen, bar);
            __builtin_amdgcn_fence(__ATOMIC_ACQUIRE, "agent");
            asm volatile("s_waitcnt vmcnt(0)" ::: "memory");
        }
    }
    __syncthreads();
}

__device__ __forceinline__ void transpose_item(const float* W, int K, int N, bf16_t* WT, LAS float* scr, int item, int lane_) {
    int lane = lane_; asm volatile("" : "+v"(lane));
    const int sup = item >> 3, sub = item & 7, nsup = N / 128, kb4 = sup / nsup, nb2 = sup - kb4 * nsup, kb = 4 * kb4 + (sub >> 1), nb = 2 * nb2 + (sub & 1), k0 = 64 * kb, n0 = 64 * nb;
    const int kq = lane >> 4, nq = lane & 15;
#pragma unroll 4
    for (int i = 0; i < 16; ++i) { const int kk = 4 * i + kq; const f32x4 v = __builtin_nontemporal_load((const f32x4*)(W + (size_t)(k0 + kk) * N + n0 + 4 * nq));
        LAS float* s = scr + kk * 65 + 4 * nq; s[0] = v[0]; s[1] = v[1]; s[2] = v[2]; s[3] = v[3]; }
    LDS_WAIT();
    const int c = lane & 7, nl = lane >> 3;
#pragma unroll
    for (int j = 0; j < 8; ++j) { const int n = 8 * j + nl; const LAS float* s = scr + (8 * c) * 65 + n;
        u32x4 o; o.x = pk2(s[0 * 65], s[1 * 65]); o.y = pk2(s[2 * 65], s[3 * 65]); o.z = pk2(s[4 * 65], s[5 * 65]); o.w = pk2(s[6 * 65], s[7 * 65]);
        *(u32x4*)(WT + (size_t)(n0 + n) * K + k0 + 8 * c) = o; }
    LDS_WAIT();
}
__device__ __forceinline__ float wave_sum(float v) {
#pragma unroll
    for (int o = 1; o < 64; o <<= 1) v += __shfl_xor(v, o);
    return v;
}
__device__ __forceinline__ void xrow_to_a0(const float* xrow, const float* g, bf16_t* orow, float* ssq, int lane) {
    float s = 0.f;
#pragma unroll 4
    for (int j = 0; j < 16; ++j) { const f32x4 v = __builtin_nontemporal_load((const f32x4*)xrow + lane + 64 * j), gg = *((const f32x4*)g + lane + 64 * j);
        s += (v[0] * v[0] + v[1] * v[1]) + (v[2] * v[2] + v[3] * v[3]);
        u32x2 w; w.x = pk2(v[0] * gg[0], v[1] * gg[1]); w.y = pk2(v[2] * gg[2], v[3] * gg[3]); *((u32x2*)orow + lane + 64 * j) = w; }
    s = wave_sum(s);
    if (lane == 0) *ssq = s;
}

constexpr int SSM_PITCH = 132, SSM_TP = 36, SSM_WAVE_BYTES = 128 * SSM_TP * 4 + 1024;
static_assert(128 * SSM_TP >= 32 * SSM_PITCH, "h image fits the Bu^T region");
template <int NT> __device__ __forceinline__ void ssm_unit(LAS float* S, const unsigned char* ws, const float* dskip_l, int l, int g, const bf16_t* U, bf16_t* YG, int row0, int ntok,
                                         const float* h0re, const float* h0im, float* ore, float* oim, int lane_) {
    int lane = lane_; asm volatile("" : "+v"(lane));
    const int r32 = lane & 31, hi = lane >> 5, p16 = lane & 15, q4 = lane >> 4;
    LAS bf16_t* Us = (LAS bf16_t*)(S + 128 * SSM_TP);
    const f32x2 ab = *((const f32x2*)(ws + WS_ABAR) + (size_t)(l * NG + g) * NST + lane);
    const float ar = ab[0], ai = ab[1];
    bf16x8 bmf[4], cmf[4];
    const bf16_t* BMT = (const bf16_t*)(ws + WS_BMT) + (size_t)(l * NG + g) * 128 * 16;
    const bf16_t* CMT = (const bf16_t*)(ws + WS_CMT) + (size_t)(l * NG + g) * 16 * 128;
#pragma unroll
    for (int nb = 0; nb < 4; ++nb) bmf[nb] = *(const bf16x8*)(BMT + (size_t)(32 * nb + r32) * 16 + 8 * hi);
#pragma unroll
    for (int kb = 0; kb < 4; ++kb) cmf[kb] = *(const bf16x8*)(CMT + (size_t)p16 * 128 + 32 * kb + 8 * q4);
    const float dsk = dskip_l[16 * g + p16];
    float hr = h0re ? h0re[lane] : 0.f, hm = h0im ? h0im[lane] : 0.f;
    const bf16_t* up = U + (size_t)(row0 + r32) * 1024 + 16 * g + 8 * hi;
    bf16x8 uf = __builtin_nontemporal_load((const bf16x8*)up);
    for (int t0 = 0; t0 < ntok; t0 += 32) {
        const bf16x8 ucur = uf;
        if (t0 + 32 < ntok) uf = __builtin_nontemporal_load((const bf16x8*)(up + (size_t)(t0 + 32) * 1024));
        *(LAS bf16x8*)(Us + r32 * 16 + 8 * hi) = ucur;
#pragma unroll
        for (int nb = 0; nb < 4; ++nb) {
            f32x16 acc = {};
            acc = __builtin_amdgcn_mfma_f32_32x32x16_bf16(ucur, bmf[nb], acc, 0, 0, 0);
#pragma unroll
            for (int q = 0; q < 4; ++q) *(LAS f32x4*)(S + (32 * nb + r32) * SSM_TP + 8 * q + 4 * hi) = (f32x4){acc[4 * q], acc[4 * q + 1], acc[4 * q + 2], acc[4 * q + 3]};
        }
        LDS_WAIT();
        f32x4 br[NT / 4], bi[NT / 4];
#pragma unroll
        for (int t4 = 0; t4 < NT / 4; ++t4) { br[t4] = *(const LAS f32x4*)(S + lane * SSM_TP + 4 * t4); bi[t4] = *(const LAS f32x4*)(S + (64 + lane) * SSM_TP + 4 * t4); }
        LDS_WAIT();
#pragma unroll
        for (int t = 0; t < NT; ++t) {
            const float nr = ar * hr - ai * hm + br[t >> 2][t & 3], ni = ar * hm + ai * hr + bi[t >> 2][t & 3];
            hr = nr; hm = ni;
            S[t * SSM_PITCH + lane] = hr; S[t * SSM_PITCH + 64 + lane] = hm;
        }
        LDS_WAIT();
#pragma unroll
        for (int th = 0; th < NT / 16; ++th) {
            f32x4 ya = {0.f, 0.f, 0.f, 0.f};
#pragma unroll
            for (int kb = 0; kb < 4; ++kb) {
                const LAS float* sp = S + (16 * th + p16) * SSM_PITCH + 32 * kb + 8 * q4;
                const f32x4 a0 = *(const LAS f32x4*)sp, a1 = *(const LAS f32x4*)(sp + 4);
                u32x4 w; w.x = pk2(a0[0], a0[1]); w.y = pk2(a0[2], a0[3]); w.z = pk2(a1[0], a1[1]); w.w = pk2(a1[2], a1[3]);
                ya = __builtin_amdgcn_mfma_f32_16x16x32_bf16(__builtin_bit_cast(bf16x8, w), cmf[kb], ya, 0, 0, 0);
            }
#pragma unroll
            for (int j = 0; j < 4; ++j) {
                const int tl = 16 * th + 4 * q4 + j, tt = t0 + tl;
                const float y = ya[j] + dsk * bf2f(Us[tl * 16 + p16]);
                const float ge = y * __builtin_amdgcn_rcpf(1.0f + ex2(-2.3022081985f * y * (1.0f + 0.044715f * y * y)));
                YG[(size_t)(row0 + tt) * 1024 + 16 * g + p16] = f2bf(ge);
            }
        }
        LDS_WAIT();
    }
    ore[lane] = hr; oim[lane] = hm;
}

namespace att {
constexpr int L_V = 0, L_K = 16384, L_BUF = 32768, L_WS = 65536, L_BIAS = 67584, L_FLAG = 68864, L_OST = 73728;
#define KSWZ(row, colB) ((row) * 256 + ((colB) ^ (((row) & 7) << 4)))
#define SBAR() __builtin_amdgcn_sched_barrier(0)
__device__ __forceinline__ int crow(int r, int hi) { return (r & 3) + 8 * (r >> 2) + 4 * hi; }
__device__ __forceinline__ int v_st(int k, int c) { const int kk = (k & ~0xC) | ((k & 4) << 1) | ((k & 8) >> 1); return ((kk >> 3) * 4 + (c >> 5)) * 512 + ((kk & 7) * 32 + (c & 31)) * 2; }
__device__ __forceinline__ int v_rd_base(int lane) { return ((lane & 3) << 3) | (((lane >> 2) & 3) << 6) | (((lane >> 4) & 1) << 5) | (((lane >> 5) & 1) << 8); }
constexpr int v_rd_off(int d0, int ks, int half) { return d0 * 512 + ks * 4096 + half * 2048; }
template <int OFF> __device__ __forceinline__ s16x4 tr_read(int vb) {
    s16x4 r; asm volatile("ds_read_b64_tr_b16 %0, %1 offset:%2" : "=&v"(r) : "v"(vb), "i"(OFF) : "memory"); return r;
}
template <int D0> __device__ __forceinline__ void pv_one(f32x16& od, int vb, bf16x8 pa0, bf16x8 pa1, bf16x8 pa2, bf16x8 pa3) {
    const s16x4 l0 = tr_read<v_rd_off(D0, 0, 0)>(vb), h0 = tr_read<v_rd_off(D0, 0, 1)>(vb), l1 = tr_read<v_rd_off(D0, 1, 0)>(vb), h1 = tr_read<v_rd_off(D0, 1, 1)>(vb);
    const s16x4 l2 = tr_read<v_rd_off(D0, 2, 0)>(vb), h2 = tr_read<v_rd_off(D0, 2, 1)>(vb), l3 = tr_read<v_rd_off(D0, 3, 0)>(vb), h3 = tr_read<v_rd_off(D0, 3, 1)>(vb);
    asm volatile("s_waitcnt lgkmcnt(0)" ::: "memory"); SBAR();
#define PK(L, H) (bf16x8){L[0], L[1], L[2], L[3], H[0], H[1], H[2], H[3]}
    od = __builtin_amdgcn_mfma_f32_32x32x16_bf16(pa0, PK(l0, h0), od, 0, 0, 0);
    od = __builtin_amdgcn_mfma_f32_32x32x16_bf16(pa1, PK(l1, h1), od, 0, 0, 0);
    od = __builtin_amdgcn_mfma_f32_32x32x16_bf16(pa2, PK(l2, h2), od, 0, 0, 0);
    od = __builtin_amdgcn_mfma_f32_32x32x16_bf16(pa3, PK(l3, h3), od, 0, 0, 0);
#undef PK
}
__device__ __forceinline__ void pv_d0(f32x16* o, int vb, bf16x8 pa0, bf16x8 pa1, bf16x8 pa2, bf16x8 pa3) {
    pv_one<0>(o[0], vb, pa0, pa1, pa2, pa3); pv_one<1>(o[1], vb, pa0, pa1, pa2, pa3); pv_one<2>(o[2], vb, pa0, pa1, pa2, pa3); pv_one<3>(o[3], vb, pa0, pa1, pa2, pa3);
}
__device__ __forceinline__ void qkt(f32x16& p0, f32x16& p1, const LAS unsigned char* Ks, const LAS unsigned char* Qs, int r32, int hi) {
    p0 = f32x16{}; p1 = f32x16{};
    bf16x8 b0[2], b1[2], q[2];
    { const int cb = (hi * 8) * 2; b0[0] = *(const LAS bf16x8*)(Ks + KSWZ(r32, cb)); b1[0] = *(const LAS bf16x8*)(Ks + KSWZ(32 + r32, cb)); q[0] = *(const LAS bf16x8*)(Qs + KSWZ(r32, cb)); }
#pragma unroll
    for (int d0 = 0; d0 < 8; ++d0) { const int c = d0 & 1, n = c ^ 1;
        if (d0 < 7) { const int cb = ((d0 + 1) * 16 + hi * 8) * 2;
            b0[n] = *(const LAS bf16x8*)(Ks + KSWZ(r32, cb)); b1[n] = *(const LAS bf16x8*)(Ks + KSWZ(32 + r32, cb)); q[n] = *(const LAS bf16x8*)(Qs + KSWZ(r32, cb)); }
        if (d0 < 7) asm volatile("s_waitcnt lgkmcnt(3)" ::: "memory"); else asm volatile("s_waitcnt lgkmcnt(0)" ::: "memory");
        SBAR();
        p0 = __builtin_amdgcn_mfma_f32_32x32x16_bf16(b0[c], q[c], p0, 0, 0, 0);
        p1 = __builtin_amdgcn_mfma_f32_32x32x16_bf16(b1[c], q[c], p1, 0, 0, 0);
        SBAR(); }
}
__device__ __forceinline__ void qkt_half(f32x16& p, const LAS unsigned char* Ks, const LAS unsigned char* Qs, int r32, int hi, int half) {
    p = f32x16{};
    bf16x8 b0[2], q[2];
    { const int cb = (hi * 8) * 2; b0[0] = *(const LAS bf16x8*)(Ks + KSWZ(32 * half + r32, cb)); q[0] = *(const LAS bf16x8*)(Qs + KSWZ(r32, cb)); }
#pragma unroll
    for (int d0 = 0; d0 < 8; ++d0) { const int c = d0 & 1, n = c ^ 1;
        if (d0 < 7) { const int cb = ((d0 + 1) * 16 + hi * 8) * 2; b0[n] = *(const LAS bf16x8*)(Ks + KSWZ(32 * half + r32, cb)); q[n] = *(const LAS bf16x8*)(Qs + KSWZ(r32, cb)); }
        if (d0 < 7) asm volatile("s_waitcnt lgkmcnt(2)" ::: "memory"); else asm volatile("s_waitcnt lgkmcnt(0)" ::: "memory");
        SBAR();
        p = __builtin_amdgcn_mfma_f32_32x32x16_bf16(b0[c], q[c], p, 0, 0, 0);
        SBAR(); }
}
#define PK4(P, BASE, OUT) do { unsigned a0 = pk2(P[BASE + 0], P[BASE + 1]), a1 = pk2(P[BASE + 2], P[BASE + 3]);   \
    unsigned b0 = pk2(P[BASE + 4], P[BASE + 5]), b1 = pk2(P[BASE + 6], P[BASE + 7]);                              \
    auto r0 = __builtin_amdgcn_permlane32_swap(a0, b0, false, false); auto r1 = __builtin_amdgcn_permlane32_swap(a1, b1, false, false); \
    u32x4 w = {r0[0], r1[0], r0[1], r1[1]}; OUT = __builtin_bit_cast(bf16x8, w); } while (0)
__device__ __forceinline__ float swap_max(float v) { auto rr = __builtin_amdgcn_permlane32_swap(__float_as_uint(v), __float_as_uint(v), false, false); return fmaxf(__uint_as_float(rr[0]), __uint_as_float(rr[1])); }
__device__ __forceinline__ float swap_add(float v) { auto rr = __builtin_amdgcn_permlane32_swap(__float_as_uint(v), __float_as_uint(v), false, false); return __uint_as_float(rr[0]) + __uint_as_float(rr[1]); }

struct Desc {
    const bf16_t* Q;
    const bf16_t* K; const bf16_t* V;
    const bf16_t* SZ; bf16_t* Y;
    const float* bias;
    int qpos0, nvalid, nkeys;
};
template <int TYPE>
__device__ __forceinline__ void unit(LAS unsigned char* lds, const Desc& d) {
    int tid = threadIdx.x; asm volatile("" : "+v"(tid));
    const int wid = __builtin_amdgcn_readfirstlane(tid >> 6), lane = tid & 63, r32 = lane & 31, hi = lane >> 5;
    LAS float* wsf = (LAS float*)(lds + L_WS) + wid * 64;
    LAS float* biasL = (LAS float*)(lds + L_BIAS);
    volatile LAS unsigned* flags = (volatile LAS unsigned*)(lds + L_FLAG);
    const bool wvalid = (32 * wid < d.nvalid);
    const int qpos = d.qpos0 + 32 * wid + r32;
    const int cw = (d.qpos0 + 32 * wid) >> 6;
    const bool rowinvalid = (32 * wid + r32) >= d.nvalid;
    int t_lo, t_hi;
    if (TYPE == 0) { const int c0 = d.qpos0 >> 6; t_lo = c0 - 8 > 0 ? c0 - 8 : 0; t_hi = c0 + 3; const int tk = (d.nkeys - 1) >> 6; if (t_hi > tk) t_hi = tk; }
    else { t_lo = 0; t_hi = (d.qpos0 + 255) >> 6; const int tk = (d.nkeys - 1) >> 6; if (t_hi > tk) t_hi = tk; }
    __syncthreads();
    if (TYPE == 0) { for (int i = tid; i < 257; i += 512) biasL[i] = d.bias[i] * LOG2E; }
    if (TYPE == 1) { if (tid < 16) flags[tid] = (32 * (tid & 7) < d.nvalid) ? 0u : 1u; }
    LAS unsigned char* Ql = lds + L_OST + wid * 8192;
    if (wvalid) {
#pragma unroll
        for (int d0 = 0; d0 < 8; ++d0) { const bf16x8 qv = __builtin_nontemporal_load((const bf16x8*)(d.Q + (size_t)(32 * wid + r32) * 1024 + d0 * 16 + hi * 8)); *(LAS bf16x8*)(Ql + KSWZ(r32, (d0 * 16 + hi * 8) * 2)) = qv; }
    }
    const int sr = tid >> 4, sc = (tid & 15) * 8, vst0 = v_st(sr, sc), vst1 = v_st(32 + sr, sc), kst0 = KSWZ(sr, sc * 2), kst1 = KSWZ(32 + sr, sc * 2);
    const int vbase = (int)(unsigned)(uintptr_t)(lds + L_V) + v_rd_base(lane);
    bf16x8 sv0, sv1, sk0, sk1;
#define SLOAD(T_) do { const size_t k0_ = (size_t)(T_) * 64; sv0 = *(const bf16x8*)(d.V + (k0_ + sr) * 1024 + sc); sv1 = *(const bf16x8*)(d.V + (k0_ + 32 + sr) * 1024 + sc); \
        sk0 = *(const bf16x8*)(d.K + (k0_ + sr) * 1024 + sc); sk1 = *(const bf16x8*)(d.K + (k0_ + 32 + sr) * 1024 + sc); } while (0)
    f32x16 o[4]; o[0] = f32x16{}; o[1] = f32x16{}; o[2] = f32x16{}; o[3] = f32x16{};
    float m_reg = -1e30f, l_reg = 0.f, R = 0.f; bool wdone = !wvalid;
    bf16x8 T00, T01;
    if (TYPE == 1) {
#pragma unroll
        for (int e = 0; e < 8; ++e) { const int j0 = 8 * hi + e; T00[e] = (j0 > r32) ? (short)0x3F80 : (short)0; T01[e] = (16 + j0 > r32) ? (short)0x3F80 : (short)0; }
    }
    const int step = (TYPE == 0) ? 1 : -1, nT = t_hi - t_lo + 1;
    int T = (TYPE == 0) ? t_lo : t_hi;
#define SWRITE(B_) do { LAS unsigned char* vb_ = lds + (B_) * L_BUF + L_V; LAS unsigned char* kb_ = lds + (B_) * L_BUF + L_K; \
        *(LAS bf16x8*)(vb_ + vst0) = sv0; *(LAS bf16x8*)(vb_ + vst1) = sv1; *(LAS bf16x8*)(kb_ + kst0) = sk0; *(LAS bf16x8*)(kb_ + kst1) = sk1; } while (0)
    SLOAD(T); SWRITE(0);
    if (nT > 1) SLOAD(T + step);
    __syncthreads();
    if (wid < 4) __builtin_amdgcn_s_setprio(1);
    for (int it = 0; it < nT; ++it, T += step) {
        const int cur = it & 1;
        if (TYPE == 1) { volatile LAS unsigned* fl = flags + 8 * (cur ^ 1); const unsigned f = fl[0] & fl[1] & fl[2] & fl[3] & fl[4] & fl[5] & fl[6] & fl[7]; if (f) break; }
        if (it + 1 < nT) SWRITE(cur ^ 1);
        if (it + 2 < nT) SLOAD(T + 2 * step);
        const LAS unsigned char* Kl = lds + cur * L_BUF + L_K; const int vb0 = vbase + cur * L_BUF;
        if (TYPE == 0) {
            if (wvalid && T >= cw - 8 && T <= cw) {
                f32x16 p0, p1; qkt(p0, p1, Kl, Ql, r32, hi);
                const int dc = cw - T;
                if (dc >= 3) { const float bf = biasL[256];
#pragma unroll
                    for (int r = 0; r < 16; ++r) { p0[r] += bf; p1[r] += bf; } }
                else { const int relb = qpos - 64 * T + 128;
#pragma unroll
                    for (int r = 0; r < 16; ++r) { int i0 = relb - crow(r, hi); int i1 = i0 - 32; i0 = i0 < 0 ? 0 : (i0 > 256 ? 256 : i0); i1 = i1 < 0 ? 0 : (i1 > 256 ? 256 : i1); p0[r] += biasL[i0]; p1[r] += biasL[i1]; } }
                const bool needmask = (64 * T + 63 >= d.nkeys);
                if (needmask) {
#pragma unroll
                    for (int r = 0; r < 16; ++r) { const int kp = 64 * T + crow(r, hi); if (kp >= d.nkeys) p0[r] = -1e30f; if (kp + 32 >= d.nkeys) p1[r] = -1e30f; } }
                float pmax = p0[0];
#pragma unroll
                for (int r = 1; r < 16; ++r) pmax = fmaxf(pmax, p0[r]);
#pragma unroll
                for (int r = 0; r < 16; ++r) pmax = fmaxf(pmax, p1[r]);
                pmax = swap_max(pmax);
                float alpha = 1.f; const bool grow = __any(pmax > m_reg + 8.0f);
                if (grow) { const float mx = fmaxf(m_reg, pmax); alpha = ex2(m_reg - mx); m_reg = mx; }
                const float mn = m_reg;
#pragma unroll
                for (int r = 0; r < 16; ++r) { p0[r] = ex2(p0[r] - mn); p1[r] = ex2(p1[r] - mn); }
                if (needmask) {
#pragma unroll
                    for (int r = 0; r < 16; ++r) { const int kp = 64 * T + crow(r, hi); if (kp >= d.nkeys) p0[r] = 0.f; if (kp + 32 >= d.nkeys) p1[r] = 0.f; } }
                float ps = 0.f;
#pragma unroll
                for (int r = 0; r < 16; ++r) ps += p0[r] + p1[r];
                ps = swap_add(ps);
                l_reg = l_reg * alpha + ps;
                if (grow && __any(alpha < 1.f)) { if (hi == 0) wsf[r32] = alpha; LDS_WAIT();
#pragma unroll
                    for (int dd = 0; dd < 4; ++dd)
#pragma unroll
                        for (int r = 0; r < 16; ++r) o[dd][r] *= wsf[crow(r, hi)]; }
                bf16x8 pa0, pa1, pa2, pa3; PK4(p0, 0, pa0); PK4(p0, 8, pa1); PK4(p1, 0, pa2); PK4(p1, 8, pa3);
                pv_d0(o, vb0, pa0, pa1, pa2, pa3);
            }
        } else {
            if (!wdone && T <= cw) {
                const bool diag = (T == cw);
                bf16x8 pa0, pa1, pa2, pa3; float ts1, ts0;
                {
                    f32x16 z, lf; qkt_half(z, Kl, Ql, r32, hi, 1); float ts = 0.f;
#pragma unroll
                    for (int r = 0; r < 16; ++r) { const float zz = z[r], e = ex2(-fabsf(zz)), l1p = __builtin_amdgcn_logf(1.0f + e); float lb = fminf(zz, 0.f) - l1p, lfv = -fmaxf(zz, 0.f) - l1p;
                        if (diag) { const bool c = (64 * T + 32 + crow(r, hi)) < qpos; lfv = c ? lfv : 0.f; lb = c ? lb : -1e30f; }
                        z[r] = lb; lf[r] = lfv; ts += lfv; }
                    ts1 = swap_add(ts);
                    bf16x8 la2, la3; PK4(lf, 0, la2); PK4(lf, 8, la3);
                    f32x16 L = f32x16{};
                    L = __builtin_amdgcn_mfma_f32_32x32x16_bf16(T00, la2, L, 0, 0, 0); L = __builtin_amdgcn_mfma_f32_32x32x16_bf16(T01, la3, L, 0, 0, 0);
#pragma unroll
                    for (int r = 0; r < 16; ++r) z[r] = ex2(z[r] + L[r] + R);
                    PK4(z, 0, pa2); PK4(z, 8, pa3);
                }
                {
                    f32x16 z, lf; qkt_half(z, Kl, Ql, r32, hi, 0); float ts = 0.f;
#pragma unroll
                    for (int r = 0; r < 16; ++r) { const float zz = z[r], e = ex2(-fabsf(zz)), l1p = __builtin_amdgcn_logf(1.0f + e); float lb = fminf(zz, 0.f) - l1p, lfv = -fmaxf(zz, 0.f) - l1p;
                        if (diag) { const bool c = (64 * T + crow(r, hi)) < qpos; lfv = c ? lfv : 0.f; lb = c ? lb : -1e30f; }
                        z[r] = lb; lf[r] = lfv; ts += lfv; }
                    ts0 = swap_add(ts);
                    bf16x8 la0, la1; PK4(lf, 0, la0); PK4(lf, 8, la1);
                    f32x16 L = f32x16{};
                    L = __builtin_amdgcn_mfma_f32_32x32x16_bf16(T00, la0, L, 0, 0, 0); L = __builtin_amdgcn_mfma_f32_32x32x16_bf16(T01, la1, L, 0, 0, 0);
                    const float Rr = R + ts1;
#pragma unroll
                    for (int r = 0; r < 16; ++r) z[r] = ex2(z[r] + L[r] + Rr);
                    PK4(z, 0, pa0); PK4(z, 8, pa1);
                }
                pv_d0(o, vb0, pa0, pa1, pa2, pa3);
                const float ts = ts0 + ts1;
                R += ts;
                wdone = __all((R < -160.f) || rowinvalid);
            }
            if (lane == 0) flags[8 * cur + wid] = wdone ? 1u : 0u;
        }
        __syncthreads();
    }
    __builtin_amdgcn_s_setprio(0);
    if (wvalid) {
        LAS bf16_t* stg = (LAS bf16_t*)(lds + L_OST) + wid * 4096;
        if (TYPE == 0) { if (hi == 0) wsf[32 + r32] = l_reg; LDS_WAIT(); }
#pragma unroll
        for (int r = 0; r < 16; ++r) { const int rw = crow(r, hi); const float rl = (TYPE == 0) ? __builtin_amdgcn_rcpf(wsf[32 + rw]) : 1.f;
#pragma unroll
            for (int dd = 0; dd < 4; ++dd) stg[rw * 128 + dd * 32 + r32] = f2bf(o[dd][r] * rl); }
        LDS_WAIT();
#pragma unroll 2
        for (int i = 0; i < 8; ++i) { const int rw = i * 4 + (lane >> 4), ch = lane & 15, row = 32 * wid + rw;
            if (row < d.nvalid) { const size_t off = (size_t)row * 3072 + ch * 8;
                const u32x4 ov = *(const LAS u32x4*)(stg + rw * 128 + ch * 8), gv = __builtin_nontemporal_load((const u32x4*)(d.SZ + off));
                u32x4 w; w.x = pk2(bflo(ov.x) * bflo(gv.x), bfhi(ov.x) * bfhi(gv.x)); w.y = pk2(bflo(ov.y) * bflo(gv.y), bfhi(ov.y) * bfhi(gv.y));
                w.z = pk2(bflo(ov.z) * bflo(gv.z), bfhi(ov.z) * bfhi(gv.z)); w.w = pk2(bflo(ov.w) * bflo(gv.w), bfhi(ov.w) * bfhi(gv.w));
                *(u32x4*)(d.Y + off) = w; } }
    }
#undef SLOAD
#undef SWRITE
}
}

#if defined(DBG_ONLY0)
#define ATT_DISPATCH(type, lds, d) att::unit<0>(lds, d)
#elif defined(DBG_ONLY1)
#define ATT_DISPATCH(type, lds, d) att::unit<1>(lds, d)
#elif defined(DBG_NOATT)
#define ATT_DISPATCH(type, lds, d) (void)d
#else
#define ATT_DISPATCH(type, lds, d) do { if (type) att::unit<1>(lds, d); else att::unit<0>(lds, d); } while (0)
#endif
struct Args { const float* in[28]; float* out; unsigned char* ws; int ph_lo, ph_hi; };
constexpr int I_IN = (DM / 64) * (NIN / 64), I_GLU = 16 * 16, I_BR = (MW / 64) * (DM / 64), I_OUT = 64 * 64, I_L = I_IN + I_GLU + 3 * I_BR + I_OUT;
__device__ __forceinline__ void weight_item(const float* w_in, const float* w_glu, const float* w_br0, const float* w_br1, const float* w_br2, const float* w_out, unsigned char* ws, int l, int r, LAS float* scr, int lane) {
    if (r < I_IN) { transpose_item(w_in + (size_t)l * DM * NIN, DM, NIN, (bf16_t*)(ws + WS_WIN) + (size_t)l * NIN * DM, scr, r, lane); return; } r -= I_IN;
    if (r < I_GLU) { transpose_item(w_glu + (size_t)l * MW * MW, MW, MW, (bf16_t*)(ws + WS_WGLU) + (size_t)l * MW * MW, scr, r, lane); return; } r -= I_GLU;
    if (r < 3 * I_BR) { const int br = r / I_BR; r -= br * I_BR;
        transpose_item((br == 0 ? w_br0 : br == 1 ? w_br1 : w_br2) + (size_t)l * MW * DM, MW, DM, (bf16_t*)(ws + WS_WBR) + (size_t)(l * 3 + br) * DM * MW, scr, r, lane); return; } r -= 3 * I_BR;
    transpose_item(w_out + (size_t)l * DM * DM, DM, DM, (bf16_t*)(ws + WS_WOUT) + (size_t)l * DM * DM, scr, r, lane);
}
__device__ __forceinline__ void convert_caches(const float* sbk, const float* sbv, const float* bdk, const float* bdv, const WsPtrs W, int l, int wg, int nwg, int gsz) {
    int t_ = threadIdx.x; asm volatile("" : "+v"(t_));
    const size_t gt = (size_t)wg * gsz + (t_ & (gsz - 1)), NT = (size_t)nwg * gsz;
    const size_t n_sb = 8ull * PASTL * 128, n_bd = 8ull * BANDK * 128;
    for (size_t i = gt; i < 2 * n_sb + 2 * n_bd; i += NT) {
        const float* src; bf16_t* dst; size_t j = i;
        if (j < 2 * n_sb) { const int kv = j >= n_sb; j -= kv * n_sb; const size_t lb = (size_t)l * NB + j / ((size_t)PASTL * 128), rem = j % ((size_t)PASTL * 128), t = rem >> 7, c8 = rem & 127;
            src = (kv ? sbv : sbk) + (lb * PASTL + t) * 1024 + c8 * 8; dst = (kv ? W.VCS() : W.KCS()) + (lb * KCS_ROWS + t) * 1024 + c8 * 8; }
        else { j -= 2 * n_sb; const int kv = j >= n_bd; j -= kv * n_bd; const size_t lb = (size_t)l * NB + j / ((size_t)BANDK * 128), rem = j % ((size_t)BANDK * 128), t = rem >> 7, c8 = rem & 127;
            src = (kv ? bdv : bdk) + (lb * BANDK + t) * 1024 + c8 * 8; dst = (kv ? W.VBS() : W.KBS()) + (lb * KBS_ROWS + t) * 1024 + c8 * 8; }
        const f32x4 a = __builtin_nontemporal_load((const f32x4*)src), b = __builtin_nontemporal_load((const f32x4*)(src + 4));
        st_bf16x8(dst, a, b);
    }
}
constexpr int N_PHASES = 11;

__global__ void __launch_bounds__(NWAVES * 64, 2) hse_fwd(Args args) {
    extern __shared__ __attribute__((aligned(16))) unsigned char lds_raw[];
    LAS unsigned char* lds = (LAS unsigned char*)lds_raw;
    volatile LAS unsigned* MISC = (volatile LAS unsigned*)(lds + MISC_OFF);
    const int tid = threadIdx.x, lane = tid & 63, wave = __builtin_amdgcn_readfirstlane(tid >> 6);
    const int G = gridDim.x; const int bx = blockIdx.x; const int vcu = (G % 8 == 0) ? (bx % 8) * (G / 8) + bx / 8 : bx;
    unsigned char* ws = args.ws; float* out = args.out;
    const CAS Args* const kargs = (const CAS Args*)__builtin_amdgcn_kernarg_segment_ptr();
#define KARGS() const CAS Args* KA = kargs; asm volatile("" : "+s"(KA))
#define PHASE_BEGIN() KARGS(); unsigned char* ws_o_ = ws; float* out_o_ = out; asm volatile("" : "+s"(ws_o_), "+s"(out_o_)); unsigned char* const ws = asg(ws_o_); float* const out = asg(out_o_); WsPtrs W; W.ws = ws; (void)out; (void)KA; \
    int G_o_ = G, bx_o_ = bx, vcu_o_ = vcu; asm volatile("" : "+s"(G_o_), "+s"(bx_o_), "+s"(vcu_o_)); const int G = G_o_, bx = bx_o_, vcu = vcu_o_; (void)G; (void)bx; (void)vcu
    unsigned* ctl = (unsigned*)(ws + WS_CTL);
    WsPtrs W; W.ws = ws;
    for (int u = tid; u < (LDS_BYTES - LDSCTL_OFF) / 4; u += NWAVES * 64) ((LAS unsigned*)(lds + LDSCTL_OFF))[u] = 0u;
    __syncthreads();
    XcdBarrier bar; bar.bar = ctl + CW_BAR; bar.x = 0; bar.st = nullptr;
    if (!MK_SPLIT) bar = xcd_barrier_post(ctl + CW_BAR, MISC + 8);
    const int lo = args.ph_lo, hi_ph = args.ph_hi;
#define IN(k) (lo <= (k) && (k) < hi_ph)
#define SEAM(k) do { if (!MK_SPLIT && (k) + 1 < hi_ph) xcd_barrier(bar); } while (0)
    const int gw = vcu * NWAVES + wave, NGW = G * NWAVES;

#ifndef NO_P0
    if (IN(0)) {
        PHASE_BEGIN();
        for (int lg = NGW - 1 - gw; lg < 2 * NG; lg += NGW) {
            const int l = lg / NG, g = lg - l * NG, n = lane;
            const float dt = expf(KA->in[12][lg]);
            const float are = KA->in[10][(size_t)lg * NST + n], aim = KA->in[11][(size_t)lg * NST + n];
            const float mag = expf(are * dt), abr = mag * cosf(aim * dt), abi = mag * sinf(aim * dt);
            const float den = are * are + aim * aim, nr = abr - 1.0f;
            const float kre = (nr * are + abi * aim) / den, kim = (abi * are - nr * aim) / den;
            *((f32x2*)(ws + WS_ABAR) + (size_t)lg * NST + n) = (f32x2){abr, abi};
            bf16_t* BMT = (bf16_t*)(ws + WS_BMT) + (size_t)lg * 128 * 16; bf16_t* CMT = (bf16_t*)(ws + WS_CMT) + (size_t)lg * 16 * 128;
            const float* bre = KA->in[13] + ((size_t)lg * NST + n) * 16; const float* bim = KA->in[14] + ((size_t)lg * NST + n) * 16;
#pragma unroll
            for (int p = 0; p < 16; ++p) { const float br_ = bre[p], bi_ = bim[p];
                BMT[(size_t)n * 16 + p] = f2bf(kre * br_ - kim * bi_); BMT[(size_t)(64 + n) * 16 + p] = f2bf(kre * bi_ + kim * br_);
                CMT[(size_t)p * 128 + n] = f2bf(KA->in[15][((size_t)lg * 16 + p) * NST + n]); CMT[(size_t)p * 128 + 64 + n] = f2bf(-KA->in[16][((size_t)lg * 16 + p) * NST + n]); }
        }
        LAS float* scr = (LAS float*)(lds + wave * 16640);
        for (int rep_ = 0; rep_ < ((DBG_DUP & 1) ? 2 : 1); ++rep_)
        for (int it = gw; it < I_L; it += NGW) weight_item(KA->in[9], KA->in[18], KA->in[23], KA->in[24], KA->in[25], KA->in[27], ws, 0, it, scr, lane);
        for (int m = gw; m < MR; m += NGW) {
            const float* xr = (m < MP) ? KA->in[0] + (size_t)m * DM : KA->in[1] + (size_t)(m - MP) * DM;
            xrow_to_a0(xr, KA->in[8], W.A0() + (size_t)m * DM, W.SSQ0() + m, lane);
        }
        convert_caches(KA->in[2], KA->in[3], KA->in[4], KA->in[5], W, 0, vcu, G, 512);
        for (int i = gw; i < 16 * 96 * 2; i += NGW) { const int kv = i & 1, j = i >> 1, lb = j / 96, rr = j - lb * 96;
            bf16_t* p = (rr < 48) ? (kv ? W.VCS() : W.KCS()) + ((size_t)lb * KCS_ROWS + PASTL + DSEQ + rr) * 1024 : (kv ? W.VBS() : W.KBS()) + ((size_t)lb * KBS_ROWS + BANDK + DSEQ + (rr - 48)) * 1024;
            *((u32x4*)p + lane) = (u32x4){0u, 0u, 0u, 0u}; *((u32x4*)p + 64 + lane) = (u32x4){0u, 0u, 0u, 0u}; }
        SEAM(0);
    }
#endif

    for (int l = 0; l < 2; ++l) {
        const int pb = 1 + 5 * l;
#ifndef NO_P1
        if (IN(pb)) {
            PHASE_BEGIN();
            pg8::Gemm g{DM, DM, DM};
            pg8::TileOrder<1> S; S.nM = MP / 256; S.nN = NIN / 256; S.nwg = S.nM * S.nN; S.G = G; S.c = bx;
            S.A = (const char*)W.A0(); S.B = (const char*)(ws + WS_WIN) + (size_t)l * NIN * DM * 2; S.atile = 256ull * DM * 2; S.btile = 256ull * DM * 2; S.arep = 0; S.brep = 0;
            pg8::QuarterOrder<1> SQ; SQ.pmq = MP / 256; SQ.nN = S.nN; SQ.G = G; SQ.c = bx; SQ.A = S.A; SQ.B = S.B; SQ.atile = S.atile; SQ.btile = S.btile; SQ.arep = 0; SQ.brep = 0; SQ.bhalf = 128ull * DM * 2;
            Epi1 E{l == 0 ? W.SSQ0() : W.SSQ1(), KA->in[26] + (size_t)l * 3 * DM, out, W, l};
            long long ck0 = 0, rt0 = 0; if (DBG_CLK == 1 && l == 0 && bx == 0) { ck0 = clock64(); rt0 = wall_clock64(); }
            pg8::gemm_phase<false>(lds, g, S, E);
            pg8::gemm_quarter(lds, g, SQ, E);
            if (DBG_CLK == 1 && l == 0 && bx == 0 && tid == 0) { const long long dc = clock64() - ck0, dr = wall_clock64() - rt0; ((long long*)(ws + WS_CTL + 32768))[0] = dc; ((long long*)(ws + WS_CTL + 32768))[1] = dr; }
            if (DBG_DUP & 2) { pg8::gemm_phase<false>(lds, g, S, E); pg8::gemm_quarter(lds, g, SQ, E); }
            if (DBG_DUP & 0xF00) { EpiNull EN{(float*)(ws + WS_CTL + 49152)}; S.fixed = (DBG_DUP >> 9) & 3; pg8::gemm_phase<false>(lds, g, S, EN); }
            if (DBG_CLK == 2 && l == 0 && tid == 0) { const unsigned long long t_ = (unsigned long long)wall_clock64(); atomicMax((unsigned long long*)(ws + WS_CTL + 40960), t_); atomicMax((unsigned long long*)(ws + WS_CTL + 40960) + 8, ~t_); }
            SEAM(pb);
            if (DBG_CLK == 2 && l == 0 && bx == 0 && tid == 0) { const unsigned long long mx = *((unsigned long long*)(ws + WS_CTL + 40960)), mn = ~*((unsigned long long*)(ws + WS_CTL + 40960) + 8);
                ((long long*)(ws + WS_CTL + 32768))[0] = (long long)(mx - mn) * 10; ((long long*)(ws + WS_CTL + 32768))[1] = 1; }
        }
#endif
#ifndef NO_P2A
        if (IN(pb + 1)) {
            PHASE_BEGIN();
            constexpr int NSW = 2, NHWV = NWAVES - NSW;
            if (wave < NSW) {
                LAS float* S = (LAS float*)(lds + wave * SSM_WAVE_BYTES);
                __builtin_amdgcn_s_setprio(2);
                for (int st = vcu * NSW + wave; st < 1024; st += G * NSW) {
                    const int sample = st >= 512, ii = st & 511, b = ii >> 6, g = ii & 63;
                    if (!sample) ssm_unit<32>(S, ws, KA->in[17] + (size_t)l * MW, l, g, W.U(), W.YG(), b * SEQ, SEQ, nullptr, nullptr,
                                          out + O_PSR + ((size_t)(l * NB + b) * NG + g) * NST, out + O_PSI + ((size_t)(l * NB + b) * NG + g) * NST, lane);
                    else ssm_unit<16>(S, ws, KA->in[17] + (size_t)l * MW, l, g, W.U(), W.YG(), MP + b * DSEQ, DSEQ,
                                  KA->in[6] + ((size_t)(l * NB + b) * NG + g) * NST, KA->in[7] + ((size_t)(l * NB + b) * NG + g) * NST,
                                  out + O_SSR + ((size_t)(l * NB + b) * NG + g) * NST, out + O_SSI + ((size_t)(l * NB + b) * NG + g) * NST, lane);
                }
                __builtin_amdgcn_s_setprio(0);
            } else
            { const int hw = vcu * NHWV + (wave - NSW), NHW = G * NHWV;
              {
                const float* qg = KA->in[20] + (size_t)l * HD; const float* kg = KA->in[21] + (size_t)l * HD;
                int lane_o = lane; asm volatile("" : "+v"(lane_o));
                const int c0 = 16 * lane_o, dd = c0 & 127;
                float gq[16], gk[16];
#pragma unroll
                for (int j = 0; j < 16; ++j) { gq[j] = qg[dd + j] * (0.08838834764831845f * LOG2E); gk[j] = kg[dd + j]; }
                for (int row = hw; row < MR; row += NHW) {
                    { bf16_t* qp = W.QB() + (size_t)row * 1024 + c0; const u32x4 a = __builtin_nontemporal_load((const u32x4*)qp), b2 = __builtin_nontemporal_load((const u32x4*)(qp + 8));
                      float v[16] = {bflo(a.x), bfhi(a.x), bflo(a.y), bfhi(a.y), bflo(a.z), bfhi(a.z), bflo(a.w), bfhi(a.w), bflo(b2.x), bfhi(b2.x), bflo(b2.y), bfhi(b2.y), bflo(b2.z), bfhi(b2.z), bflo(b2.w), bfhi(b2.w)};
                      float s = 0.f;
#pragma unroll
                      for (int j = 0; j < 16; ++j) s += v[j] * v[j];
                      s += __shfl_xor(s, 1); s += __shfl_xor(s, 2); s += __shfl_xor(s, 4);
                      const float r = __builtin_amdgcn_rsqf(s * (1.0f / 128.0f) + 1e-6f);
#pragma unroll
                      for (int j = 0; j < 16; ++j) v[j] = v[j] * r * gq[j];
                      st_bf16x8(qp, (f32x4){v[0], v[1], v[2], v[3]}, (f32x4){v[4], v[5], v[6], v[7]}); st_bf16x8(qp + 8, (f32x4){v[8], v[9], v[10], v[11]}, (f32x4){v[12], v[13], v[14], v[15]}); }
                    { const bf16_t* kp = W.KB() + (size_t)row * 1024 + c0; const u32x4 a = __builtin_nontemporal_load((const u32x4*)kp), b2 = __builtin_nontemporal_load((const u32x4*)(kp + 8));
                      float v[16] = {bflo(a.x), bfhi(a.x), bflo(a.y), bfhi(a.y), bflo(a.z), bfhi(a.z), bflo(a.w), bfhi(a.w), bflo(b2.x), bfhi(b2.x), bflo(b2.y), bfhi(b2.y), bflo(b2.z), bfhi(b2.z), bflo(b2.w), bfhi(b2.w)};
                      float s = 0.f;
#pragma unroll
                      for (int j = 0; j < 16; ++j) s += v[j] * v[j];
                      s += __shfl_xor(s, 1); s += __shfl_xor(s, 2); s += __shfl_xor(s, 4);
                      const float r = __builtin_amdgcn_rsqf(s * (1.0f / 128.0f) + 1e-6f);
#pragma unroll
                      for (int j = 0; j < 16; ++j) v[j] = v[j] * r * gk[j];
                      bf16_t* d16; float* d32 = nullptr;
                      if (row < MP) { const int b = row >> 11, t = row & 2047; d16 = W.KB() + (size_t)row * 1024 + c0;
                          if (t >= SEQ - BANDK) d32 = out + O_PBK + ((size_t)(l * NB + b) * BANDK + (t - (SEQ - BANDK))) * 1024 + c0; }
                      else { const int sr = row - MP, b = sr >> 4, t = sr & 15; d16 = W.KBS() + ((size_t)(l * NB + b) * KBS_ROWS + BANDK + t) * 1024 + c0; d32 = out + O_SBK + ((size_t)l * MS + sr) * 1024 + c0; }
                      st_bf16x8(d16, (f32x4){v[0], v[1], v[2], v[3]}, (f32x4){v[4], v[5], v[6], v[7]}); st_bf16x8(d16 + 8, (f32x4){v[8], v[9], v[10], v[11]}, (f32x4){v[12], v[13], v[14], v[15]});
                      if (d32) { *(f32x4*)d32 = (f32x4){v[0], v[1], v[2], v[3]}; *(f32x4*)(d32 + 4) = (f32x4){v[4], v[5], v[6], v[7]}; *(f32x4*)(d32 + 8) = (f32x4){v[8], v[9], v[10], v[11]}; *(f32x4*)(d32 + 12) = (f32x4){v[12], v[13], v[14], v[15]}; } }
                }
                if (l == 0) { LAS float* scr = (LAS float*)(lds + NSW * SSM_WAVE_BYTES + (wave - NSW) * 16640);
                    for (int it = hw; it < I_IN; it += NHW) weight_item(KA->in[9], KA->in[18], KA->in[23], KA->in[24], KA->in[25], KA->in[27], ws, 1, it, scr, lane); }
                else { convert_caches(KA->in[2], KA->in[3], KA->in[4], KA->in[5], W, 1, hw, NHW, 64);
                    LAS float* scr = (LAS float*)(lds + NSW * SSM_WAVE_BYTES + (wave - NSW) * 16640);
                    for (int it = I_IN + hw; it < I_L; it += NHW) weight_item(KA->in[9], KA->in[18], KA->in[23], KA->in[24], KA->in[25], KA->in[27], ws, 1, it, scr, lane); }
              } }
            SEAM(pb + 1);
        }
#endif
#ifndef NO_P2B
        if (IN(pb + 2)) {
            PHASE_BEGIN();
            for (int rep_ = 0; rep_ < ((DBG_DUP & 8) ? 2 : 1); ++rep_) {
            const int nit = (G == 256) ? (((vcu & 7) <= 1 || (vcu & 7) >= 6) ? 5 : 4) : (1152 + G - 1 - vcu) / G;
            for (int k = 0; k < nit; ++k) {
                int item;
                if (G == 256) { const int q = vcu & 7, bq = vcu >> 3;
                    if (k < 4) { const int second = k & 1, ty = k >> 1; item = ty * 512 + (second ? ((32 + bq) << 3) + (7 - q) : (bq << 3) + q); }
                    else item = 1024 + ((q == 0 || q == 7) ? 0 : 64) + ((q == 0 || q == 1) ? 0 : 32) + bq; }
                else item = vcu + k * G;
                att::Desc d;
                if (item < 1024) {
                    const int type = item < 512 ? 1 : 0, ii = item & 511, bh = ii >> 3, qb = ii & 7, b = bh >> 3, h = bh & 7;
                    const size_t row0 = (size_t)b * SEQ + 256 * qb;
                    d.Q = (type ? W.QC() : W.QB()) + row0 * 1024 + h * HD; d.K = (type ? W.KC() : W.KB()) + (size_t)b * SEQ * 1024 + h * HD; d.V = (type ? W.VC() : W.VB()) + (size_t)b * SEQ * 1024 + h * HD;
                    d.SZ = W.SZ() + row0 * 3072 + (type ? 2048 : 1024) + h * HD; d.Y = W.Y() + row0 * 3072 + (type ? 2048 : 1024) + h * HD;
                    d.bias = KA->in[22] + ((size_t)l * NH + h) * 257; d.qpos0 = 256 * qb; d.nvalid = 256; d.nkeys = SEQ;
                    ATT_DISPATCH(type, lds, d);
                    if ((DBG_DUP & 64) && type == 1) att::unit<1>(lds, d);
                    if ((DBG_DUP & 128) && type == 0) att::unit<0>(lds, d);
                } else {
                    const int type = item < 1088 ? 0 : 1, ii = (item - 1024) & 63, b = ii >> 3, h = ii & 7;
                    const size_t row0 = (size_t)MP + b * DSEQ;
                    d.Q = (type ? W.QC() : W.QB()) + row0 * 1024 + h * HD;
                    d.K = (type ? W.KCS() + (size_t)(l * NB + b) * KCS_ROWS * 1024 : W.KBS() + (size_t)(l * NB + b) * KBS_ROWS * 1024) + h * HD;
                    d.V = (type ? W.VCS() + (size_t)(l * NB + b) * KCS_ROWS * 1024 : W.VBS() + (size_t)(l * NB + b) * KBS_ROWS * 1024) + h * HD;
                    d.SZ = W.SZ() + row0 * 3072 + (type ? 2048 : 1024) + h * HD; d.Y = W.Y() + row0 * 3072 + (type ? 2048 : 1024) + h * HD;
                    d.bias = KA->in[22] + ((size_t)l * NH + h) * 257; d.qpos0 = type ? PASTL : BANDK; d.nvalid = DSEQ; d.nkeys = (type ? PASTL : BANDK) + DSEQ;
                    ATT_DISPATCH(type, lds, d);
                }
            }
#ifndef DBG_NOGLU
            __syncthreads();
            { pg8::Gemm g{MW, MW, MW};
              pg8::TileOrder<1> S; S.nM = MP / 256; S.nN = MW / 256; S.nwg = S.nM * S.nN; S.G = G; S.c = bx;
              S.A = (const char*)W.YG(); S.B = (const char*)(ws + WS_WGLU) + (size_t)l * MW * MW * 2; S.atile = 256ull * MW * 2; S.btile = 256ull * MW * 2; S.arep = 0; S.brep = 0;
              pg8::QuarterOrder<1> SQ; SQ.pmq = MP / 256; SQ.nN = S.nN; SQ.G = G; SQ.c = (vcu + G / 2) % G; SQ.A = S.A; SQ.B = S.B; SQ.atile = S.atile; SQ.btile = S.btile; SQ.arep = 0; SQ.brep = 0; SQ.bhalf = 128ull * MW * 2;
              EpiGlu E{KA->in[19] + (size_t)l * MW, W};
              pg8::gemm_phase<false>(lds, g, S, E);
              pg8::gemm_quarter(lds, g, SQ, E); }
#endif
            }
            SEAM(pb + 2);
        }
#endif
#ifndef NO_P3
        if (IN(pb + 3)) {
            PHASE_BEGIN();
            pg8::Gemm g{3 * MW, MW, MW};
            pg8::TileOrder<3> S; S.nM = MP / 256; S.nN = DM / 256; S.nwg = S.nM * S.nN; S.G = G; S.c = bx;
            S.A = (const char*)W.Y(); S.B = (const char*)(ws + WS_WBR) + (size_t)l * 3 * DM * MW * 2; S.atile = 256ull * 3 * MW * 2; S.btile = 256ull * MW * 2; S.arep = (size_t)MW * 2; S.brep = (size_t)DM * MW * 2;
            pg8::QuarterOrder<3> SQ; SQ.pmq = MP / 256; SQ.nN = S.nN; SQ.G = G; SQ.c = bx; SQ.A = S.A; SQ.B = S.B; SQ.atile = S.atile; SQ.btile = S.btile; SQ.arep = S.arep; SQ.brep = S.brep; SQ.bhalf = 128ull * MW * 2;
            EpiBr E{W};
            pg8::gemm_phase<false>(lds, g, S, E);
            pg8::gemm_quarter(lds, g, SQ, E);
            if (DBG_DUP & 16) { pg8::gemm_phase<false>(lds, g, S, E); pg8::gemm_quarter(lds, g, SQ, E); }
            if (DBG_DUP & 2048) { EpiNull EN{(float*)(ws + WS_CTL + 49152)}; pg8::gemm_phase<false>(lds, g, S, EN); }
            if (DBG_DUP & 4096) pg8::gemm_phase<false>(lds, g, S, E);
            SEAM(pb + 3);
        }
#endif
#ifndef NO_P4
        if (IN(pb + 4)) {
            PHASE_BEGIN();
            pg8::Gemm g{DM, DM, DM};
            pg8::TileOrder<1> S; S.nM = MP / 256; S.nN = DM / 256; S.nwg = S.nM * S.nN; S.G = G; S.c = bx;
            S.A = (const char*)W.MX(); S.B = (const char*)(ws + WS_WOUT) + (size_t)l * DM * DM * 2; S.atile = 256ull * DM * 2; S.btile = 256ull * DM * 2; S.arep = 0; S.brep = 0;
            pg8::QuarterOrder<1> SQ; SQ.pmq = MP / 256; SQ.nN = S.nN; SQ.G = G; SQ.c = bx; SQ.A = S.A; SQ.B = S.B; SQ.atile = S.atile; SQ.btile = S.btile; SQ.arep = 0; SQ.brep = 0; SQ.bhalf = 128ull * DM * 2;
            EpiOut E{KA->in[0], KA->in[1], KA->in[8] + DM, out, W, l};
            pg8::gemm_phase<false>(lds, g, S, E);
            pg8::gemm_quarter(lds, g, SQ, E);
            if ((DBG_DUP & 32) && l == 1) { pg8::gemm_phase<false>(lds, g, S, E); pg8::gemm_quarter(lds, g, SQ, E); }
            SEAM(pb + 4);
        }
#endif
    }
    if (DBG_CLK && bx == 0 && tid == 0) { const long long dc = ((long long*)(ws + WS_CTL + 32768))[0], dr = ((long long*)(ws + WS_CTL + 32768))[1];
        const long long ticks = (DBG_CLK == 2) ? dc : (dc * 10000) / (dr > 0 ? dr : 1); const long long t0 = wall_clock64(); while (wall_clock64() - t0 < ticks) __builtin_amdgcn_s_sleep(8); }
#undef IN
#undef SEAM
}

extern "C" void kernel_launch(void* const* d_in, const int* in_sizes, int n_in, void* d_out, int out_size, void* d_ws, size_t ws_size, hipStream_t stream) {
    static int grid = 0;
    if (grid == 0) {
        if ((size_t)out_size != O_END) fprintf(stderr, "kernel_launch: note: out_size %d, built for %zu\n", out_size, (size_t)O_END);
        if (n_in != 28 || ws_size < WS_END) { fprintf(stderr, "kernel_launch: shape mismatch n_in %d ws %zu (want %zu)\n", n_in, ws_size, (size_t)WS_END); grid = -1; return; }
        int dev = 0, cus = 0;
        if (hipGetDevice(&dev) != hipSuccess || hipDeviceGetAttribute(&cus, hipDeviceAttributeMultiprocessorCount, dev) != hipSuccess) { grid = -1; return; }
        if (hipFuncSetAttribute((const void*)hse_fwd, hipFuncAttributeMaxDynamicSharedMemorySize, LDS_BYTES) != hipSuccess) { fprintf(stderr, "kernel_launch: hipFuncSetAttribute failed\n"); grid = -1; return; }
        int per_cu = 0;
        if (hipOccupancyMaxActiveBlocksPerMultiprocessor(&per_cu, (const void*)hse_fwd, NWAVES * 64, LDS_BYTES) != hipSuccess || per_cu < 1) fprintf(stderr, "kernel_launch: occupancy query says %d\n", per_cu);
        (void)hipGetLastError();
        grid = cus;
    }
    if (grid < 0) return;
    if (hipMemsetAsync((char*)d_ws + WS_CTL, 0, CTL_ZERO_BYTES, stream) != hipSuccess) return;
    Args a{};
    for (int i = 0; i < 28; ++i) a.in[i] = (const float*)d_in[i];
    a.out = (float*)d_out; a.ws = (unsigned char*)d_ws;
#if MK_SPLIT
    for (int p = 0; p < N_PHASES; ++p) { a.ph_lo = p; a.ph_hi = p + 1; hipLaunchKernelGGL(hse_fwd, dim3(grid), dim3(NWAVES * 64), LDS_BYTES, stream, a); }
#else
    a.ph_lo = 0; a.ph_hi = N_PHASES; hipLaunchKernelGGL(hse_fwd, dim3(grid), dim3(NWAVES * 64), LDS_BYTES, stream, a);
#endif
}
```

```cpp
#include <hip/hip_runtime.h>
#include <cstdio>
#include <cstdint>

#ifndef DBG_DUP
#define DBG_DUP 0
#endif
#ifndef DBG_CLK
#define DBG_CLK 0
#endif
#ifndef MK_SPLIT
#define MK_SPLIT 0
#endif

#define LAS __attribute__((address_space(3)))
#define GAS __attribute__((address_space(1)))
#define CAS __attribute__((address_space(4)))
typedef unsigned short bf16_t;
typedef short bf16x8 __attribute__((ext_vector_type(8)));
typedef short s16x4 __attribute__((ext_vector_type(4)));
typedef float f32x2 __attribute__((ext_vector_type(2)));
typedef float f32x4 __attribute__((ext_vector_type(4)));
typedef float f32x16 __attribute__((ext_vector_type(16)));
typedef unsigned u32x2 __attribute__((ext_vector_type(2)));
typedef unsigned u32x4 __attribute__((ext_vector_type(4)));
typedef __bf16 bf16x2_t __attribute__((ext_vector_type(2)));

constexpr int DM = 4096, SEQ = 2048, NB = 8, DSEQ = 16, MW = 1024, HD = 128, NH = 8, NG = 64, NST = 64, NIN = 22528;
constexpr int MP = NB * SEQ, MS = NB * DSEQ, MR = MP + MS, MROWS = 16640;
constexpr int KCS_ROWS = 2112, KBS_ROWS = 576, BANDK = 512, PASTL = 2048;
constexpr float LOG2E = 1.4426950408889634f, LN2 = 0.6931471805599453f;
constexpr size_t O_YP = 0, O_YS = O_YP + (size_t)MP * DM, O_PSBK = O_YS + (size_t)MS * DM, O_PSBV = O_PSBK + 2ull * MP * MW, O_PBK = O_PSBV + 2ull * MP * MW,
                 O_PBV = O_PBK + 2ull * NB * BANDK * MW, O_PSR = O_PBV + 2ull * NB * BANDK * MW, O_PSI = O_PSR + 2ull * NB * NG * NST, O_SSBK = O_PSI + 2ull * NB * NG * NST,
                 O_SSBV = O_SSBK + 2ull * MS * MW, O_SBK = O_SSBV + 2ull * MS * MW, O_SBV = O_SBK + 2ull * MS * MW, O_SSR = O_SBV + 2ull * MS * MW, O_SSI = O_SSR + 2ull * NB * NG * NST,
                 O_END = O_SSI + 2ull * NB * NG * NST;
constexpr size_t MiB = 1u << 20;
constexpr size_t R1K = (size_t)MROWS * 1024 * 2;
constexpr size_t WS_CTL = 0, CTL_ZERO_BYTES = 1 * MiB;
constexpr size_t WS_SSQ1 = 65536;
constexpr size_t WS_SSQ0 = 1 * MiB;
constexpr size_t WS_ABAR = WS_SSQ0 + 128 * 1024;
constexpr size_t WS_BMT = WS_ABAR + 64 * 1024;
constexpr size_t WS_CMT = WS_BMT + 512 * 1024;
constexpr size_t WS_WIN = 4 * MiB;
constexpr size_t WS_WGLU = WS_WIN + 2ull * NIN * DM * 2;
constexpr size_t WS_WBR = WS_WGLU + 2ull * MW * MW * 2;
constexpr size_t WS_WOUT = WS_WBR + 6ull * DM * MW * 2;
constexpr size_t WS_A0 = WS_WOUT + 2ull * DM * DM * 2;
constexpr size_t WS_U = WS_A0 + 4 * R1K;
constexpr size_t WS_SZ = WS_U + R1K;
constexpr size_t WS_QB = WS_SZ + 3 * R1K, WS_KB = WS_QB + R1K, WS_VB = WS_KB + R1K, WS_QC = WS_VB + R1K, WS_KC = WS_QC + R1K, WS_VC = WS_KC + R1K;
constexpr size_t WS_G = WS_VC + R1K;
constexpr size_t WS_YG = WS_G + 12 * R1K;
constexpr size_t WS_Y = WS_YG + R1K;
constexpr size_t WS_MX = WS_Y + 3 * R1K;
constexpr size_t WS_Y0 = WS_MX + 4 * R1K;
constexpr size_t WS_KCS = WS_Y0 + (size_t)MROWS * DM * 4;
constexpr size_t WS_VCS = WS_KCS + 16ull * KCS_ROWS * 1024 * 2;
constexpr size_t WS_KBS = WS_VCS + 16ull * KCS_ROWS * 1024 * 2;
constexpr size_t WS_VBS = WS_KBS + 16ull * KBS_ROWS * 1024 * 2;
constexpr size_t WS_END = WS_VBS + 16ull * KBS_ROWS * 1024 * 2;
static_assert(WS_END < 2900ull * MiB && WS_CMT + 512 * 1024 <= WS_WIN && (WS_WGLU % 256) == 0 && (R1K % 256) == 0, "d_ws map");
constexpr int CW_BAR = 4096;
constexpr int SCR_BYTES = 147456;
constexpr int LDSCTL_OFF = SCR_BYTES, MISC_OFF = LDSCTL_OFF + 320;
constexpr int LDS_BYTES = 155648;
constexpr int NWAVES = 8;

__device__ __forceinline__ unsigned pk2(float lo, float hi) { f32x2 v = {lo, hi}; bf16x2_t b = __builtin_convertvector(v, bf16x2_t); return __builtin_bit_cast(unsigned, b); }
__device__ __forceinline__ float bflo(unsigned w) { return __uint_as_float(w << 16); }
__device__ __forceinline__ float bfhi(unsigned w) { return __uint_as_float(w & 0xffff0000u); }
__device__ __forceinline__ float bf2f(bf16_t h) { return __uint_as_float((unsigned)h << 16); }
__device__ __forceinline__ bf16_t f2bf(float f) { return (bf16_t)(pk2(f, 0.f) & 0xffffu); }
__device__ __forceinline__ float ex2(float x) { return __builtin_amdgcn_exp2f(x); }
__device__ __forceinline__ float sigmoidf_(float x) { return __builtin_amdgcn_rcpf(1.0f + ex2(-x * LOG2E)); }
#define LDS_WAIT() asm volatile("s_waitcnt lgkmcnt(0)" ::: "memory")
#define VM_WAIT() asm volatile("s_waitcnt vmcnt(0)" ::: "memory")

namespace pg8 {
constexpr int BM = 256, BK = 64, HALF = 128, HTB = HALF * BK * 2  , STAGE_BYTES = 8 * HTB, NXCD = 8, WGM = 8;
__host__ __device__ __forceinline__ int lds_byte(int r, int c) { const int st = (r >> 4) * 2 + (c >> 5), rr = r & 15, cc = c & 31, ob = rr * 64 + cc * 2; return st * 1024 + (ob ^ (((ob >> 9) & 1) << 5)); }
__host__ __device__ __forceinline__ void stage_rc(int b, int& R, int& C) { const int st = b / 1024, sb = b % 1024, swz = sb ^ (((sb >> 9) & 1) << 5); R = (st >> 1) * 16 + swz / 64; C = (st & 1) * 32 + (swz % 64) / 2; }
__host__ __device__ __forceinline__ int perm32(int rho) { const int n = rho >> 4, i = rho & 15; return 8 * (i >> 2) + 4 * n + (i & 3); }

struct Unit { const char* a; const char* b; int pm, pn, aux, q, cs; };
struct Gemm { int lda, ldb, K; };

template <int REP> struct TileOrder {
    int nM, nN, nwg, G, c; const char* A; const char* B; size_t atile, btile, arep, brep; int fixed = 0;
    __device__ __forceinline__ bool next(int i, Unit& u) const {
        const int ti = i / REP, r = i - ti * REP;
        const long L = (long)ti * G + c; if (L >= nwg) return false;
        int wgid = (int)L; { const int q = nwg / NXCD, rr = nwg % NXCD, xcd = wgid % NXCD, off = wgid / NXCD; wgid = (xcd < rr ? xcd * (q + 1) : rr * (q + 1) + (xcd - rr) * q) + off; }
        const int nig = WGM * nN, gid = wgid / nig, fm = gid * WGM, gsz = (nM - fm) < WGM ? (nM - fm) : WGM;
        u.pm = fm + ((wgid % nig) % gsz); u.pn = (wgid % nig) / gsz; u.aux = r; u.q = 0; u.cs = 0;
        u.a = A + (size_t)((fixed & 1) ? 0 : u.pm) * atile + (size_t)r * arep; u.b = B + (size_t)((fixed & 2) ? 0 : u.pn) * btile + (size_t)r * brep; return true;
    }
};

template <int REP> struct QuarterOrder {
    int pmq, nN, G, c; const char* A; const char* B; size_t atile, btile, arep, brep, bhalf;
    __device__ __forceinline__ bool next(int i, Unit& u) const {
        const int ti = i / REP, r = i - ti * REP;
        const int L = ti * G + c; if (L >= 2 * nN) return false;
        u.pm = pmq; u.pn = L >> 1; u.aux = r; u.q = 1; u.cs = (L & 1) * HALF;
        u.a = A + (size_t)pmq * atile + (size_t)r * arep; u.b = B + (size_t)u.pn * btile + (size_t)(L & 1) * bhalf + (size_t)r * brep; return true;
    }
};

template <bool Q, class Epi, class Sched>
__device__ __forceinline__ void gemm_phase(LAS unsigned char* lds, const Gemm g, const Sched& S, const Epi& E) {
    int tid = threadIdx.x; asm volatile("" : "+v"(tid));
    const int wid = __builtin_amdgcn_readfirstlane(tid >> 6), lane = tid & 63, wr = wid >> 2, wc = wid & 3, fr = lane & 15, fq = lane >> 4;
    const int K = g.K, nt = K / BK;
    unsigned voffA[2], voffB[2];
#pragma unroll
    for (int i = 0; i < 2; ++i) { int R, C; stage_rc(tid * 16 + i * 8192, R, C); const int Rb = Epi::PERM ? ((R & ~31) + perm32(R & 31)) : R;
        voffA[i] = (unsigned)(R * g.lda + C) * 2u; voffB[i] = (unsigned)(Rb * g.ldb + C) * 2u; }
    const size_t kstep = (size_t)(BK * 2);
    const size_t hstepA = Q ? 0 : (size_t)HALF * g.lda * 2, hstepB = Q ? 0 : (size_t)HALF * g.ldb * 2;
    const unsigned ldsw = (unsigned)wid * 1024u;
    const int aoff = lds_byte(wr * 64 + fr, fq * 8), boff = lds_byte(wc * 32 + fr, fq * 8);
#define PG8_SA(b, h) (((b) * 2 + (h)) * HTB)
#define PG8_SB(b, h) ((4 + (b) * 2 + (h)) * HTB)
#define PG8_STAGE(bufoff, gbase, voff) do { _Pragma("unroll") for (int _i = 0; _i < 2; ++_i) \
        __builtin_amdgcn_global_load_lds((const unsigned*)((const char*)(gbase) + (voff)[_i]), (LAS unsigned*)(lds + (bufoff) + ldsw + _i * 8192), 16, 0, 0); } while (0)
#define PG8_LDA(dst, b, h) do { _Pragma("unroll") for (int m = 0; m < 4; ++m) _Pragma("unroll") for (int k = 0; k < 2; ++k) dst[m][k] = *(const LAS bf16x8*)(lds + PG8_SA(b, h) + aoff + m * 2048 + k * 1024); } while (0)
#define PG8_LDB(dst, b, h) do { _Pragma("unroll") for (int n = 0; n < 2; ++n) _Pragma("unroll") for (int k = 0; k < 2; ++k) dst[n][k] = *(const LAS bf16x8*)(lds + PG8_SB(b, h) + boff + n * 2048 + k * 1024); } while (0)
#define PG8_MMA(ai, bj, At, Bt) do { __builtin_amdgcn_s_setprio(1); _Pragma("unroll") for (int m = 0; m < 4; ++m) _Pragma("unroll") for (int n = 0; n < 2; ++n) _Pragma("unroll") for (int k = 0; k < 2; ++k) \
        acc[ai][bj][m][n] = __builtin_amdgcn_mfma_f32_16x16x32_bf16(Bt[n][k], At[m][k], acc[ai][bj][m][n], 0, 0, 0); __builtin_amdgcn_s_setprio(0); } while (0)
#define PG8_WAIT_V(n) asm volatile("s_waitcnt vmcnt(" #n ")" ::: "memory")
#define PG8_WAIT_L(n) asm volatile("s_waitcnt lgkmcnt(" #n ")" ::: "memory")
#define PG8_BAR __builtin_amdgcn_s_barrier()
#define PG8_SCHED __builtin_amdgcn_sched_barrier(0)
    Unit cur, nxt; int ui = 0;
    if (!S.next(0, cur)) return;
    f32x4 acc[2][2][4][2];
#pragma unroll
    for (int a = 0; a < 2; ++a)
#pragma unroll
        for (int b = 0; b < 2; ++b)
#pragma unroll
            for (int m = 0; m < 4; ++m)
#pragma unroll
                for (int n = 0; n < 2; ++n) acc[a][b][m][n] = (f32x4){0.f, 0.f, 0.f, 0.f};
    bf16x8 At[4][2], B0[2][2], B1[2][2];
    const char* cA = cur.a; const char* cB = cur.b;
    PG8_STAGE(PG8_SB(0, 0), cB, voffB); PG8_STAGE(PG8_SB(0, 1), cB + hstepB, voffB); PG8_STAGE(PG8_SA(0, 0), cA, voffA); PG8_STAGE(PG8_SA(0, 1), cA + hstepA, voffA);
    if (wr == 1) PG8_BAR;
    PG8_WAIT_V(2); PG8_BAR;
    PG8_STAGE(PG8_SB(1, 0), cB + kstep, voffB); PG8_STAGE(PG8_SA(1, 0), cA + kstep, voffA); PG8_STAGE(PG8_SB(1, 1), cB + hstepB + kstep, voffB);
    PG8_WAIT_V(6); PG8_BAR;
    for (;;) {
        const bool has_next = S.next(ui + 1, nxt);
        const char* nA = has_next ? nxt.a : cA; const char* nB = has_next ? nxt.b : cB;
        for (int t = 0; t < nt; t += 2) {
            const bool last = (t == nt - 2);
            const char* a1 = cA + (size_t)(t + 1) * kstep;
            const char* a2 = last ? nA : cA + (size_t)(t + 2) * kstep; const char* b2 = last ? nB : cB + (size_t)(t + 2) * kstep;
            const char* a3 = a2 + kstep; const char* b3 = b2 + kstep;
            PG8_LDB(B0, 0, 0); if (!Q) PG8_LDB(B1, 0, 1); PG8_SCHED; PG8_LDA(At, 0, 0); PG8_STAGE(PG8_SA(1, 1), a1 + hstepA, voffA);
            PG8_WAIT_V(8); PG8_WAIT_L(0); PG8_BAR; PG8_MMA(0, 0, At, B0); if (!Q) PG8_MMA(0, 1, At, B1); PG8_BAR; PG8_SCHED;
            if (!Q) PG8_LDA(At, 0, 1); PG8_STAGE(PG8_SB(0, 0), b2, voffB); PG8_STAGE(PG8_SB(0, 1), b2 + hstepB, voffB); PG8_STAGE(PG8_SA(0, 0), a2, voffA);
            PG8_WAIT_V(8); PG8_WAIT_L(0); PG8_BAR; if (!Q) { PG8_MMA(1, 0, At, B0); PG8_MMA(1, 1, At, B1); } PG8_BAR; PG8_SCHED;
            PG8_LDB(B0, 1, 0); if (!Q) PG8_LDB(B1, 1, 1); PG8_SCHED; PG8_LDA(At, 1, 0); PG8_STAGE(PG8_SA(0, 1), a2 + hstepA, voffA);
            PG8_WAIT_V(8); PG8_WAIT_L(0); PG8_BAR; PG8_MMA(0, 0, At, B0); if (!Q) PG8_MMA(0, 1, At, B1); PG8_BAR; PG8_SCHED;
            if (!Q) PG8_LDA(At, 1, 1); PG8_STAGE(PG8_SB(1, 0), b3, voffB); PG8_STAGE(PG8_SB(1, 1), b3 + hstepB, voffB); PG8_STAGE(PG8_SA(1, 0), a3, voffA);
            PG8_WAIT_V(8); PG8_WAIT_L(0); PG8_BAR; if (!Q) { PG8_MMA(1, 0, At, B0); PG8_MMA(1, 1, At, B1); } PG8_BAR; PG8_SCHED;
        }
        if (wr == 0) PG8_BAR;
        E.template run<Q>(acc, cur, wr, wc, fr, fq);
        if (!has_next) break;
        if (!E.keep(cur)) {
#pragma unroll
        for (int a = 0; a < 2; ++a)
#pragma unroll
            for (int b = 0; b < 2; ++b)
#pragma unroll
                for (int m = 0; m < 4; ++m)
#pragma unroll
                    for (int n = 0; n < 2; ++n) acc[a][b][m][n] = (f32x4){0.f, 0.f, 0.f, 0.f};
        }
        cur = nxt; cA = nA; cB = nB; ++ui;
        if (wr == 1) PG8_BAR;
    }
    PG8_WAIT_V(0);
    PG8_BAR;
#undef PG8_SA
#undef PG8_SB
#undef PG8_STAGE
#undef PG8_LDA
#undef PG8_LDB
#undef PG8_MMA
#undef PG8_WAIT_V
#undef PG8_WAIT_L
#undef PG8_BAR
#undef PG8_SCHED
}

template <class Epi, class Sched>
__device__ __forceinline__ void gemm_quarter(LAS unsigned char* lds, const Gemm g, const Sched& S, const Epi& E) {
    int tid = threadIdx.x; asm volatile("" : "+v"(tid));
    const int wid = __builtin_amdgcn_readfirstlane(tid >> 6), lane = tid & 63, wr = wid >> 2, wc = wid & 3, fr = lane & 15, fq = lane >> 4;
    const int nt = g.K / BK;
    unsigned voffA[2], voffB[2];
#pragma unroll
    for (int i = 0; i < 2; ++i) { int R, C; stage_rc(tid * 16 + i * 8192, R, C); const int Rb = Epi::PERM ? ((R & ~31) + perm32(R & 31)) : R;
        voffA[i] = (unsigned)(R * g.lda + C) * 2u; voffB[i] = (unsigned)(Rb * g.ldb + C) * 2u; }
    const unsigned ldsw = (unsigned)wid * 1024u;
    const int aoff = lds_byte(wr * 64 + fr, fq * 8), boff = lds_byte(wc * 32 + fr, fq * 8);
#define GQ_STAGE(slot, ga, gb) do { _Pragma("unroll") for (int _i = 0; _i < 2; ++_i) { \
        __builtin_amdgcn_global_load_lds((const unsigned*)((const char*)(ga) + voffA[_i]), (LAS unsigned*)(lds + (slot) * 32768 + ldsw + _i * 8192), 16, 0, 0); \
        __builtin_amdgcn_global_load_lds((const unsigned*)((const char*)(gb) + voffB[_i]), (LAS unsigned*)(lds + (slot) * 32768 + 16384 + ldsw + _i * 8192), 16, 0, 0); } } while (0)
    f32x4 acc[2][2][4][2];
    Unit cur; bool kept = false;
    for (int ui = 0; S.next(ui, cur); ++ui) {
        if (!kept) {
#pragma unroll
            for (int m = 0; m < 4; ++m)
#pragma unroll
                for (int n = 0; n < 2; ++n) acc[0][0][m][n] = (f32x4){0.f, 0.f, 0.f, 0.f};
        }
        const char* cA = cur.a; const char* cB = cur.b;
#pragma unroll
        for (int s4 = 0; s4 < 4; ++s4) GQ_STAGE(s4, cA + (size_t)s4 * (BK * 2), cB + (size_t)s4 * (BK * 2));
        for (int t = 0; t < nt; ++t) {
            const int slot = t & 3;
            asm volatile("s_waitcnt vmcnt(12)" ::: "memory");
            __builtin_amdgcn_s_barrier();
            bf16x8 At[4][2], B0[2][2];
#pragma unroll
            for (int n = 0; n < 2; ++n)
#pragma unroll
                for (int k = 0; k < 2; ++k) B0[n][k] = *(const LAS bf16x8*)(lds + slot * 32768 + 16384 + boff + n * 2048 + k * 1024);
#pragma unroll
            for (int m = 0; m < 4; ++m)
#pragma unroll
                for (int k = 0; k < 2; ++k) At[m][k] = *(const LAS bf16x8*)(lds + slot * 32768 + aoff + m * 2048 + k * 1024);
            asm volatile("s_waitcnt lgkmcnt(0)" ::: "memory");
            __builtin_amdgcn_s_barrier();
            const int tn = (t + 4 < nt) ? t + 4 : 0;
            GQ_STAGE(slot, cA + (size_t)tn * (BK * 2), cB + (size_t)tn * (BK * 2));
#pragma unroll
            for (int m = 0; m < 4; ++m)
#pragma unroll
                for (int n = 0; n < 2; ++n)
#pragma unroll
                    for (int k = 0; k < 2; ++k) acc[0][0][m][n] = __builtin_amdgcn_mfma_f32_16x16x32_bf16(B0[n][k], At[m][k], acc[0][0][m][n], 0, 0, 0);
        }
        asm volatile("s_waitcnt vmcnt(0)" ::: "memory");
        __builtin_amdgcn_s_barrier();
        E.template run<true>(acc, cur, wr, wc, fr, fq);
        kept = E.keep(cur);
    }
#undef GQ_STAGE
}
}

template <class T> __device__ __forceinline__ T* asg(T* p) { return (T*)(__attribute__((address_space(1))) T*)(unsigned long long)p; }
struct WsPtrs {
    unsigned char* ws;
#define WSP(name, T, off) __device__ __forceinline__ T* name() const { return (T*)(ws + (off)); }
    WSP(U, bf16_t, WS_U) WSP(SZ, bf16_t, WS_SZ) WSP(QB, bf16_t, WS_QB) WSP(KB, bf16_t, WS_KB) WSP(VB, bf16_t, WS_VB) WSP(QC, bf16_t, WS_QC) WSP(KC, bf16_t, WS_KC) WSP(VC, bf16_t, WS_VC)
    WSP(G, bf16_t, WS_G) WSP(YG, bf16_t, WS_YG) WSP(Y, bf16_t, WS_Y) WSP(MX, bf16_t, WS_MX) WSP(A0, bf16_t, WS_A0) WSP(KCS, bf16_t, WS_KCS) WSP(VCS, bf16_t, WS_VCS) WSP(KBS, bf16_t, WS_KBS) WSP(VBS, bf16_t, WS_VBS)
    WSP(Y0, float, WS_Y0) WSP(SSQ0, float, WS_SSQ0) WSP(SSQ1, float, WS_SSQ1)
#undef WSP
};
#ifndef G_NATIVE
#define G_NATIVE 1
#endif
#if G_NATIVE
__device__ __forceinline__ size_t g_slot(int pm, int gt, int wv, int ai, int m, int bjx, int lane) { return ((((((size_t)pm * 48 + gt) * 8 + wv) * 2 + ai) * 4 + m) * 2 + bjx) * 64 + lane; }
#else
__device__ __forceinline__ size_t g_slot(int pm, int gt, int wv, int ai, int m, int bjx, int lane) { const int row = pm * 256 + ai * 128 + (wv >> 2) * 64 + m * 16 + (lane & 15); return (size_t)row * 1536 + gt * 32 + bjx * 16 + (wv & 3) * 4 + (lane >> 4); }
#endif
typedef unsigned short u16x2 __attribute__((ext_vector_type(2)));
__device__ __forceinline__ unsigned pkmin_u16(unsigned a, unsigned b) { return __builtin_bit_cast(unsigned, __builtin_elementwise_min(__builtin_bit_cast(u16x2, a), __builtin_bit_cast(u16x2, b))); }
__device__ __forceinline__ void st_bf16x8_cap(bf16_t* p, f32x4 v0, f32x4 v1) {
    u32x4 w; w.x = pkmin_u16(pk2(v0[0], v0[1]), 0x71497149u); w.y = pkmin_u16(pk2(v0[2], v0[3]), 0x71497149u); w.z = pkmin_u16(pk2(v1[0], v1[1]), 0x71497149u); w.w = pkmin_u16(pk2(v1[2], v1[3]), 0x71497149u); __builtin_nontemporal_store(w, (u32x4*)p);
}
__device__ __forceinline__ void st_bf16x8_nt(bf16_t* p, f32x4 v0, f32x4 v1) {
    u32x4 w; w.x = pk2(v0[0], v0[1]); w.y = pk2(v0[2], v0[3]); w.z = pk2(v1[0], v1[1]); w.w = pk2(v1[2], v1[3]); __builtin_nontemporal_store(w, (u32x4*)p);
}
__device__ __forceinline__ void st_bf16x8(bf16_t* p, f32x4 v0, f32x4 v1) {
    u32x4 w; w.x = pk2(v0[0], v0[1]); w.y = pk2(v0[2], v0[3]); w.z = pk2(v1[0], v1[1]); w.w = pk2(v1[2], v1[3]); *(u32x4*)p = w;
}
struct Epi1 {
    static constexpr bool PERM = true;
    __device__ __forceinline__ bool keep(const pg8::Unit&) const { return false; }
    const float* ssq; const float* gate_b; float* out; WsPtrs W; int layer;
    template <bool Q> __device__ __forceinline__ void run(f32x4 (&acc)[2][2][4][2], const pg8::Unit& u, int wr, int wc, int fr, int fq) const {
        constexpr int NAI = Q ? 1 : 2, NBJ = Q ? 1 : 2;
        const int sec = u.pn >> 2;
        const int colt = (u.pn & 3) * 256 + u.cs + wc * 32 + 8 * fq;
        int mode = 0, ld = 1024, coff = 0, special = 0; float scale = 1.f; bf16_t* base;
        if (sec >= 10) { mode = 2; base = W.G(); ld = 12288; coff = (sec - 10) * 1024; }
        else if (sec == 1 || sec == 5 || sec == 9) { mode = 1; base = W.SZ(); ld = 3072; coff = (sec == 1) ? 0 : (sec == 5 ? 1024 : 2048); }
        else { base = (sec == 0) ? W.U() : (sec == 2) ? W.QB() : (sec == 3) ? W.KB() : (sec == 4) ? W.VB() : (sec == 6) ? W.QC() : (sec == 7) ? W.KC() : W.VC();
               if (sec == 6) scale = 0.08838834764831845f * LOG2E; special = (sec == 4 || sec == 7 || sec == 8) ? sec : 0; }
        f32x4 bv[NBJ][2];
#pragma unroll
        for (int bj = 0; bj < NBJ; ++bj)
#pragma unroll
            for (int n = 0; n < 2; ++n) bv[bj][n] = (mode == 2) ? *(const f32x4*)(gate_b + coff + colt + bj * 128 + 4 * n) * (-LOG2E) : (f32x4){0.f, 0.f, 0.f, 0.f};
        const int l = layer, row0 = u.pm * 256 + wr * 64 + fr;
        float rs[NAI][4];
#pragma unroll
        for (int ai = 0; ai < NAI; ++ai)
#pragma unroll
            for (int m = 0; m < 4; ++m) rs[ai][m] = ssq[row0 + ai * 128 + m * 16];
#pragma unroll
        for (int ai = 0; ai < NAI; ++ai)
#pragma unroll
            for (int m = 0; m < 4; ++m) rs[ai][m] = __builtin_amdgcn_rsqf(rs[ai][m] * (1.0f / 4096.0f) + 1e-6f) * scale;
        if (mode == 2) scale = -LOG2E;
#pragma unroll
        for (int ai = 0; ai < NAI; ++ai)
#pragma unroll
            for (int m = 0; m < 4; ++m) {
                const int row = row0 + ai * 128 + m * 16;
                bf16_t* d16 = base + (size_t)row * ld + coff + colt; float* d32 = nullptr;
                if (special) {
                    if (!Q) { const int b = row >> 11, t = row & 2047;
                        if (special == 7) d32 = out + O_PSBK + ((size_t)l * MP + row) * 1024 + colt;
                        else if (special == 8) d32 = out + O_PSBV + ((size_t)l * MP + row) * 1024 + colt;
                        else if (t >= SEQ - BANDK) d32 = out + O_PBV + ((size_t)(l * NB + b) * BANDK + (t - (SEQ - BANDK))) * 1024 + colt;
                    } else { const int sr = row - MP, b = sr >> 4, t = sr & 15;
                        if (special == 7) { d16 = W.KCS() + ((size_t)(l * NB + b) * KCS_ROWS + PASTL + t) * 1024 + colt; d32 = out + O_SSBK + ((size_t)l * MS + sr) * 1024 + colt; }
                        else if (special == 8) { d16 = W.VCS() + ((size_t)(l * NB + b) * KCS_ROWS + PASTL + t) * 1024 + colt; d32 = out + O_SSBV + ((size_t)l * MS + sr) * 1024 + colt; }
                        else { d16 = W.VBS() + ((size_t)(l * NB + b) * KBS_ROWS + BANDK + t) * 1024 + colt; d32 = out + O_SBV + ((size_t)l * MS + sr) * 1024 + colt; }
                    }
                }
#pragma unroll
                for (int bj = 0; bj < NBJ; ++bj) {
                    if (mode == 2) {
                        const float nrs = rs[ai][m] * scale;
                        f32x4 v0 = acc[ai][bj][m][0] * nrs + bv[bj][0], v1 = acc[ai][bj][m][1] * nrs + bv[bj][1];
#pragma unroll
                        for (int j = 0; j < 4; ++j) { v0[j] = ex2(v0[j]); v1[j] = ex2(v1[j]); }
                        v0 = v0 + 1.0f; v1 = v1 + 1.0f;
                        st_bf16x8_cap(W.G() + 8 * g_slot(u.pm, u.pn - 40, wr * 4 + wc, ai, m, bj + (u.cs >> 7), fq * 16 + fr), v0, v1);
                    } else {
                    f32x4 v0 = acc[ai][bj][m][0] * rs[ai][m], v1 = acc[ai][bj][m][1] * rs[ai][m];
                    if (mode == 1) {
#pragma unroll
                        for (int j = 0; j < 4; ++j) { v0[j] = v0[j] * sigmoidf_(v0[j]); v1[j] = v1[j] * sigmoidf_(v1[j]); } }
                    if (mode == 1 || sec == 4 || sec >= 6) st_bf16x8_nt(d16 + bj * 128, v0, v1); else st_bf16x8(d16 + bj * 128, v0, v1);
                    if (d32) { __builtin_nontemporal_store(v0, (f32x4*)(d32 + bj * 128)); __builtin_nontemporal_store(v1, (f32x4*)(d32 + bj * 128 + 4)); }
                    }
                }
            }
    }
};
struct EpiNull {
    static constexpr bool PERM = true;
    __device__ __forceinline__ bool keep(const pg8::Unit&) const { return false; }
    float* sink;
    template <bool Q> __device__ __forceinline__ void run(f32x4 (&acc)[2][2][4][2], const pg8::Unit& u, int wr, int wc, int fr, int fq) const {
        float s = 0.f;
#pragma unroll
        for (int ai = 0; ai < 2; ++ai)
#pragma unroll
            for (int bj = 0; bj < 2; ++bj)
#pragma unroll
                for (int m = 0; m < 4; ++m)
#pragma unroll
                    for (int n = 0; n < 2; ++n) s += (acc[ai][bj][m][n][0] + acc[ai][bj][m][n][1]) + (acc[ai][bj][m][n][2] + acc[ai][bj][m][n][3]);
        if (s == 1.2345e30f) sink[u.pm + u.pn + wr + wc + fr + fq] = s;
    }
};
struct EpiGlu {
    static constexpr bool PERM = true;
    __device__ __forceinline__ bool keep(const pg8::Unit&) const { return false; }
    const float* bglu; WsPtrs W;
    template <bool Q> __device__ __forceinline__ void run(f32x4 (&acc)[2][2][4][2], const pg8::Unit& u, int wr, int wc, int fr, int fq) const {
        constexpr int NAI = Q ? 1 : 2, NBJ = Q ? 1 : 2;
        const int colt = u.pn * 256 + u.cs + wc * 32 + 8 * fq, row0 = u.pm * 256 + wr * 64 + fr;
        f32x4 bv[NBJ][2];
#pragma unroll
        for (int bj = 0; bj < NBJ; ++bj)
#pragma unroll
            for (int n = 0; n < 2; ++n) bv[bj][n] = *(const f32x4*)(bglu + colt + bj * 128 + 4 * n);
#pragma unroll
        for (int aim = 0; aim < 2 * NAI; ++aim) { const int ai = aim >> 1, mb = (aim & 1) * 2;
            u32x4 yg[4][NBJ], sz[4][NBJ];
#pragma unroll
            for (int m = mb; m < mb + 2; ++m)
#pragma unroll
                for (int bj = 0; bj < NBJ; ++bj) { const int row = row0 + ai * 128 + m * 16, col = colt + bj * 128;
                    yg[m][bj] = __builtin_nontemporal_load((const u32x4*)(W.YG() + (size_t)row * 1024 + col)); sz[m][bj] = __builtin_nontemporal_load((const u32x4*)(W.SZ() + (size_t)row * 3072 + col)); }
#pragma unroll
            for (int m = mb; m < mb + 2; ++m)
#pragma unroll
                for (int bj = 0; bj < NBJ; ++bj) { const int row = row0 + ai * 128 + m * 16, col = colt + bj * 128;
                    const u32x4 y = yg[m][bj], z = sz[m][bj];
                    f32x4 v0 = acc[ai][bj][m][0] + bv[bj][0], v1 = acc[ai][bj][m][1] + bv[bj][1];
                    v0[0] = bflo(y.x) * sigmoidf_(v0[0]) * bflo(z.x); v0[1] = bfhi(y.x) * sigmoidf_(v0[1]) * bfhi(z.x);
                    v0[2] = bflo(y.y) * sigmoidf_(v0[2]) * bflo(z.y); v0[3] = bfhi(y.y) * sigmoidf_(v0[3]) * bfhi(z.y);
                    v1[0] = bflo(y.z) * sigmoidf_(v1[0]) * bflo(z.z); v1[1] = bfhi(y.z) * sigmoidf_(v1[1]) * bfhi(z.z);
                    v1[2] = bflo(y.w) * sigmoidf_(v1[2]) * bflo(z.w); v1[3] = bfhi(y.w) * sigmoidf_(v1[3]) * bfhi(z.w);
                    st_bf16x8(W.Y() + (size_t)row * 3072 + col, v0, v1); }
        }
    }
};
struct EpiBr {
    static constexpr bool PERM = true;
    WsPtrs W;
    __device__ __forceinline__ bool keep(const pg8::Unit& u) const { return u.aux < 2; }
    template <bool Q> __device__ __forceinline__ void run(f32x4 (&acc)[2][2][4][2], const pg8::Unit& u, int wr, int wc, int fr, int fq) const {
        constexpr int NAI = Q ? 1 : 2, NBJ = Q ? 1 : 2;
        const int colt = u.pn * 256 + u.cs + wc * 32 + 8 * fq, br = u.aux, row0 = u.pm * 256 + wr * 64 + fr;
        if (br < 2) {
#pragma unroll
            for (int ai = 0; ai < NAI; ++ai) { constexpr int mb = 0;
                u32x4 gn[4][NBJ], gd[4][NBJ];
#pragma unroll
                for (int m = mb; m < mb + 4; ++m)
#pragma unroll
                    for (int bj = 0; bj < NBJ; ++bj) { const int bjx = bj + (u.cs >> 7), wv = wr * 4 + wc, ln = fq * 16 + fr;
                        gn[m][bj] = __builtin_nontemporal_load((const u32x4*)(W.G() + 8 * g_slot(u.pm, br * 16 + u.pn, wv, ai, m, bjx, ln))); gd[m][bj] = __builtin_nontemporal_load((const u32x4*)(W.G() + 8 * g_slot(u.pm, (br + 1) * 16 + u.pn, wv, ai, m, bjx, ln))); }
#pragma unroll
                for (int m = mb; m < mb + 4; ++m)
#pragma unroll
                    for (int bj = 0; bj < NBJ; ++bj) { const u32x4 a = gn[m][bj], d = gd[m][bj]; f32x4& v0 = acc[ai][bj][m][0]; f32x4& v1 = acc[ai][bj][m][1];
#define RAT(de, nu) ((nu) * __builtin_amdgcn_rcpf(de))
                        v0[0] *= RAT(bflo(a.x), bflo(d.x)); v0[1] *= RAT(bfhi(a.x), bfhi(d.x)); v0[2] *= RAT(bflo(a.y), bflo(d.y)); v0[3] *= RAT(bfhi(a.y), bfhi(d.y));
                        v1[0] *= RAT(bflo(a.z), bflo(d.z)); v1[1] *= RAT(bfhi(a.z), bfhi(d.z)); v1[2] *= RAT(bflo(a.w), bflo(d.w)); v1[3] *= RAT(bfhi(a.w), bfhi(d.w));
#undef RAT
                    }
            }
        } else {
#pragma unroll
            for (int ai = 0; ai < NAI; ++ai) {
                u32x4 g2[4][NBJ];
#pragma unroll
                for (int m = 0; m < 4; ++m)
#pragma unroll
                    for (int bj = 0; bj < NBJ; ++bj) g2[m][bj] = __builtin_nontemporal_load((const u32x4*)(W.G() + 8 * g_slot(u.pm, 32 + u.pn, wr * 4 + wc, ai, m, bj + (u.cs >> 7), fq * 16 + fr)));
#pragma unroll
                for (int m = 0; m < 4; ++m)
#pragma unroll
                    for (int bj = 0; bj < NBJ; ++bj) { const u32x4 g = g2[m][bj]; const f32x4 v0 = acc[ai][bj][m][0], v1 = acc[ai][bj][m][1];
                        f32x4 o0, o1;
                        o0[0] = v0[0] * __builtin_amdgcn_rcpf(bflo(g.x)); o0[1] = v0[1] * __builtin_amdgcn_rcpf(bfhi(g.x)); o0[2] = v0[2] * __builtin_amdgcn_rcpf(bflo(g.y)); o0[3] = v0[3] * __builtin_amdgcn_rcpf(bfhi(g.y));
                        o1[0] = v1[0] * __builtin_amdgcn_rcpf(bflo(g.z)); o1[1] = v1[1] * __builtin_amdgcn_rcpf(bfhi(g.z)); o1[2] = v1[2] * __builtin_amdgcn_rcpf(bflo(g.w)); o1[3] = v1[3] * __builtin_amdgcn_rcpf(bfhi(g.w));
                        st_bf16x8(W.MX() + (size_t)(row0 + ai * 128 + m * 16) * 4096 + colt + bj * 128, o0, o1); }
            }
        }
    }
};
struct EpiOut {
    static constexpr bool PERM = false;
    __device__ __forceinline__ bool keep(const pg8::Unit&) const { return false; }
    const float* xp; const float* xs; const float* ng1; float* out; WsPtrs W; int layer;
    template <bool Q> __device__ __forceinline__ void run(f32x4 (&acc)[2][2][4][2], const pg8::Unit& u, int wr, int wc, int fr, int fq) const {
        constexpr int NAI = Q ? 1 : 2, NBJ = Q ? 1 : 2;
        const int colt = u.pn * 256 + u.cs + wc * 32 + 4 * fq, row0 = u.pm * 256 + wr * 64 + fr;
        f32x4 gg[NBJ][2];
#pragma unroll
        for (int bj = 0; bj < NBJ; ++bj)
#pragma unroll
            for (int n = 0; n < 2; ++n) gg[bj][n] = (layer == 0) ? *(const f32x4*)(ng1 + colt + bj * 128 + n * 16) : (f32x4){0.f, 0.f, 0.f, 0.f};
#pragma unroll
        for (int aim = 0; aim < 2 * NAI; ++aim) { const int ai = aim >> 1, mb = (aim & 1) * 2;
            f32x4 rv[4][NBJ][2];
#pragma unroll
            for (int m = mb; m < mb + 2; ++m) { const int row = row0 + ai * 128 + m * 16;
                const float* res = (layer == 0) ? (Q ? xs + (size_t)(row - MP) * DM : xp + (size_t)row * DM) : W.Y0() + (size_t)row * DM;
#pragma unroll
                for (int bj = 0; bj < NBJ; ++bj)
#pragma unroll
                    for (int n = 0; n < 2; ++n) rv[m][bj][n] = __builtin_nontemporal_load((const f32x4*)(res + colt + bj * 128 + n * 16)); }
#pragma unroll
            for (int m = mb; m < mb + 2; ++m) { const int row = row0 + ai * 128 + m * 16;
                float* dst = (layer == 0) ? W.Y0() + (size_t)row * DM : (Q ? out + O_YS + (size_t)(row - MP) * DM : out + O_YP + (size_t)row * DM);
                float ss = 0.f;
#pragma unroll
                for (int bj = 0; bj < NBJ; ++bj)
#pragma unroll
                    for (int n = 0; n < 2; ++n) { const int col = colt + bj * 128 + n * 16;
                        const f32x4 y = acc[ai][bj][m][n] + rv[m][bj][n];
                        __builtin_nontemporal_store(y, (f32x4*)(dst + col));
                        if (layer == 0) { const f32x4 g4 = gg[bj][n]; ss += (y[0] * y[0] + y[1] * y[1]) + (y[2] * y[2] + y[3] * y[3]);
                            u32x2 w; w.x = pk2(y[0] * g4[0], y[1] * g4[1]); w.y = pk2(y[2] * g4[2], y[3] * g4[3]); *(u32x2*)(W.A0() + (size_t)row * DM + col) = w; } }
                if (layer == 0) { ss += __shfl_xor(ss, 16); ss += __shfl_xor(ss, 32); if (fq == 0) atomicAdd(W.SSQ1() + row, ss); }
            }
        }
    }
};

#define XB_TMO      128
#define XB_XCNT(j)  (256  + 64 * (j))
#define XB_XSUB(j)  (1280 + 64 * (j))
#define XB_XGEN(j)  (2304 + 64 * (j))
#define XB_TOP      3328
#define XB_TOPGEN   3392
#define XCD_BAR_WORDS 3456
#define XB_SPIN_CAP (1u << 22)
__device__ __forceinline__ unsigned xb_ld(unsigned* p)              { return __hip_atomic_load(p, __ATOMIC_RELAXED, __HIP_MEMORY_SCOPE_AGENT); }
__device__ __forceinline__ unsigned xb_add(unsigned* p, unsigned v) { return __hip_atomic_fetch_add(p, v, __ATOMIC_RELAXED, __HIP_MEMORY_SCOPE_AGENT); }
__device__ __forceinline__ unsigned xb_xcc_id() { return (unsigned)__builtin_amdgcn_s_getreg((3 << 11) | 20) & 0xFu; }
#define XB_SPIN(cond, bar) do { unsigned _sp = 0; while (cond) { __builtin_amdgcn_s_sleep(1); \
    if ((++_sp & 255u) == 0u) { if (xb_ld(&(bar)[XB_TMO])) break; if (_sp > XB_SPIN_CAP) { atomicAdd(&(bar)[XB_TMO], 1u); break; } } } } while (0)
struct XcdBarrier { unsigned* bar; unsigned x; volatile LAS unsigned* st; };
__device__ __forceinline__ XcdBarrier xcd_barrier_post(unsigned* bar, volatile LAS unsigned* st) {
    XcdBarrier b; b.bar = bar; b.x = xb_xcc_id(); b.st = st;
    if (threadIdx.x == 0) (void)xb_add(&bar[XB_XCNT(b.x)], 1u);
    return b;
}
__device__ __forceinline__ void xcd_barrier_complete(unsigned* bar, unsigned x, unsigned& nloc, unsigned& nx) {
    const unsigned G = gridDim.x * gridDim.y * gridDim.z;
    unsigned sum, cnt, mine, sp = 0u;
    for (;;) {
        sum = 0u; cnt = 0u; mine = 0u;
#pragma unroll
        for (unsigned j = 0; j < 16; ++j) { const unsigned c = xb_ld(&bar[XB_XCNT(j)]); sum += c; cnt += (c > 0u) ? 1u : 0u; mine = (j == x) ? c : mine; }
        if (sum == G) break;
        __builtin_amdgcn_s_sleep(1);
        if ((++sp & 255u) == 0u) { if (xb_ld(&bar[XB_TMO])) break; if (sp > XB_SPIN_CAP) { atomicAdd(&bar[XB_TMO], 1u); break; } }
    }
    nloc = mine > 0u ? mine : 1u; nx = cnt > 0u ? cnt : 1u;
}
__device__ __forceinline__ void xcd_barrier(const XcdBarrier& b) {
    asm volatile("s_waitcnt vmcnt(0)" ::: "memory");
    __syncthreads();
    if (threadIdx.x == 0) {
        unsigned* bar = b.bar;
        __builtin_amdgcn_s_waitcnt(0);
        unsigned nloc = b.st[0], nx = b.st[1];
        if (nloc == 0u) { xcd_barrier_complete(bar, b.x, nloc, nx); b.st[0] = nloc; b.st[1] = nx; }
        const unsigned old = xb_add(&bar[XB_XSUB(b.x)], 1u);
        const unsigned gen = old / nloc;
        if (old + 1u == (gen + 1u) * nloc) {
            __builtin_amdgcn_fence(__ATOMIC_RELEASE, "agent");
            asm volatile("s_waitcnt vmcnt(0)" ::: "memory");
            const unsigned og = xb_add(&bar[XB_TOP], 1u);
            const unsigned tg = og / nx;
            if (og + 1u == (tg + 1u) * nx) xb_add(&bar[XB_TOPGEN], 1u);
            else XB_SPIN(xb_ld(&bar[XB_TOPGEN]) == tg, bar);
            __builtin_amdgcn_fence(__ATOMIC_ACQUIRE, "agent");
            xb_add(&bar[XB_XGEN(b.x)], 1u);
            asm volatile("s_waitcnt vmcnt(0)" ::: "memory");
        } else {
            XB_SPIN(xb_ld(&bar[XB_XGEN(b.x)]) == gen, bar);
            __builtin_amdgcn_fence(__ATOMIC_ACQUIRE, "agent");
            asm volatile("s_waitcnt vmcnt(0)" ::: "memory");
        }
    }
    __syncthreads();
}

__device__ __forceinline__ void transpose_item(const float* W, int K, int N, bf16_t* WT, LAS float* scr, int item, int lane_) {
    int lane = lane_; asm volatile("" : "+v"(lane));
    const int sup = item >> 3, sub = item & 7, nsup = N / 128, kb4 = sup / nsup, nb2 = sup - kb4 * nsup, kb = 4 * kb4 + (sub >> 1), nb = 2 * nb2 + (sub & 1), k0 = 64 * kb, n0 = 64 * nb;
    const int kq = lane >> 4, nq = lane & 15;
#pragma unroll 4
    for (int i = 0; i < 16; ++i) { const int kk = 4 * i + kq; const f32x4 v = __builtin_nontemporal_load((const f32x4*)(W + (size_t)(k0 + kk) * N + n0 + 4 * nq));
        LAS float* s = scr + kk * 65 + 4 * nq; s[0] = v[0]; s[1] = v[1]; s[2] = v[2]; s[3] = v[3]; }
    LDS_WAIT();
    const int c = lane & 7, nl = lane >> 3;
#pragma unroll
    for (int j = 0; j < 8; ++j) { const int n = 8 * j + nl; const LAS float* s = scr + (8 * c) * 65 + n;
        u32x4 o; o.x = pk2(s[0 * 65], s[1 * 65]); o.y = pk2(s[2 * 65], s[3 * 65]); o.z = pk2(s[4 * 65], s[5 * 65]); o.w = pk2(s[6 * 65], s[7 * 65]);
        *(u32x4*)(WT + (size_t)(n0 + n) * K + k0 + 8 * c) = o; }
    LDS_WAIT();
}
__device__ __forceinline__ float wave_sum(float v) {
#pragma unroll
    for (int o = 1; o < 64; o <<= 1) v += __shfl_xor(v, o);
    return v;
}
__device__ __forceinline__ void xrow_to_a0(const float* xrow, const float* g, bf16_t* orow, float* ssq, int lane) {
    float s = 0.f;
#pragma unroll 4
    for (int j = 0; j < 16; ++j) { const f32x4 v = __builtin_nontemporal_load((const f32x4*)xrow + lane + 64 * j), gg = *((const f32x4*)g + lane + 64 * j);
        s += (v[0] * v[0] + v[1] * v[1]) + (v[2] * v[2] + v[3] * v[3]);
        u32x2 w; w.x = pk2(v[0] * gg[0], v[1] * gg[1]); w.y = pk2(v[2] * gg[2], v[3] * gg[3]); *((u32x2*)orow + lane + 64 * j) = w; }
    s = wave_sum(s);
    if (lane == 0) *ssq = s;
}

constexpr int SSM_PITCH = 132, SSM_TP = 36, SSM_WAVE_BYTES = 128 * SSM_TP * 4 + 1024;
static_assert(128 * SSM_TP >= 32 * SSM_PITCH, "h image fits the Bu^T region");
template <int NT> __device__ __forceinline__ void ssm_unit(LAS float* S, const unsigned char* ws, const float* dskip_l, int l, int g, const bf16_t* U, bf16_t* YG, int row0, int ntok,
                                         const float* h0re, const float* h0im, float* ore, float* oim, int lane_) {
    int lane = lane_; asm volatile("" : "+v"(lane));
    const int r32 = lane & 31, hi = lane >> 5, p16 = lane & 15, q4 = lane >> 4;
    LAS bf16_t* Us = (LAS bf16_t*)(S + 128 * SSM_TP);
    const f32x2 ab = *((const f32x2*)(ws + WS_ABAR) + (size_t)(l * NG + g) * NST + lane);
    const float ar = ab[0], ai = ab[1];
    bf16x8 bmf[4], cmf[4];
    const bf16_t* BMT = (const bf16_t*)(ws + WS_BMT) + (size_t)(l * NG + g) * 128 * 16;
    const bf16_t* CMT = (const bf16_t*)(ws + WS_CMT) + (size_t)(l * NG + g) * 16 * 128;
#pragma unroll
    for (int nb = 0; nb < 4; ++nb) bmf[nb] = *(const bf16x8*)(BMT + (size_t)(32 * nb + r32) * 16 + 8 * hi);
#pragma unroll
    for (int kb = 0; kb < 4; ++kb) cmf[kb] = *(const bf16x8*)(CMT + (size_t)p16 * 128 + 32 * kb + 8 * q4);
    const float dsk = dskip_l[16 * g + p16];
    float hr = h0re ? h0re[lane] : 0.f, hm = h0im ? h0im[lane] : 0.f;
    const bf16_t* up = U + (size_t)(row0 + r32) * 1024 + 16 * g + 8 * hi;
    bf16x8 uf = __builtin_nontemporal_load((const bf16x8*)up);
    for (int t0 = 0; t0 < ntok; t0 += 32) {
        const bf16x8 ucur = uf;
        if (t0 + 32 < ntok) uf = __builtin_nontemporal_load((const bf16x8*)(up + (size_t)(t0 + 32) * 1024));
        *(LAS bf16x8*)(Us + r32 * 16 + 8 * hi) = ucur;
#pragma unroll
        for (int nb = 0; nb < 4; ++nb) {
            f32x16 acc = {};
            acc = __builtin_amdgcn_mfma_f32_32x32x16_bf16(ucur, bmf[nb], acc, 0, 0, 0);
#pragma unroll
            for (int q = 0; q < 4; ++q) *(LAS f32x4*)(S + (32 * nb + r32) * SSM_TP + 8 * q + 4 * hi) = (f32x4){acc[4 * q], acc[4 * q + 1], acc[4 * q + 2], acc[4 * q + 3]};
        }
        LDS_WAIT();
        f32x4 br[NT / 4], bi[NT / 4];
#pragma unroll
        for (int t4 = 0; t4 < NT / 4; ++t4) { br[t4] = *(const LAS f32x4*)(S + lane * SSM_TP + 4 * t4); bi[t4] = *(const LAS f32x4*)(S + (64 + lane) * SSM_TP + 4 * t4); }
        LDS_WAIT();
#pragma unroll
        for (int t = 0; t < NT; ++t) {
            const float nr = ar * hr - ai * hm + br[t >> 2][t & 3], ni = ar * hm + ai * hr + bi[t >> 2][t & 3];
            hr = nr; hm = ni;
            S[t * SSM_PITCH + lane] = hr; S[t * SSM_PITCH + 64 + lane] = hm;
        }
        LDS_WAIT();
#pragma unroll
        for (int th = 0; th < NT / 16; ++th) {
            f32x4 ya = {0.f, 0.f, 0.f, 0.f};
#pragma unroll
            for (int kb = 0; kb < 4; ++kb) {
                const LAS float* sp = S + (16 * th + p16) * SSM_PITCH + 32 * kb + 8 * q4;
                const f32x4 a0 = *(const LAS f32x4*)sp, a1 = *(const LAS f32x4*)(sp + 4);
                u32x4 w; w.x = pk2(a0[0], a0[1]); w.y = pk2(a0[2], a0[3]); w.z = pk2(a1[0], a1[1]); w.w = pk2(a1[2], a1[3]);
                ya = __builtin_amdgcn_mfma_f32_16x16x32_bf16(__builtin_bit_cast(bf16x8, w), cmf[kb], ya, 0, 0, 0);
            }
#pragma unroll
            for (int j = 0; j < 4; ++j) {
                const int tl = 16 * th + 4 * q4 + j, tt = t0 + tl;
                const float y = ya[j] + dsk * bf2f(Us[tl * 16 + p16]);
                const float ge = y * __builtin_amdgcn_rcpf(1.0f + ex2(-2.3022081985f * y * (1.0f + 0.044715f * y * y)));
                YG[(size_t)(row0 + tt) * 1024 + 16 * g + p16] = f2bf(ge);
            }
        }
        LDS_WAIT();
    }
    ore[lane] = hr; oim[lane] = hm;
}

namespace att {
constexpr int L_V = 0, L_K = 16384, L_BUF = 32768, L_WS = 65536, L_BIAS = 67584, L_FLAG = 68864, L_OST = 73728;
#define KSWZ(row, colB) ((row) * 256 + ((colB) ^ (((row) & 7) << 4)))
#define SBAR() __builtin_amdgcn_sched_barrier(0)
__device__ __forceinline__ int crow(int r, int hi) { return (r & 3) + 8 * (r >> 2) + 4 * hi; }
__device__ __forceinline__ int v_st(int k, int c) { const int kk = (k & ~0xC) | ((k & 4) << 1) | ((k & 8) >> 1); return ((kk >> 3) * 4 + (c >> 5)) * 512 + ((kk & 7) * 32 + (c & 31)) * 2; }
__device__ __forceinline__ int v_rd_base(int lane) { return ((lane & 3) << 3) | (((lane >> 2) & 3) << 6) | (((lane >> 4) & 1) << 5) | (((lane >> 5) & 1) << 8); }
constexpr int v_rd_off(int d0, int ks, int half) { return d0 * 512 + ks * 4096 + half * 2048; }
template <int OFF> __device__ __forceinline__ s16x4 tr_read(int vb) {
    s16x4 r; asm volatile("ds_read_b64_tr_b16 %0, %1 offset:%2" : "=&v"(r) : "v"(vb), "i"(OFF) : "memory"); return r;
}
template <int D0> __device__ __forceinline__ void pv_one(f32x16& od, int vb, bf16x8 pa0, bf16x8 pa1, bf16x8 pa2, bf16x8 pa3) {
    const s16x4 l0 = tr_read<v_rd_off(D0, 0, 0)>(vb), h0 = tr_read<v_rd_off(D0, 0, 1)>(vb), l1 = tr_read<v_rd_off(D0, 1, 0)>(vb), h1 = tr_read<v_rd_off(D0, 1, 1)>(vb);
    const s16x4 l2 = tr_read<v_rd_off(D0, 2, 0)>(vb), h2 = tr_read<v_rd_off(D0, 2, 1)>(vb), l3 = tr_read<v_rd_off(D0, 3, 0)>(vb), h3 = tr_read<v_rd_off(D0, 3, 1)>(vb);
    asm volatile("s_waitcnt lgkmcnt(0)" ::: "memory"); SBAR();
#define PK(L, H) (bf16x8){L[0], L[1], L[2], L[3], H[0], H[1], H[2], H[3]}
    od = __builtin_amdgcn_mfma_f32_32x32x16_bf16(pa0, PK(l0, h0), od, 0, 0, 0);
    od = __builtin_amdgcn_mfma_f32_32x32x16_bf16(pa1, PK(l1, h1), od, 0, 0, 0);
    od = __builtin_amdgcn_mfma_f32_32x32x16_bf16(pa2, PK(l2, h2), od, 0, 0, 0);
    od = __builtin_amdgcn_mfma_f32_32x32x16_bf16(pa3, PK(l3, h3), od, 0, 0, 0);
#undef PK
}
__device__ __forceinline__ void pv_d0(f32x16* o, int vb, bf16x8 pa0, bf16x8 pa1, bf16x8 pa2, bf16x8 pa3) {
    pv_one<0>(o[0], vb, pa0, pa1, pa2, pa3); pv_one<1>(o[1], vb, pa0, pa1, pa2, pa3); pv_one<2>(o[2], vb, pa0, pa1, pa2, pa3); pv_one<3>(o[3], vb, pa0, pa1, pa2, pa3);
}
__device__ __forceinline__ void qkt(f32x16& p0, f32x16& p1, const LAS unsigned char* Ks, const LAS unsigned char* Qs, int r32, int hi) {
    p0 = f32x16{}; p1 = f32x16{};
    bf16x8 b0[2], b1[2], q[2];
    { const int cb = (hi * 8) * 2; b0[0] = *(const LAS bf16x8*)(Ks + KSWZ(r32, cb)); b1[0] = *(const LAS bf16x8*)(Ks + KSWZ(32 + r32, cb)); q[0] = *(const LAS bf16x8*)(Qs + KSWZ(r32, cb)); }
#pragma unroll
    for (int d0 = 0; d0 < 8; ++d0) { const int c = d0 & 1, n = c ^ 1;
        if (d0 < 7) { const int cb = ((d0 + 1) * 16 + hi * 8) * 2;
            b0[n] = *(const LAS bf16x8*)(Ks + KSWZ(r32, cb)); b1[n] = *(const LAS bf16x8*)(Ks + KSWZ(32 + r32, cb)); q[n] = *(const LAS bf16x8*)(Qs + KSWZ(r32, cb)); }
        if (d0 < 7) asm volatile("s_waitcnt lgkmcnt(3)" ::: "memory"); else asm volatile("s_waitcnt lgkmcnt(0)" ::: "memory");
        SBAR();
        p0 = __builtin_amdgcn_mfma_f32_32x32x16_bf16(b0[c], q[c], p0, 0, 0, 0);
        p1 = __builtin_amdgcn_mfma_f32_32x32x16_bf16(b1[c], q[c], p1, 0, 0, 0);
        SBAR(); }
}
__device__ __forceinline__ void qkt_half(f32x16& p, const LAS unsigned char* Ks, const LAS unsigned char* Qs, int r32, int hi, int half) {
    p = f32x16{};
    bf16x8 b0[2], q[2];
    { const int cb = (hi * 8) * 2; b0[0] = *(const LAS bf16x8*)(Ks + KSWZ(32 * half + r32, cb)); q[0] = *(const LAS bf16x8*)(Qs + KSWZ(r32, cb)); }
#pragma unroll
    for (int d0 = 0; d0 < 8; ++d0) { const int c = d0 & 1, n = c ^ 1;
        if (d0 < 7) { const int cb = ((d0 + 1) * 16 + hi * 8) * 2; b0[n] = *(const LAS bf16x8*)(Ks + KSWZ(32 * half + r32, cb)); q[n] = *(const LAS bf16x8*)(Qs + KSWZ(r32, cb)); }
        if (d0 < 7) asm volatile("s_waitcnt lgkmcnt(2)" ::: "memory"); else asm volatile("s_waitcnt lgkmcnt(0)" ::: "memory");
        SBAR();
        p = __builtin_amdgcn_mfma_f32_32x32x16_bf16(b0[c], q[c], p, 0, 0, 0);
        SBAR(); }
}
#define PK4(P, BASE, OUT) do { unsigned a0 = pk2(P[BASE + 0], P[BASE + 1]), a1 = pk2(P[BASE + 2], P[BASE + 3]);   \
    unsigned b0 = pk2(P[BASE + 4], P[BASE + 5]), b1 = pk2(P[BASE + 6], P[BASE + 7]);                              \
    auto r0 = __builtin_amdgcn_permlane32_swap(a0, b0, false, false); auto r1 = __builtin_amdgcn_permlane32_swap(a1, b1, false, false); \
    u32x4 w = {r0[0], r1[0], r0[1], r1[1]}; OUT = __builtin_bit_cast(bf16x8, w); } while (0)
__device__ __forceinline__ float swap_max(float v) { auto rr = __builtin_amdgcn_permlane32_swap(__float_as_uint(v), __float_as_uint(v), false, false); return fmaxf(__uint_as_float(rr[0]), __uint_as_float(rr[1])); }
__device__ __forceinline__ float swap_add(float v) { auto rr = __builtin_amdgcn_permlane32_swap(__float_as_uint(v), __float_as_uint(v), false, false); return __uint_as_float(rr[0]) + __uint_as_float(rr[1]); }

struct Desc {
    const bf16_t* Q;
    const bf16_t* K; const bf16_t* V;
    const bf16_t* SZ; bf16_t* Y;
    const float* bias;
    int qpos0, nvalid, nkeys;
};
template <int TYPE>
__device__ __forceinline__ void unit(LAS unsigned char* lds, const Desc& d) {
    int tid = threadIdx.x; asm volatile("" : "+v"(tid));
    const int wid = __builtin_amdgcn_readfirstlane(tid >> 6), lane = tid & 63, r32 = lane & 31, hi = lane >> 5;
    LAS float* wsf = (LAS float*)(lds + L_WS) + wid * 64;
    LAS float* biasL = (LAS float*)(lds + L_BIAS);
    volatile LAS unsigned* flags = (volatile LAS unsigned*)(lds + L_FLAG);
    const bool wvalid = (32 * wid < d.nvalid);
    const int qpos = d.qpos0 + 32 * wid + r32;
    const int cw = (d.qpos0 + 32 * wid) >> 6;
    const bool rowinvalid = (32 * wid + r32) >= d.nvalid;
    int t_lo, t_hi;
    if (TYPE == 0) { const int c0 = d.qpos0 >> 6; t_lo = c0 - 8 > 0 ? c0 - 8 : 0; t_hi = c0 + 3; const int tk = (d.nkeys - 1) >> 6; if (t_hi > tk) t_hi = tk; }
    else { t_lo = 0; t_hi = (d.qpos0 + 255) >> 6; const int tk = (d.nkeys - 1) >> 6; if (t_hi > tk) t_hi = tk; }
    __syncthreads();
    if (TYPE == 0) { for (int i = tid; i < 257; i += 512) biasL[i] = d.bias[i] * LOG2E; }
    if (TYPE == 1) { if (tid < 16) flags[tid] = (32 * (tid & 7) < d.nvalid) ? 0u : 1u; }
    LAS unsigned char* Ql = lds + L_OST + wid * 8192;
    if (wvalid) {
#pragma unroll
        for (int d0 = 0; d0 < 8; ++d0) { const bf16x8 qv = __builtin_nontemporal_load((const bf16x8*)(d.Q + (size_t)(32 * wid + r32) * 1024 + d0 * 16 + hi * 8)); *(LAS bf16x8*)(Ql + KSWZ(r32, (d0 * 16 + hi * 8) * 2)) = qv; }
    }
    const int sr = tid >> 4, sc = (tid & 15) * 8, vst0 = v_st(sr, sc), vst1 = v_st(32 + sr, sc), kst0 = KSWZ(sr, sc * 2), kst1 = KSWZ(32 + sr, sc * 2);
    const int vbase = (int)(unsigned)(uintptr_t)(lds + L_V) + v_rd_base(lane);
    bf16x8 sv0, sv1, sk0, sk1;
#define SLOAD(T_) do { const size_t k0_ = (size_t)(T_) * 64; sv0 = *(const bf16x8*)(d.V + (k0_ + sr) * 1024 + sc); sv1 = *(const bf16x8*)(d.V + (k0_ + 32 + sr) * 1024 + sc); \
        sk0 = *(const bf16x8*)(d.K + (k0_ + sr) * 1024 + sc); sk1 = *(const bf16x8*)(d.K + (k0_ + 32 + sr) * 1024 + sc); } while (0)
    f32x16 o[4]; o[0] = f32x16{}; o[1] = f32x16{}; o[2] = f32x16{}; o[3] = f32x16{};
    float m_reg = -1e30f, l_reg = 0.f, R = 0.f; bool wdone = !wvalid;
    bf16x8 T00, T01;
    if (TYPE == 1) {
#pragma unroll
        for (int e = 0; e < 8; ++e) { const int j0 = 8 * hi + e; T00[e] = (j0 > r32) ? (short)0x3F80 : (short)0; T01[e] = (16 + j0 > r32) ? (short)0x3F80 : (short)0; }
    }
    const int step = (TYPE == 0) ? 1 : -1, nT = t_hi - t_lo + 1;
    int T = (TYPE == 0) ? t_lo : t_hi;
#define SWRITE(B_) do { LAS unsigned char* vb_ = lds + (B_) * L_BUF + L_V; LAS unsigned char* kb_ = lds + (B_) * L_BUF + L_K; \
        *(LAS bf16x8*)(vb_ + vst0) = sv0; *(LAS bf16x8*)(vb_ + vst1) = sv1; *(LAS bf16x8*)(kb_ + kst0) = sk0; *(LAS bf16x8*)(kb_ + kst1) = sk1; } while (0)
    SLOAD(T); SWRITE(0);
    if (nT > 1) SLOAD(T + step);
    __syncthreads();
    if (wid < 4) __builtin_amdgcn_s_setprio(1);
    for (int it = 0; it < nT; ++it, T += step) {
        const int cur = it & 1;
        if (TYPE == 1) { volatile LAS unsigned* fl = flags + 8 * (cur ^ 1); const unsigned f = fl[0] & fl[1] & fl[2] & fl[3] & fl[4] & fl[5] & fl[6] & fl[7]; if (f) break; }
        if (it + 1 < nT) SWRITE(cur ^ 1);
        if (it + 2 < nT) SLOAD(T + 2 * step);
        const LAS unsigned char* Kl = lds + cur * L_BUF + L_K; const int vb0 = vbase + cur * L_BUF;
        if (TYPE == 0) {
            if (wvalid && T >= cw - 8 && T <= cw) {
                f32x16 p0, p1; qkt(p0, p1, Kl, Ql, r32, hi);
                const int dc = cw - T;
                if (dc >= 3) { const float bf = biasL[256];
#pragma unroll
                    for (int r = 0; r < 16; ++r) { p0[r] += bf; p1[r] += bf; } }
                else { const int relb = qpos - 64 * T + 128;
#pragma unroll
                    for (int r = 0; r < 16; ++r) { int i0 = relb - crow(r, hi); int i1 = i0 - 32; i0 = i0 < 0 ? 0 : (i0 > 256 ? 256 : i0); i1 = i1 < 0 ? 0 : (i1 > 256 ? 256 : i1); p0[r] += biasL[i0]; p1[r] += biasL[i1]; } }
                const bool needmask = (64 * T + 63 >= d.nkeys);
                if (needmask) {
#pragma unroll
                    for (int r = 0; r < 16; ++r) { const int kp = 64 * T + crow(r, hi); if (kp >= d.nkeys) p0[r] = -1e30f; if (kp + 32 >= d.nkeys) p1[r] = -1e30f; } }
                float pmax = p0[0];
#pragma unroll
                for (int r = 1; r < 16; ++r) pmax = fmaxf(pmax, p0[r]);
#pragma unroll
                for (int r = 0; r < 16; ++r) pmax = fmaxf(pmax, p1[r]);
                pmax = swap_max(pmax);
                float alpha = 1.f; const bool grow = __any(pmax > m_reg + 8.0f);
                if (grow) { const float mx = fmaxf(m_reg, pmax); alpha = ex2(m_reg - mx); m_reg = mx; }
                const float mn = m_reg;
#pragma unroll
                for (int r = 0; r < 16; ++r) { p0[r] = ex2(p0[r] - mn); p1[r] = ex2(p1[r] - mn); }
                if (needmask) {
#pragma unroll
                    for (int r = 0; r < 16; ++r) { const int kp = 64 * T + crow(r, hi); if (kp >= d.nkeys) p0[r] = 0.f; if (kp + 32 >= d.nkeys) p1[r] = 0.f; } }
                float ps = 0.f;
#pragma unroll
                for (int r = 0; r < 16; ++r) ps += p0[r] + p1[r];
                ps = swap_add(ps);
                l_reg = l_reg * alpha + ps;
                if (grow && __any(alpha < 1.f)) { if (hi == 0) wsf[r32] = alpha; LDS_WAIT();
#pragma unroll
                    for (int dd = 0; dd < 4; ++dd)
#pragma unroll
                        for (int r = 0; r < 16; ++r) o[dd][r] *= wsf[crow(r, hi)]; }
                bf16x8 pa0, pa1, pa2, pa3; PK4(p0, 0, pa0); PK4(p0, 8, pa1); PK4(p1, 0, pa2); PK4(p1, 8, pa3);
                pv_d0(o, vb0, pa0, pa1, pa2, pa3);
            }
        } else {
            if (!wdone && T <= cw) {
                const bool diag = (T == cw);
                bf16x8 pa0, pa1, pa2, pa3; float ts1, ts0;
                {
                    f32x16 z, lf; qkt_half(z, Kl, Ql, r32, hi, 1); float ts = 0.f;
#pragma unroll
                    for (int r = 0; r < 16; ++r) { const float zz = z[r], e = ex2(-fabsf(zz)), l1p = __builtin_amdgcn_logf(1.0f + e); float lb = fminf(zz, 0.f) - l1p, lfv = -fmaxf(zz, 0.f) - l1p;
                        if (diag) { const bool c = (64 * T + 32 + crow(r, hi)) < qpos; lfv = c ? lfv : 0.f; lb = c ? lb : -1e30f; }
                        z[r] = lb; lf[r] = lfv; ts += lfv; }
                    ts1 = swap_add(ts);
                    bf16x8 la2, la3; PK4(lf, 0, la2); PK4(lf, 8, la3);
                    f32x16 L = f32x16{};
                    L = __builtin_amdgcn_mfma_f32_32x32x16_bf16(T00, la2, L, 0, 0, 0); L = __builtin_amdgcn_mfma_f32_32x32x16_bf16(T01, la3, L, 0, 0, 0);
#pragma unroll
                    for (int r = 0; r < 16; ++r) z[r] = ex2(z[r] + L[r] + R);
                    PK4(z, 0, pa2); PK4(z, 8, pa3);
                }
                {
                    f32x16 z, lf; qkt_half(z, Kl, Ql, r32, hi, 0); float ts = 0.f;
#pragma unroll
                    for (int r = 0; r < 16; ++r) { const float zz = z[r], e = ex2(-fabsf(zz)), l1p = __builtin_amdgcn_logf(1.0f + e); float lb = fminf(zz, 0.f) - l1p, lfv = -fmaxf(zz, 0.f) - l1p;
                        if (diag) { const bool c = (64 * T + crow(r, hi)) < qpos; lfv = c ? lfv : 0.f; lb = c ? lb : -1e30f; }
                        z[r] = lb; lf[r] = lfv; ts += lfv; }
                    ts0 = swap_add(ts);
                    bf16x8 la0, la1; PK4(lf, 0, la0); PK4(lf, 8, la1);
                    f32x16 L = f32x16{};
                    L = __builtin_amdgcn_mfma_f32_32x32x16_bf16(T00, la0, L, 0, 0, 0); L = __builtin_amdgcn_mfma_f32_32x32x16_bf16(T01, la1, L, 0, 0, 0);
                    const float Rr = R + ts1;
#pragma unroll
                    for (int r = 0; r < 16; ++r) z[r] = ex2(z[r] + L[r] + Rr);
                    PK4(z, 0, pa0); PK4(z, 8, pa1);
                }
                pv_d0(o, vb0, pa0, pa1, pa2, pa3);
                const float ts = ts0 + ts1;
                R += ts;
                wdone = __all((R < -160.f) || rowinvalid);
            }
            if (lane == 0) flags[8 * cur + wid] = wdone ? 1u : 0u;
        }
        __syncthreads();
    }
    __builtin_amdgcn_s_setprio(0);
    if (wvalid) {
        LAS bf16_t* stg = (LAS bf16_t*)(lds + L_OST) + wid * 4096;
        if (TYPE == 0) { if (hi == 0) wsf[32 + r32] = l_reg; LDS_WAIT(); }
#pragma unroll
        for (int r = 0; r < 16; ++r) { const int rw = crow(r, hi); const float rl = (TYPE == 0) ? __builtin_amdgcn_rcpf(wsf[32 + rw]) : 1.f;
#pragma unroll
            for (int dd = 0; dd < 4; ++dd) stg[rw * 128 + dd * 32 + r32] = f2bf(o[dd][r] * rl); }
        LDS_WAIT();
#pragma unroll 2
        for (int i = 0; i < 8; ++i) { const int rw = i * 4 + (lane >> 4), ch = lane & 15, row = 32 * wid + rw;
            if (row < d.nvalid) { const size_t off = (size_t)row * 3072 + ch * 8;
                const u32x4 ov = *(const LAS u32x4*)(stg + rw * 128 + ch * 8), gv = __builtin_nontemporal_load((const u32x4*)(d.SZ + off));
                u32x4 w; w.x = pk2(bflo(ov.x) * bflo(gv.x), bfhi(ov.x) * bfhi(gv.x)); w.y = pk2(bflo(ov.y) * bflo(gv.y), bfhi(ov.y) * bfhi(gv.y));
                w.z = pk2(bflo(ov.z) * bflo(gv.z), bfhi(ov.z) * bfhi(gv.z)); w.w = pk2(bflo(ov.w) * bflo(gv.w), bfhi(ov.w) * bfhi(gv.w));
                *(u32x4*)(d.Y + off) = w; } }
    }
#undef SLOAD
#undef SWRITE
}
}

#if defined(DBG_ONLY0)
#define ATT_DISPATCH(type, lds, d) att::unit<0>(lds, d)
#elif defined(DBG_ONLY1)
#define ATT_DISPATCH(type, lds, d) att::unit<1>(lds, d)
#elif defined(DBG_NOATT)
#define ATT_DISPATCH(type, lds, d) (void)d
#else
#define ATT_DISPATCH(type, lds, d) do { if (type) att::unit<1>(lds, d); else att::unit<0>(lds, d); } while (0)
#endif
struct Args { const float* in[28]; float* out; unsigned char* ws; int ph_lo, ph_hi; };
constexpr int I_IN = (DM / 64) * (NIN / 64), I_GLU = 16 * 16, I_BR = (MW / 64) * (DM / 64), I_OUT = 64 * 64, I_L = I_IN + I_GLU + 3 * I_BR + I_OUT;
__device__ __forceinline__ void weight_item(const float* w_in, const float* w_glu, const float* w_br0, const float* w_br1, const float* w_br2, const float* w_out, unsigned char* ws, int l, int r, LAS float* scr, int lane) {
    if (r < I_IN) { transpose_item(w_in + (size_t)l * DM * NIN, DM, NIN, (bf16_t*)(ws + WS_WIN) + (size_t)l * NIN * DM, scr, r, lane); return; } r -= I_IN;
    if (r < I_GLU) { transpose_item(w_glu + (size_t)l * MW * MW, MW, MW, (bf16_t*)(ws + WS_WGLU) + (size_t)l * MW * MW, scr, r, lane); return; } r -= I_GLU;
    if (r < 3 * I_BR) { const int br = r / I_BR; r -= br * I_BR;
        transpose_item((br == 0 ? w_br0 : br == 1 ? w_br1 : w_br2) + (size_t)l * MW * DM, MW, DM, (bf16_t*)(ws + WS_WBR) + (size_t)(l * 3 + br) * DM * MW, scr, r, lane); return; } r -= 3 * I_BR;
    transpose_item(w_out + (size_t)l * DM * DM, DM, DM, (bf16_t*)(ws + WS_WOUT) + (size_t)l * DM * DM, scr, r, lane);
}
__device__ __forceinline__ void convert_caches(const float* sbk, const float* sbv, const float* bdk, const float* bdv, const WsPtrs W, int l, int wg, int nwg, int gsz) {
    int t_ = threadIdx.x; asm volatile("" : "+v"(t_));
    const size_t gt = (size_t)wg * gsz + (t_ & (gsz - 1)), NT = (size_t)nwg * gsz;
    const size_t n_sb = 8ull * PASTL * 128, n_bd = 8ull * BANDK * 128;
    for (size_t i = gt; i < 2 * n_sb + 2 * n_bd; i += NT) {
        const float* src; bf16_t* dst; size_t j = i;
        if (j < 2 * n_sb) { const int kv = j >= n_sb; j -= kv * n_sb; const size_t lb = (size_t)l * NB + j / ((size_t)PASTL * 128), rem = j % ((size_t)PASTL * 128), t = rem >> 7, c8 = rem & 127;
            src = (kv ? sbv : sbk) + (lb * PASTL + t) * 1024 + c8 * 8; dst = (kv ? W.VCS() : W.KCS()) + (lb * KCS_ROWS + t) * 1024 + c8 * 8; }
        else { j -= 2 * n_sb; const int kv = j >= n_bd; j -= kv * n_bd; const size_t lb = (size_t)l * NB + j / ((size_t)BANDK * 128), rem = j % ((size_t)BANDK * 128), t = rem >> 7, c8 = rem & 127;
            src = (kv ? bdv : bdk) + (lb * BANDK + t) * 1024 + c8 * 8; dst = (kv ? W.VBS() : W.KBS()) + (lb * KBS_ROWS + t) * 1024 + c8 * 8; }
        const f32x4 a = __builtin_nontemporal_load((const f32x4*)src), b = __builtin_nontemporal_load((const f32x4*)(src + 4));
        st_bf16x8(dst, a, b);
    }
}
constexpr int N_PHASES = 11;

__global__ void __launch_bounds__(NWAVES * 64, 2) hse_fwd(Args args) {
    extern __shared__ __attribute__((aligned(16))) unsigned char lds_raw[];
    LAS unsigned char* lds = (LAS unsigned char*)lds_raw;
    volatile LAS unsigned* MISC = (volatile LAS unsigned*)(lds + MISC_OFF);
    const int tid = threadIdx.x, lane = tid & 63, wave = __builtin_amdgcn_readfirstlane(tid >> 6);
    const int G = gridDim.x; const int bx = blockIdx.x; const int vcu = (G % 8 == 0) ? (bx % 8) * (G / 8) + bx / 8 : bx;
    unsigned char* ws = args.ws; float* out = args.out;
    const CAS Args* const kargs = (const CAS Args*)__builtin_amdgcn_kernarg_segment_ptr();
#define KARGS() const CAS Args* KA = kargs; asm volatile("" : "+s"(KA))
#define PHASE_BEGIN() KARGS(); unsigned char* ws_o_ = ws; float* out_o_ = out; asm volatile("" : "+s"(ws_o_), "+s"(out_o_)); unsigned char* const ws = asg(ws_o_); float* const out = asg(out_o_); WsPtrs W; W.ws = ws; (void)out; (void)KA; \
    int G_o_ = G, bx_o_ = bx, vcu_o_ = vcu; asm volatile("" : "+s"(G_o_), "+s"(bx_o_), "+s"(vcu_o_)); const int G = G_o_, bx = bx_o_, vcu = vcu_o_; (void)G; (void)bx; (void)vcu
    unsigned* ctl = (unsigned*)(ws + WS_CTL);
    WsPtrs W; W.ws = ws;
    for (int u = tid; u < (LDS_BYTES - LDSCTL_OFF) / 4; u += NWAVES * 64) ((LAS unsigned*)(lds + LDSCTL_OFF))[u] = 0u;
    __syncthreads();
    XcdBarrier bar; bar.bar = ctl + CW_BAR; bar.x = 0; bar.st = nullptr;
    if (!MK_SPLIT) bar = xcd_barrier_post(ctl + CW_BAR, MISC + 8);
    const int lo = args.ph_lo, hi_ph = args.ph_hi;
#define IN(k) (lo <= (k) && (k) < hi_ph)
#define SEAM(k) do { if (!MK_SPLIT && (k) + 1 < hi_ph) xcd_barrier(bar); } while (0)
    const int gw = vcu * NWAVES + wave, NGW = G * NWAVES;

#ifndef NO_P0
    if (IN(0)) {
        PHASE_BEGIN();
        for (int lg = NGW - 1 - gw; lg < 2 * NG; lg += NGW) {
            const int l = lg / NG, g = lg - l * NG, n = lane;
            const float dt = expf(KA->in[12][lg]);
            const float are = KA->in[10][(size_t)lg * NST + n], aim = KA->in[11][(size_t)lg * NST + n];
            const float mag = expf(are * dt), abr = mag * cosf(aim * dt), abi = mag * sinf(aim * dt);
            const float den = are * are + aim * aim, nr = abr - 1.0f;
            const float kre = (nr * are + abi * aim) / den, kim = (abi * are - nr * aim) / den;
            *((f32x2*)(ws + WS_ABAR) + (size_t)lg * NST + n) = (f32x2){abr, abi};
            bf16_t* BMT = (bf16_t*)(ws + WS_BMT) + (size_t)lg * 128 * 16; bf16_t* CMT = (bf16_t*)(ws + WS_CMT) + (size_t)lg * 16 * 128;
            const float* bre = KA->in[13] + ((size_t)lg * NST + n) * 16; const float* bim = KA->in[14] + ((size_t)lg * NST + n) * 16;
#pragma unroll
            for (int p = 0; p < 16; ++p) { const float br_ = bre[p], bi_ = bim[p];
                BMT[(size_t)n * 16 + p] = f2bf(kre * br_ - kim * bi_); BMT[(size_t)(64 + n) * 16 + p] = f2bf(kre * bi_ + kim * br_);
                CMT[(size_t)p * 128 + n] = f2bf(KA->in[15][((size_t)lg * 16 + p) * NST + n]); CMT[(size_t)p * 128 + 64 + n] = f2bf(-KA->in[16][((size_t)lg * 16 + p) * NST + n]); }
        }
        LAS float* scr = (LAS float*)(lds + wave * 16640);
        for (int rep_ = 0; rep_ < ((DBG_DUP & 1) ? 2 : 1); ++rep_)
        for (int it = gw; it < I_L; it += NGW) weight_item(KA->in[9], KA->in[18], KA->in[23], KA->in[24], KA->in[25], KA->in[27], ws, 0, it, scr, lane);
        for (int m = gw; m < MR; m += NGW) {
            const float* xr = (m < MP) ? KA->in[0] + (size_t)m * DM : KA->in[1] + (size_t)(m - MP) * DM;
            xrow_to_a0(xr, KA->in[8], W.A0() + (size_t)m * DM, W.SSQ0() + m, lane);
        }
        convert_caches(KA->in[2], KA->in[3], KA->in[4], KA->in[5], W, 0, vcu, G, 512);
        for (int i = gw; i < 16 * 96 * 2; i += NGW) { const int kv = i & 1, j = i >> 1, lb = j / 96, rr = j - lb * 96;
            bf16_t* p = (rr < 48) ? (kv ? W.VCS() : W.KCS()) + ((size_t)lb * KCS_ROWS + PASTL + DSEQ + rr) * 1024 : (kv ? W.VBS() : W.KBS()) + ((size_t)lb * KBS_ROWS + BANDK + DSEQ + (rr - 48)) * 1024;
            *((u32x4*)p + lane) = (u32x4){0u, 0u, 0u, 0u}; *((u32x4*)p + 64 + lane) = (u32x4){0u, 0u, 0u, 0u}; }
        SEAM(0);
    }
#endif

    for (int l = 0; l < 2; ++l) {
        const int pb = 1 + 5 * l;
#ifndef NO_P1
        if (IN(pb)) {
            PHASE_BEGIN();
            pg8::Gemm g{DM, DM, DM};
            pg8::TileOrder<1> S; S.nM = MP / 256; S.nN = NIN / 256; S.nwg = S.nM * S.nN; S.G = G; S.c = bx;
            S.A = (const char*)W.A0(); S.B = (const char*)(ws + WS_WIN) + (size_t)l * NIN * DM * 2; S.atile = 256ull * DM * 2; S.btile = 256ull * DM * 2; S.arep = 0; S.brep = 0;
            pg8::QuarterOrder<1> SQ; SQ.pmq = MP / 256; SQ.nN = S.nN; SQ.G = G; SQ.c = bx; SQ.A = S.A; SQ.B = S.B; SQ.atile = S.atile; SQ.btile = S.btile; SQ.arep = 0; SQ.brep = 0; SQ.bhalf = 128ull * DM * 2;
            Epi1 E{l == 0 ? W.SSQ0() : W.SSQ1(), KA->in[26] + (size_t)l * 3 * DM, out, W, l};
            long long ck0 = 0, rt0 = 0; if (DBG_CLK == 1 && l == 0 && bx == 0) { ck0 = clock64(); rt0 = wall_clock64(); }
            pg8::gemm_phase<false>(lds, g, S, E);
            pg8::gemm_quarter(lds, g, SQ, E);
            if (DBG_CLK == 1 && l == 0 && bx == 0 && tid == 0) { const long long dc = clock64() - ck0, dr = wall_clock64() - rt0; ((long long*)(ws + WS_CTL + 32768))[0] = dc; ((long long*)(ws + WS_CTL + 32768))[1] = dr; }
            if (DBG_DUP & 2) { pg8::gemm_phase<false>(lds, g, S, E); pg8::gemm_quarter(lds, g, SQ, E); }
            if (DBG_DUP & 0xF00) { EpiNull EN{(float*)(ws + WS_CTL + 49152)}; S.fixed = (DBG_DUP >> 9) & 3; pg8::gemm_phase<false>(lds, g, S, EN); }
            if (DBG_CLK == 2 && l == 0 && tid == 0) { const unsigned long long t_ = (unsigned long long)wall_clock64(); atomicMax((unsigned long long*)(ws + WS_CTL + 40960), t_); atomicMax((unsigned long long*)(ws + WS_CTL + 40960) + 8, ~t_); }
            SEAM(pb);
            if (DBG_CLK == 2 && l == 0 && bx == 0 && tid == 0) { const unsigned long long mx = *((unsigned long long*)(ws + WS_CTL + 40960)), mn = ~*((unsigned long long*)(ws + WS_CTL + 40960) + 8);
                ((long long*)(ws + WS_CTL + 32768))[0] = (long long)(mx - mn) * 10; ((long long*)(ws + WS_CTL + 32768))[1] = 1; }
        }
#endif
#ifndef NO_P2A
        if (IN(pb + 1)) {
            PHASE_BEGIN();
            constexpr int NSW = 2, NHWV = NWAVES - NSW;
            if (wave < NSW) {
                LAS float* S = (LAS float*)(lds + wave * SSM_WAVE_BYTES);
                __builtin_amdgcn_s_setprio(2);
                for (int st = vcu * NSW + wave; st < 1024; st += G * NSW) {
                    const int sample = st >= 512, ii = st & 511, b = ii >> 6, g = ii & 63;
                    if (!sample) ssm_unit<32>(S, ws, KA->in[17] + (size_t)l * MW, l, g, W.U(), W.YG(), b * SEQ, SEQ, nullptr, nullptr,
                                          out + O_PSR + ((size_t)(l * NB + b) * NG + g) * NST, out + O_PSI + ((size_t)(l * NB + b) * NG + g) * NST, lane);
                    else ssm_unit<16>(S, ws, KA->in[17] + (size_t)l * MW, l, g, W.U(), W.YG(), MP + b * DSEQ, DSEQ,
                                  KA->in[6] + ((size_t)(l * NB + b) * NG + g) * NST, KA->in[7] + ((size_t)(l * NB + b) * NG + g) * NST,
                                  out + O_SSR + ((size_t)(l * NB + b) * NG + g) * NST, out + O_SSI + ((size_t)(l * NB + b) * NG + g) * NST, lane);
                }
                __builtin_amdgcn_s_setprio(0);
            } else
            { const int hw = vcu * NHWV + (wave - NSW), NHW = G * NHWV;
              {
                const float* qg = KA->in[20] + (size_t)l * HD; const float* kg = KA->in[21] + (size_t)l * HD;
                int lane_o = lane; asm volatile("" : "+v"(lane_o));
                const int c0 = 16 * lane_o, dd = c0 & 127;
                float gq[16], gk[16];
#pragma unroll
                for (int j = 0; j < 16; ++j) { gq[j] = qg[dd + j] * (0.08838834764831845f * LOG2E); gk[j] = kg[dd + j]; }
                for (int row = hw; row < MR; row += NHW) {
                    { bf16_t* qp = W.QB() + (size_t)row * 1024 + c0; const u32x4 a = __builtin_nontemporal_load((const u32x4*)qp), b2 = __builtin_nontemporal_load((const u32x4*)(qp + 8));
                      float v[16] = {bflo(a.x), bfhi(a.x), bflo(a.y), bfhi(a.y), bflo(a.z), bfhi(a.z), bflo(a.w), bfhi(a.w), bflo(b2.x), bfhi(b2.x), bflo(b2.y), bfhi(b2.y), bflo(b2.z), bfhi(b2.z), bflo(b2.w), bfhi(b2.w)};
                      float s = 0.f;
#pragma unroll
                      for (int j = 0; j < 16; ++j) s += v[j] * v[j];
                      s += __shfl_xor(s, 1); s += __shfl_xor(s, 2); s += __shfl_xor(s, 4);
                      const float r = __builtin_amdgcn_rsqf(s * (1.0f / 128.0f) + 1e-6f);
#pragma unroll
                      for (int j = 0; j < 16; ++j) v[j] = v[j] * r * gq[j];
                      st_bf16x8(qp, (f32x4){v[0], v[1], v[2], v[3]}, (f32x4){v[4], v[5], v[6], v[7]}); st_bf16x8(qp + 8, (f32x4){v[8], v[9], v[10], v[11]}, (f32x4){v[12], v[13], v[14], v[15]}); }
                    { const bf16_t* kp = W.KB() + (size_t)row * 1024 + c0; const u32x4 a = __builtin_nontemporal_load((const u32x4*)kp), b2 = __builtin_nontemporal_load((const u32x4*)(kp + 8));
                      float v[16] = {bflo(a.x), bfhi(a.x), bflo(a.y), bfhi(a.y), bflo(a.z), bfhi(a.z), bflo(a.w), bfhi(a.w), bflo(b2.x), bfhi(b2.x), bflo(b2.y), bfhi(b2.y), bflo(b2.z), bfhi(b2.z), bflo(b2.w), bfhi(b2.w)};
                      float s = 0.f;
#pragma unroll
                      for (int j = 0; j < 16; ++j) s += v[j] * v[j];
                      s += __shfl_xor(s, 1); s += __shfl_xor(s, 2); s += __shfl_xor(s, 4);
                      const float r = __builtin_amdgcn_rsqf(s * (1.0f / 128.0f) + 1e-6f);
#pragma unroll
                      for (int j = 0; j < 16; ++j) v[j] = v[j] * r * gk[j];
                      bf16_t* d16; float* d32 = nullptr;
                      if (row < MP) { const int b = row >> 11, t = row & 2047; d16 = W.KB() + (size_t)row * 1024 + c0;
                          if (t >= SEQ - BANDK) d32 = out + O_PBK + ((size_t)(l * NB + b) * BANDK + (t - (SEQ - BANDK))) * 1024 + c0; }
                      else { const int sr = row - MP, b = sr >> 4, t = sr & 15; d16 = W.KBS() + ((size_t)(l * NB + b) * KBS_ROWS + BANDK + t) * 1024 + c0; d32 = out + O_SBK + ((size_t)l * MS + sr) * 1024 + c0; }
                      st_bf16x8(d16, (f32x4){v[0], v[1], v[2], v[3]}, (f32x4){v[4], v[5], v[6], v[7]}); st_bf16x8(d16 + 8, (f32x4){v[8], v[9], v[10], v[11]}, (f32x4){v[12], v[13], v[14], v[15]});
                      if (d32) { *(f32x4*)d32 = (f32x4){v[0], v[1], v[2], v[3]}; *(f32x4*)(d32 + 4) = (f32x4){v[4], v[5], v[6], v[7]}; *(f32x4*)(d32 + 8) = (f32x4){v[8], v[9], v[10], v[11]}; *(f32x4*)(d32 + 12) = (f32x4){v[12], v[13], v[14], v[15]}; } }
                }
                if (l == 0) { LAS float* scr = (LAS float*)(lds + NSW * SSM_WAVE_BYTES + (wave - NSW) * 16640);
                    for (int it = hw; it < I_IN; it += NHW) weight_item(KA->in[9], KA->in[18], KA->in[23], KA->in[24], KA->in[25], KA->in[27], ws, 1, it, scr, lane); }
                else { convert_caches(KA->in[2], KA->in[3], KA->in[4], KA->in[5], W, 1, hw, NHW, 64);
                    LAS float* scr = (LAS float*)(lds + NSW * SSM_WAVE_BYTES + (wave - NSW) * 16640);
                    for (int it = I_IN + hw; it < I_L; it += NHW) weight_item(KA->in[9], KA->in[18], KA->in[23], KA->in[24], KA->in[25], KA->in[27], ws, 1, it, scr, lane); }
              } }
            SEAM(pb + 1);
        }
#endif
#ifndef NO_P2B
        if (IN(pb + 2)) {
            PHASE_BEGIN();
            for (int rep_ = 0; rep_ < ((DBG_DUP & 8) ? 2 : 1); ++rep_) {
            const int nit = (G == 256) ? (((vcu & 7) <= 1 || (vcu & 7) >= 6) ? 5 : 4) : (1152 + G - 1 - vcu) / G;
            for (int k = 0; k < nit; ++k) {
                int item;
                if (G == 256) { const int q = vcu & 7, bq = vcu >> 3;
                    if (k < 4) { const int second = k & 1, ty = k >> 1; item = ty * 512 + (second ? ((32 + bq) << 3) + (7 - q) : (bq << 3) + q); }
                    else item = 1024 + ((q == 0 || q == 7) ? 0 : 64) + ((q == 0 || q == 1) ? 0 : 32) + bq; }
                else item = vcu + k * G;
                att::Desc d;
                if (item < 1024) {
                    const int type = item < 512 ? 1 : 0, ii = item & 511, bh = ii >> 3, qb = ii & 7, b = bh >> 3, h = bh & 7;
                    const size_t row0 = (size_t)b * SEQ + 256 * qb;
                    d.Q = (type ? W.QC() : W.QB()) + row0 * 1024 + h * HD; d.K = (type ? W.KC() : W.KB()) + (size_t)b * SEQ * 1024 + h * HD; d.V = (type ? W.VC() : W.VB()) + (size_t)b * SEQ * 1024 + h * HD;
                    d.SZ = W.SZ() + row0 * 3072 + (type ? 2048 : 1024) + h * HD; d.Y = W.Y() + row0 * 3072 + (type ? 2048 : 1024) + h * HD;
                    d.bias = KA->in[22] + ((size_t)l * NH + h) * 257; d.qpos0 = 256 * qb; d.nvalid = 256; d.nkeys = SEQ;
                    ATT_DISPATCH(type, lds, d);
                    if ((DBG_DUP & 64) && type == 1) att::unit<1>(lds, d);
                    if ((DBG_DUP & 128) && type == 0) att::unit<0>(lds, d);
                } else {
                    const int type = item < 1088 ? 0 : 1, ii = (item - 1024) & 63, b = ii >> 3, h = ii & 7;
                    const size_t row0 = (size_t)MP + b * DSEQ;
                    d.Q = (type ? W.QC() : W.QB()) + row0 * 1024 + h * HD;
                    d.K = (type ? W.KCS() + (size_t)(l * NB + b) * KCS_ROWS * 1024 : W.KBS() + (size_t)(l * NB + b) * KBS_ROWS * 1024) + h * HD;
                    d.V = (type ? W.VCS() + (size_t)(l * NB + b) * KCS_ROWS * 1024 : W.VBS() + (size_t)(l * NB + b) * KBS_ROWS * 1024) + h * HD;
                    d.SZ = W.SZ() + row0 * 3072 + (type ? 2048 : 1024) + h * HD; d.Y = W.Y() + row0 * 3072 + (type ? 2048 : 1024) + h * HD;
                    d.bias = KA->in[22] + ((size_t)l * NH + h) * 257; d.qpos0 = type ? PASTL : BANDK; d.nvalid = DSEQ; d.nkeys = (type ? PASTL : BANDK) + DSEQ;
                    ATT_DISPATCH(type, lds, d);
                }
            }
#ifndef DBG_NOGLU
            __syncthreads();
            { pg8::Gemm g{MW, MW, MW};
              pg8::TileOrder<1> S; S.nM = MP / 256; S.nN = MW / 256; S.nwg = S.nM * S.nN; S.G = G; S.c = bx;
              S.A = (const char*)W.YG(); S.B = (const char*)(ws + WS_WGLU) + (size_t)l * MW * MW * 2; S.atile = 256ull * MW * 2; S.btile = 256ull * MW * 2; S.arep = 0; S.brep = 0;
              pg8::QuarterOrder<1> SQ; SQ.pmq = MP / 256; SQ.nN = S.nN; SQ.G = G; SQ.c = (vcu + G / 2) % G; SQ.A = S.A; SQ.B = S.B; SQ.atile = S.atile; SQ.btile = S.btile; SQ.arep = 0; SQ.brep = 0; SQ.bhalf = 128ull * MW * 2;
              EpiGlu E{KA->in[19] + (size_t)l * MW, W};
              pg8::gemm_phase<false>(lds, g, S, E);
              pg8::gemm_quarter(lds, g, SQ, E); }
#endif
            }
            SEAM(pb + 2);
        }
#endif
#ifndef NO_P3
        if (IN(pb + 3)) {
            PHASE_BEGIN();
            pg8::Gemm g{3 * MW, MW, MW};
            pg8::TileOrder<3> S; S.nM = MP / 256; S.nN = DM / 256; S.nwg = S.nM * S.nN; S.G = G; S.c = bx;
            S.A = (const char*)W.Y(); S.B = (const char*)(ws + WS_WBR) + (size_t)l * 3 * DM * MW * 2; S.atile = 256ull * 3 * MW * 2; S.btile = 256ull * MW * 2; S.arep = (size_t)MW * 2; S.brep = (size_t)DM * MW * 2;
            pg8::QuarterOrder<3> SQ; SQ.pmq = MP / 256; SQ.nN = S.nN; SQ.G = G; SQ.c = bx; SQ.A = S.A; SQ.B = S.B; SQ.atile = S.atile; SQ.btile = S.btile; SQ.arep = S.arep; SQ.brep = S.brep; SQ.bhalf = 128ull * MW * 2;
            EpiBr E{W};
            pg8::gemm_phase<false>(lds, g, S, E);
            pg8::gemm_quarter(lds, g, SQ, E);
            if (DBG_DUP & 16) { pg8::gemm_phase<false>(lds, g, S, E); pg8::gemm_quarter(lds, g, SQ, E); }
            if (DBG_DUP & 2048) { EpiNull EN{(float*)(ws + WS_CTL + 49152)}; pg8::gemm_phase<false>(lds, g, S, EN); }
            if (DBG_DUP & 4096) pg8::gemm_phase<false>(lds, g, S, E);
            SEAM(pb + 3);
        }
#endif
#ifndef NO_P4
        if (IN(pb + 4)) {
            PHASE_BEGIN();
            pg8::Gemm g{DM, DM, DM};
            pg8::TileOrder<1> S; S.nM = MP / 256; S.nN = DM / 256; S.nwg = S.nM * S.nN; S.G = G; S.c = bx;
            S.A = (const char*)W.MX(); S.B = (const char*)(ws + WS_WOUT) + (size_t)l * DM * DM * 2; S.atile = 256ull * DM * 2; S.btile = 256ull * DM * 2; S.arep = 0; S.brep = 0;
            pg8::QuarterOrder<1> SQ; SQ.pmq = MP / 256; SQ.nN = S.nN; SQ.G = G; SQ.c = bx; SQ.A = S.A; SQ.B = S.B; SQ.atile = S.atile; SQ.btile = S.btile; SQ.arep = 0; SQ.brep = 0; SQ.bhalf = 128ull * DM * 2;
            EpiOut E{KA->in[0], KA->in[1], KA->in[8] + DM, out, W, l};
            pg8::gemm_phase<false>(lds, g, S, E);
            pg8::gemm_quarter(lds, g, SQ, E);
            if ((DBG_DUP & 32) && l == 1) { pg8::gemm_phase<false>(lds, g, S, E); pg8::gemm_quarter(lds, g, SQ, E); }
            SEAM(pb + 4);
        }
#endif
    }
    if (DBG_CLK && bx == 0 && tid == 0) { const long long dc = ((long long*)(ws + WS_CTL + 32768))[0], dr = ((long long*)(ws + WS_CTL + 32768))[1];
        const long long ticks = (DBG_CLK == 2) ? dc : (dc * 10000) / (dr > 0 ? dr : 1); const long long t0 = wall_clock64(); while (wall_clock64() - t0 < ticks) __builtin_amdgcn_s_sleep(8); }
#undef IN
#undef SEAM
}

extern "C" void kernel_launch(void* const* d_in, const int* in_sizes, int n_in, void* d_out, int out_size, void* d_ws, size_t ws_size, hipStream_t stream) {
    static int grid = 0;
    if (grid == 0) {
        if ((size_t)out_size != O_END) fprintf(stderr, "kernel_launch: note: out_size %d, built for %zu\n", out_size, (size_t)O_END);
        if (n_in != 28 || ws_size < WS_END) { fprintf(stderr, "kernel_launch: shape mismatch n_in %d ws %zu (want %zu)\n", n_in, ws_size, (size_t)WS_END); grid = -1; return; }
        int dev = 0, cus = 0;
        if (hipGetDevice(&dev) != hipSuccess || hipDeviceGetAttribute(&cus, hipDeviceAttributeMultiprocessorCount, dev) != hipSuccess) { grid = -1; return; }
        if (hipFuncSetAttribute((const void*)hse_fwd, hipFuncAttributeMaxDynamicSharedMemorySize, LDS_BYTES) != hipSuccess) { fprintf(stderr, "kernel_launch: hipFuncSetAttribute failed\n"); grid = -1; return; }
        int per_cu = 0;
        if (hipOccupancyMaxActiveBlocksPerMultiprocessor(&per_cu, (const void*)hse_fwd, NWAVES * 64, LDS_BYTES) != hipSuccess || per_cu < 1) fprintf(stderr, "kernel_launch: occupancy query says %d\n", per_cu);
        (void)hipGetLastError();
        grid = cus;
    }
    if (grid < 0) return;
    if (hipMemsetAsync((char*)d_ws + WS_CTL, 0, CTL_ZERO_BYTES, stream) != hipSuccess) return;
    Args a{};
    for (int i = 0; i < 28; ++i) a.in[i] = (const float*)d_in[i];
    a.out = (float*)d_out; a.ws = (unsigned char*)d_ws;
#if MK_SPLIT
    for (int p = 0; p < N_PHASES; ++p) { a.ph_lo = p; a.ph_hi = p + 1; hipLaunchKernelGGL(hse_fwd, dim3(grid), dim3(NWAVES * 64), LDS_BYTES, stream, a); }
#else
    a.ph_lo = 0; a.ph_hi = N_PHASES; hipLaunchKernelGGL(hse_fwd, dim3(grid), dim3(NWAVES * 64), LDS_BYTES, stream, a);
#endif
}
```
